# Optimizing an MI355X kernel written in HIP

```python
import math
import jax, jax.numpy as jnp
from jax import lax
import numpy as np

D_MODEL = 1024
BATCH = 4
SEQ = 4096
DEPTH = 1

HEAD_DIM = 64
DIFF_HEADS = D_MODEL // (4 * HEAD_DIM)
DIFF_VDIM = 2 * HEAD_DIM
SB_HEADS = D_MODEL // (2 * HEAD_DIM)
DIFF_WIDTH = DIFF_HEADS * DIFF_VDIM
SB_WIDTH = SB_HEADS * HEAD_DIM
MIX_WIDTH = DIFF_WIDTH + SB_WIDTH
IN_SIZES = (DIFF_WIDTH, DIFF_WIDTH, DIFF_WIDTH, SB_WIDTH, SB_WIDTH, SB_WIDTH)
IN_COLS = sum(IN_SIZES)
ROPE_THETA = 10000.0
Q_BLOCK = 128
N_EXPERTS = 256
TOP_K = 8
N_GROUPS = 8
TOPK_GROUPS = 4
EXPERT_FF = 256
SHARED_FF = 256
ROUTED_SCALE = 2.5
EXPERT_ROWS = 128
NORM_EPS = 1e-6
N_MOD = 6

kernel_name = "hybrid_diffattn_stickbreak_moe_adaln"


def rms_norm(x, g):
    xf = x.astype(jnp.float32)
    y = xf * lax.rsqrt(jnp.mean(xf * xf, axis=-1, keepdims=True) + NORM_EPS)
    return y * g.astype(jnp.float32)


def rope_tables(positions):
    inv = ROPE_THETA ** (-jnp.arange(0, HEAD_DIM, 2, dtype=jnp.float32) / HEAD_DIM)
    ang = positions.astype(jnp.float32)[..., None] * inv
    ang = jnp.concatenate([ang, ang], axis=-1)
    return jnp.cos(ang), jnp.sin(ang)


def apply_rope(x, cos, sin):
    x1, x2 = jnp.split(x, 2, axis=-1)
    return x * cos + jnp.concatenate([-x2, x1], axis=-1) * sin


def diff_attention(q, k, v, lam, g_q, g_k, g_sub, cos, sin, lambda_init):
    B, S = q.shape[0], q.shape[1]
    cs = cos[:, :, None, None, :]
    sn = sin[:, :, None, None, :]
    q = apply_rope(rms_norm(q, g_q), cs, sn).transpose(0, 2, 3, 1, 4)
    k = apply_rope(rms_norm(k, g_k), cs, sn).transpose(0, 2, 3, 1, 4)
    v = v.astype(jnp.float32).transpose(0, 2, 1, 3)
    lam = lam.astype(jnp.float32)
    lmbda = jnp.exp(jnp.sum(lam[0] * lam[1])) - jnp.exp(jnp.sum(lam[2] * lam[3])) + lambda_init
    scale = HEAD_DIM ** -0.5
    outs = []
    for i in range(S // Q_BLOCK):
        lo, hi = i * Q_BLOCK, (i + 1) * Q_BLOCK
        s = jnp.einsum("bhmqd,bhmkd->bhmqk", q[:, :, :, lo:hi], k[:, :, :, :hi]) * scale
        causal = jnp.arange(hi)[None, :] <= jnp.arange(lo, hi)[:, None]
        p = jax.nn.softmax(jnp.where(causal, s, -jnp.inf), axis=-1)
        a = p[:, :, 0] - lmbda * p[:, :, 1]
        outs.append(jnp.einsum("bhqk,bhkd->bhqd", a, v[:, :, :hi]))
    o = jnp.concatenate(outs, axis=2)
    o = rms_norm(o, g_sub) * (1.0 - lambda_init)
    return o.transpose(0, 2, 1, 3).reshape(B, S, DIFF_WIDTH)


def stick_breaking(q, k, v):
    B, S = q.shape[0], q.shape[1]
    q = q.astype(jnp.float32).transpose(0, 2, 1, 3)
    k = k.astype(jnp.float32).transpose(0, 2, 1, 3)
    v = v.astype(jnp.float32).transpose(0, 2, 1, 3)
    scale = HEAD_DIM ** -0.5
    outs = []
    for i in range(S // Q_BLOCK):
        lo, hi = i * Q_BLOCK, (i + 1) * Q_BLOCK
        z = jnp.einsum("bhqd,bhkd->bhqk", q[:, :, lo:hi], k[:, :, :hi]) * scale
        strict = jnp.arange(hi)[None, :] < jnp.arange(lo, hi)[:, None]
        log_keep = jnp.where(strict, jax.nn.log_sigmoid(-z), 0.0)
        log_w = jax.nn.log_sigmoid(z) + lax.cumsum(log_keep, axis=3, reverse=True) - log_keep
        w = jnp.where(strict, jnp.exp(log_w), 0.0)
        outs.append(jnp.einsum("bhqk,bhkd->bhqd", w, v[:, :, :hi]))
    o = jnp.concatenate(outs, axis=2)
    return o.transpose(0, 2, 1, 3).reshape(B, S, SB_WIDTH)


def route(h, w_router, e_bias):
    T = h.shape[0]
    scores = jax.nn.sigmoid(h @ w_router.astype(jnp.float32))
    biased = scores + e_bias.astype(jnp.float32)
    grp = biased.reshape(T, N_GROUPS, N_EXPERTS // N_GROUPS)
    gscore = jnp.sum(lax.top_k(grp, 2)[0], axis=-1)
    _, gidx = lax.top_k(gscore, TOPK_GROUPS)
    gmask = jnp.any(gidx[..., None] == jnp.arange(N_GROUPS), axis=1)
    emask = jnp.repeat(gmask, N_EXPERTS // N_GROUPS, axis=1)
    _, idx = lax.top_k(jnp.where(emask, biased, -jnp.inf), TOP_K)
    w = jnp.take_along_axis(scores, idx, axis=1)
    w = w / jnp.sum(w, axis=-1, keepdims=True) * ROUTED_SCALE
    return idx, w


def swiglu(x, w_gu, w_down):
    gu = x @ w_gu.astype(jnp.float32)
    g, u = jnp.split(gu, 2, axis=-1)
    return (jax.nn.silu(g) * u) @ w_down.astype(jnp.float32)


def routed_experts(h, idx, wts, w_gu, w_down):
    T, D = h.shape
    K = idx.shape[1]
    A = T * K
    flat_e = idx.reshape(-1).astype(jnp.int32)
    flat_tok = jnp.repeat(jnp.arange(T, dtype=jnp.int32), K)
    flat_w = wts.reshape(-1)
    order = jnp.argsort(flat_e)
    se = flat_e[order]
    counts = jnp.bincount(flat_e, length=N_EXPERTS)
    padded = (counts + EXPERT_ROWS - 1) // EXPERT_ROWS * EXPERT_ROWS
    start = jnp.cumsum(counts) - counts
    pend = jnp.cumsum(padded)
    pstart = pend - padded
    dest = pstart[se] + (jnp.arange(A, dtype=jnp.int32) - start[se])
    n_blocks = -(-A // EXPERT_ROWS) + N_EXPERTS
    P = n_blocks * EXPERT_ROWS
    slot_tok = jnp.full((P,), T, jnp.int32).at[dest].set(flat_tok[order])
    slot_w = jnp.zeros((P,), jnp.float32).at[dest].set(flat_w[order])
    block_e = jnp.clip(jnp.searchsorted(pend, jnp.arange(n_blocks) * EXPERT_ROWS, side="right"),
                       0, N_EXPERTS - 1).astype(jnp.int32)
    h_pad = jnp.concatenate([h, jnp.zeros((1, D), h.dtype)], axis=0)

    def one_block(args):
        tok, e = args
        return swiglu(h_pad[tok], w_gu[e], w_down[e])

    y = lax.map(one_block, (slot_tok.reshape(n_blocks, EXPERT_ROWS), block_e))
    y = y.reshape(P, D) * slot_w[:, None]
    return jax.ops.segment_sum(y, slot_tok, num_segments=T + 1)[:T]


def setup_inputs(seed: int = 0) -> dict:
    key = jax.random.key(seed)
    ks = jax.random.split(key, 20)
    L, D, E, F = DEPTH, D_MODEL, N_EXPERTS, EXPERT_FF
    nrm = jax.random.normal
    x = nrm(ks[0], (BATCH, SEQ, D), jnp.float32)
    c = nrm(ks[1], (BATCH, D), jnp.float32)
    positions = (jnp.arange(SEQ, dtype=jnp.int32)[None, :]
                 + jax.random.randint(ks[2], (BATCH, 1), 0, 1024, dtype=jnp.int32))
    w_ada = nrm(ks[3], (L, D, N_MOD * D), jnp.float32) * (0.5 * D ** -0.5)
    b_ada = 0.02 * nrm(ks[4], (L, N_MOD * D), jnp.float32)
    g_mix = 1.0 + 0.02 * nrm(ks[5], (L, D), jnp.float32)
    w_in = nrm(ks[6], (L, D, IN_COLS), jnp.float32) * D ** -0.5
    g_q = 1.0 + 0.02 * nrm(ks[7], (L, HEAD_DIM), jnp.float32)
    g_k = 1.0 + 0.02 * nrm(ks[8], (L, HEAD_DIM), jnp.float32)
    lam = 0.1 * nrm(ks[9], (L, 4, HEAD_DIM), jnp.float32)
    g_sub = 1.0 + 0.02 * nrm(ks[10], (L, DIFF_VDIM), jnp.float32)
    w_out = nrm(ks[11], (L, MIX_WIDTH, D), jnp.float32) * MIX_WIDTH ** -0.5
    g_ffn = 1.0 + 0.02 * nrm(ks[12], (L, D), jnp.float32)
    w_router = nrm(ks[13], (L, D, E), jnp.float32) * D ** -0.5
    e_bias = 0.01 * nrm(ks[14], (L, E), jnp.float32)
    w_sh_gu = nrm(ks[15], (L, D, 2 * SHARED_FF), jnp.float32) * D ** -0.5
    w_sh_down = nrm(ks[16], (L, SHARED_FF, D), jnp.float32) * SHARED_FF ** -0.5
    w_gu = nrm(ks[17], (L, E, D, 2 * F), jnp.float32) * D ** -0.5
    w_down = nrm(ks[18], (L, E, F, D), jnp.float32) * F ** -0.5
    return {"x": x, "c": c, "positions": positions, "w_ada": w_ada, "b_ada": b_ada,
            "g_mix": g_mix, "w_in": w_in, "g_q": g_q, "g_k": g_k, "lam": lam, "g_sub": g_sub,
            "w_out": w_out, "g_ffn": g_ffn, "w_router": w_router, "e_bias": e_bias,
            "w_sh_gu": w_sh_gu, "w_sh_down": w_sh_down, "w_gu": w_gu, "w_down": w_down}


def reference(x, c, positions, w_ada, b_ada, g_mix, w_in, g_q, g_k, lam, g_sub, w_out,
              g_ffn, w_router, e_bias, w_sh_gu, w_sh_down, w_gu, w_down):
    B, S, D = x.shape
    cos, sin = rope_tables(positions)
    cond = jax.nn.silu(c.astype(jnp.float32))
    offs = [int(v) for v in np.cumsum(IN_SIZES)[:-1]]
    r = x.astype(jnp.float32)
    for l in range(DEPTH):
        lambda_init = 0.8 - 0.6 * math.exp(-0.3 * l)
        mod = cond @ w_ada[l].astype(jnp.float32) + b_ada[l].astype(jnp.float32)
        sh_a, sc_a, gt_a, sh_m, sc_m, gt_m = jnp.split(mod[:, None, :], N_MOD, axis=-1)
        h = rms_norm(r, g_mix[l]) * (1.0 + sc_a) + sh_a
        proj = h @ w_in[l].astype(jnp.float32)
        dq, dk, dv, sq, sk, sv = jnp.split(proj, offs, axis=-1)
        o_diff = diff_attention(dq.reshape(B, S, DIFF_HEADS, 2, HEAD_DIM),
                                dk.reshape(B, S, DIFF_HEADS, 2, HEAD_DIM),
                                dv.reshape(B, S, DIFF_HEADS, DIFF_VDIM),
                                lam[l], g_q[l], g_k[l], g_sub[l], cos, sin, lambda_init)
        o_sb = stick_breaking(sq.reshape(B, S, SB_HEADS, HEAD_DIM),
                              sk.reshape(B, S, SB_HEADS, HEAD_DIM),
                              sv.reshape(B, S, SB_HEADS, HEAD_DIM))
        mixed = jnp.concatenate([o_diff, o_sb], axis=-1)
        r = r + gt_a * (mixed @ w_out[l].astype(jnp.float32))
        h2 = rms_norm(r, g_ffn[l]) * (1.0 + sc_m) + sh_m
        hf = h2.reshape(B * S, D)
        idx, wts = route(hf, w_router[l], e_bias[l])
        y = swiglu(hf, w_sh_gu[l], w_sh_down[l]) + routed_experts(hf, idx, wts, w_gu[l], w_down[l])
        r = r + gt_m * y.reshape(B, S, D)
    return r.astype(x.dtype)
```

```cpp
#include <hip/hip_runtime.h>
#include <hip/hip_bf16.h>
#include <cstdio>
#include <cstdint>
#include <cmath>
namespace pg8 {
#define PG8_LAS __attribute__((address_space(3)))
typedef unsigned short bf16_t;
typedef short bf16x8 __attribute__((ext_vector_type(8)));
typedef float f32x4 __attribute__((ext_vector_type(4)));
typedef unsigned u32x4 __attribute__((ext_vector_type(4)));
constexpr int BM = 256, BK = 64, HALF = 128, HTB = HALF * BK * 2  , STAGE_BYTES = 8 * HTB, NXCD = 8, WGM = 8;

__host__ __device__ __forceinline__ int lds_byte(int r, int c) { const int st = (r >> 4) * 2 + (c >> 5), rr = r & 15, cc = c & 31, ob = rr * 64 + cc * 2; return st * 1024 + (ob ^ (((ob >> 9) & 1) << 5)); }
__host__ __device__ __forceinline__ void stage_rc(int b, int& R, int& C) { const int st = b / 1024, sb = b % 1024, swz = sb ^ (((sb >> 9) & 1) << 5); R = (st >> 1) * 16 + swz / 64; C = (st & 1) * 32 + (swz % 64) / 2; }
__host__ __device__ __forceinline__ int perm32(int rho) { const int n = rho >> 4, i = rho & 15; return 8 * (i >> 2) + 4 * n + (i & 3); }

struct Unit { int pm, pn; };
struct Gemm { const bf16_t* A; const bf16_t* Bt; int M, N, K; };

struct StaticOrder {
    int nM, nN, nwg, G, c;
    __host__ __device__ void init(int M, int N, int G_, int c_) { nM = M / BM; nN = N / BM; nwg = nM * nN; G = G_; c = c_; }
    __host__ __device__ bool next(int i, Unit& u) const {
        const long L = (long)i * G + c; if (L >= nwg) return false;
        int wgid = (int)L; { const int q = nwg / NXCD, r = nwg % NXCD, xcd = wgid % NXCD, off = wgid / NXCD; wgid = (xcd < r ? xcd * (q + 1) : r * (q + 1) + (xcd - r) * q) + off; }
        const int nig = WGM * nN, gid = wgid / nig, fm = gid * WGM, gsz = (nM - fm) < WGM ? (nM - fm) : WGM;
        u.pm = fm + ((wgid % nig) % gsz); u.pn = (wgid % nig) / gsz; return true;
    }
    __device__ __forceinline__ void a_ready(const Unit&) const {}
    __device__ __forceinline__ void done(const Unit&) const {}
};

__device__ __forceinline__ unsigned cvt_pk_bf16(float lo, float hi) { typedef float f2_t __attribute__((ext_vector_type(2))); typedef __bf16 b2_t __attribute__((ext_vector_type(2)));
    f2_t v = {lo, hi}; b2_t b = __builtin_convertvector(v, b2_t); return __builtin_bit_cast(unsigned, b); }
typedef unsigned u32x2 __attribute__((ext_vector_type(2)));
constexpr float QK_C2 = 0.125f * 1.4426950408889634f;

struct EpiGateBf16 {
    static constexpr bool PERM = false, AFTER_DRAIN = false;
    const float* gate; bf16_t* DLT;
    __device__ __forceinline__ void operator()(const f32x4 (&acc)[2][2][4][2], const Unit& u, int wr, int wc, int fr, int fq) const {
        const int row0 = u.pm * BM + wr * 64 + fr, col0 = u.pn * BM + wc * 32 + 4 * fq;
        const float* gb = gate + (size_t)(u.pm >> 4) * 6144 + col0;
        f32x4 gv[2][2];
#pragma unroll
        for (int bj = 0; bj < 2; ++bj)
#pragma unroll
            for (int n = 0; n < 2; ++n) gv[bj][n] = *(const f32x4*)(gb + bj * HALF + n * 16);
#pragma unroll
        for (int ai = 0; ai < 2; ++ai)
#pragma unroll
            for (int m = 0; m < 4; ++m) { bf16_t* rowp = DLT + (size_t)(row0 + ai * HALF + m * 16) * 1024 + col0;
#pragma unroll
                for (int bj = 0; bj < 2; ++bj)
#pragma unroll
                    for (int n = 0; n < 2; ++n) { const f32x4 v = gv[bj][n] * acc[ai][bj][m][n]; u32x2 w; w.x = cvt_pk_bf16(v[0], v[1]); w.y = cvt_pk_bf16(v[2], v[3]); *(u32x2*)(rowp + bj * HALF + n * 16) = w; } }
    }
};
struct EpiProj {
    static constexpr bool PERM = false, AFTER_DRAIN = false;
    bf16_t* P; bf16_t* SVT; const float* rcos; const float* rsin; const float* gq; const float* gk;
    __device__ __forceinline__ void operator()(const f32x4 (&acc)[2][2][4][2], const Unit& u, int wr, int wc, int fr, int fq) const {
        const int row0 = u.pm * BM + wr * 64 + fr, pn = u.pn;
        const int cbase = pn * BM + 64 * wc + 4 * fq;
        if (pn < 4) {
            const float* g = pn < 2 ? gq : gk; const float osc = pn < 2 ? QK_C2 : 1.0f;
            f32x4 gv[2][2];
#pragma unroll
            for (int bj = 0; bj < 2; ++bj)
#pragma unroll
                for (int n = 0; n < 2; ++n) gv[bj][n] = *(const f32x4*)(g + 32 * bj + 16 * n + 4 * fq);
#pragma unroll
            for (int ai = 0; ai < 2; ++ai)
#pragma unroll
                for (int m = 0; m < 4; ++m) { const int row = row0 + ai * HALF + m * 16; float ss = 0.f;
#pragma unroll
                    for (int bj = 0; bj < 2; ++bj)
#pragma unroll
                        for (int n = 0; n < 2; ++n) { const f32x4 v = acc[ai][bj][m][n]; ss += (v[0] * v[0] + v[1] * v[1]) + (v[2] * v[2] + v[3] * v[3]); }
                    ss += __shfl_xor(ss, 16); ss += __shfl_xor(ss, 32);
                    const float rstd = 1.0f / sqrtf(ss * (1.0f / 64.0f) + 1e-6f);
                    bf16_t* prow = P + (size_t)row * 3072 + cbase;
#pragma unroll
                    for (int n = 0; n < 2; ++n) { const f32x4 cs = *(const f32x4*)(rcos + (size_t)row * 32 + 16 * n + 4 * fq), sn = *(const f32x4*)(rsin + (size_t)row * 32 + 16 * n + 4 * fq);
                        const f32x4 lo = acc[ai][0][m][n] * rstd * gv[0][n], hi = acc[ai][1][m][n] * rstd * gv[1][n];
                        const f32x4 olo = (lo * cs - hi * sn) * osc, ohi = (hi * cs + lo * sn) * osc;
                        u32x2 w0, w1; w0.x = cvt_pk_bf16(olo[0], olo[1]); w0.y = cvt_pk_bf16(olo[2], olo[3]); w1.x = cvt_pk_bf16(ohi[0], ohi[1]); w1.y = cvt_pk_bf16(ohi[2], ohi[3]);
                        *(u32x2*)(prow + 16 * n) = w0; *(u32x2*)(prow + 32 + 16 * n) = w1; } }
        } else if (pn < 10) {
            const float osc = (pn == 6 || pn == 7) ? QK_C2 : 1.0f;
#pragma unroll
            for (int ai = 0; ai < 2; ++ai)
#pragma unroll
                for (int m = 0; m < 4; ++m) { bf16_t* prow = P + (size_t)(row0 + ai * HALF + m * 16) * 3072 + cbase;
#pragma unroll
                    for (int bj = 0; bj < 2; ++bj)
#pragma unroll
                        for (int n = 0; n < 2; ++n) { const f32x4 v = acc[ai][bj][m][n] * osc; u32x2 w; w.x = cvt_pk_bf16(v[0], v[1]); w.y = cvt_pk_bf16(v[2], v[3]); *(u32x2*)(prow + 32 * bj + 16 * n) = w; } }
        } else {
            const int hd = 4 * (pn - 10) + wc;
#pragma unroll
            for (int ai = 0; ai < 2; ++ai)
#pragma unroll
                for (int m = 0; m < 4; ++m) { const int row = row0 + ai * HALF + m * 16, b = row >> 12, t = row & 4095;
                    bf16_t* vb = SVT + ((size_t)(b * 8 + hd) * 64 + 4 * fq) * 4096 + t;
#pragma unroll
                    for (int bj = 0; bj < 2; ++bj)
#pragma unroll
                        for (int n = 0; n < 2; ++n) { const f32x4 v = acc[ai][bj][m][n]; const unsigned p0 = cvt_pk_bf16(v[0], v[1]), p1 = cvt_pk_bf16(v[2], v[3]);
                            bf16_t* d = vb + (size_t)(32 * bj + 16 * n) * 4096;
                            d[0] = (bf16_t)(p0 & 0xffffu); d[4096] = (bf16_t)(p0 >> 16); d[2 * 4096] = (bf16_t)(p1 & 0xffffu); d[3 * 4096] = (bf16_t)(p1 >> 16); } }
        }
    }
};

template <class Epi, class Sched, bool ALIGN_EPI = false, bool SP2 = false>
__device__ __forceinline__ void gemm_phase(PG8_LAS unsigned char* lds, const Gemm g, const Sched& S, const Epi& E) {
    int tid_ = threadIdx.x; asm volatile("" : "+v"(tid_));
    const int tid = tid_, wid = __builtin_amdgcn_readfirstlane(tid >> 6), lane = tid & 63, wr = wid >> 2, wc = wid & 3, fr = lane & 15, fq = lane >> 4;
    const int K = g.K, nt = K / BK;
    unsigned voffA[2], voffB[2];
#pragma unroll
    for (int i = 0; i < 2; ++i) { int R, C; stage_rc(tid * 16 + i * 8192, R, C); const int Rb = Epi::PERM ? ((R & ~31) + perm32(R & 31)) : R;
        voffA[i] = (unsigned)(R * K + C) * 2u; voffB[i] = (unsigned)(Rb * K + C) * 2u; }
    const size_t kstep = (size_t)(BK * 2);
    const size_t hstep = (size_t)HALF * K * 2;
    const size_t tstep = 2 * hstep;
    const unsigned ldsw = (unsigned)wid * 1024u;
    const int aoff = lds_byte(wr * 64 + fr, fq * 8), boff = lds_byte(wc * 32 + fr, fq * 8);
#define PG8_SA(b, h) (((b) * 2 + (h)) * HTB)
#define PG8_SB(b, h) ((4 + (b) * 2 + (h)) * HTB)
#define PG8_STAGE(bufoff, gbase, voff) do { _Pragma("unroll") for (int _i = 0; _i < 2; ++_i) \
        __builtin_amdgcn_global_load_lds((const unsigned*)((const char*)(gbase) + (voff)[_i]), (PG8_LAS unsigned*)(lds + (bufoff) + ldsw + _i * 8192), 16, 0, 0); } while (0)
#define PG8_LDA(dst, b, h) do { _Pragma("unroll") for (int m = 0; m < 4; ++m) _Pragma("unroll") for (int k = 0; k < 2; ++k) dst[m][k] = *(const PG8_LAS bf16x8*)(lds + PG8_SA(b, h) + aoff + m * 2048 + k * 1024); } while (0)
#define PG8_LDB(dst, b, h) do { _Pragma("unroll") for (int n = 0; n < 2; ++n) _Pragma("unroll") for (int k = 0; k < 2; ++k) dst[n][k] = *(const PG8_LAS bf16x8*)(lds + PG8_SB(b, h) + boff + n * 2048 + k * 1024); } while (0)
#define PG8_MMA(ai, bj, At, Bt) do { __builtin_amdgcn_s_setprio(1); _Pragma("unroll") for (int m = 0; m < 4; ++m) _Pragma("unroll") for (int n = 0; n < 2; ++n) _Pragma("unroll") for (int k = 0; k < 2; ++k) \
        acc[ai][bj][m][n] = __builtin_amdgcn_mfma_f32_16x16x32_bf16(Bt[n][k], At[m][k], acc[ai][bj][m][n], 0, 0, 0); __builtin_amdgcn_s_setprio(0); } while (0)
#define PG8_WAIT_V(n) asm volatile("s_waitcnt vmcnt(" #n ")" ::: "memory")
#define PG8_WAIT_L(n) asm volatile("s_waitcnt lgkmcnt(" #n ")" ::: "memory")
#define PG8_BAR __builtin_amdgcn_s_barrier()
#define PG8_SCHED __builtin_amdgcn_sched_barrier(0)
    Unit cur, nxt; int ui = 0;
    if (!S.next(0, cur)) return;
    f32x4 acc[2][2][4][2];
#pragma unroll
    for (int a = 0; a < 2; ++a)
#pragma unroll
        for (int b = 0; b < 2; ++b)
#pragma unroll
            for (int m = 0; m < 4; ++m)
#pragma unroll
                for (int n = 0; n < 2; ++n) acc[a][b][m][n] = (f32x4){0.f, 0.f, 0.f, 0.f};
    bf16x8 At[4][2], B0[2][2], B1[2][2];
    const char* cA = (const char*)g.A + (size_t)cur.pm * tstep; const char* cB = (const char*)g.Bt + (size_t)cur.pn * tstep;
    S.a_ready(cur);
    if constexpr (SP2) {
        PG8_STAGE(PG8_SB(0, 0), cB, voffB); PG8_STAGE(PG8_SB(0, 1), cB + hstep, voffB); PG8_STAGE(PG8_SA(0, 0), cA, voffA); PG8_STAGE(PG8_SA(0, 1), cA + hstep, voffA);
        if (wr == 1) PG8_BAR;
        PG8_WAIT_V(2); PG8_BAR;
        PG8_STAGE(PG8_SB(1, 0), cB + kstep, voffB); PG8_STAGE(PG8_SA(1, 0), cA + kstep, voffA); PG8_STAGE(PG8_SB(1, 1), cB + hstep + kstep, voffB);
        PG8_WAIT_V(6); PG8_BAR;
    } else {
        PG8_STAGE(PG8_SB(0, 0), cB, voffB); PG8_STAGE(PG8_SA(0, 0), cA, voffA); PG8_STAGE(PG8_SB(0, 1), cB + hstep, voffB); PG8_STAGE(PG8_SA(0, 1), cA + hstep, voffA);
        if (wr == 1) PG8_BAR;
        PG8_WAIT_V(4); PG8_BAR;
        PG8_STAGE(PG8_SB(1, 0), cB + kstep, voffB); PG8_STAGE(PG8_SA(1, 0), cA + kstep, voffA); PG8_STAGE(PG8_SB(1, 1), cB + hstep + kstep, voffB);
        PG8_WAIT_V(6); PG8_BAR;
    }
    for (;;) {
        const bool has_next = S.next(ui + 1, nxt);
        const char* nA = has_next ? (const char*)g.A + (size_t)nxt.pm * tstep : cA; const char* nB = has_next ? (const char*)g.Bt + (size_t)nxt.pn * tstep : cB;
        for (int t = 0; t < nt; t += 2) {
            const bool last = (t == nt - 2);
            const char* a1 = cA + (size_t)(t + 1) * kstep;
            const char* a2 = last ? nA : cA + (size_t)(t + 2) * kstep; const char* b2 = last ? nB : cB + (size_t)(t + 2) * kstep;
            const char* a3 = a2 + kstep; const char* b3 = b2 + kstep;
            if (last && has_next) S.a_ready(nxt);
            if constexpr (SP2) {
            PG8_LDB(B0, 0, 0); PG8_LDB(B1, 0, 1); PG8_SCHED; PG8_LDA(At, 0, 0); PG8_STAGE(PG8_SA(1, 1), a1 + hstep, voffA);
            PG8_WAIT_V(8); PG8_WAIT_L(0); PG8_BAR; PG8_MMA(0, 0, At, B0); PG8_MMA(0, 1, At, B1); PG8_BAR; PG8_SCHED;
            PG8_LDA(At, 0, 1); PG8_STAGE(PG8_SB(0, 0), b2, voffB); PG8_STAGE(PG8_SB(0, 1), b2 + hstep, voffB); PG8_STAGE(PG8_SA(0, 0), a2, voffA);
            PG8_WAIT_V(8); PG8_WAIT_L(0); PG8_BAR; PG8_MMA(1, 0, At, B0); PG8_MMA(1, 1, At, B1); PG8_BAR; PG8_SCHED;
            PG8_LDB(B0, 1, 0); PG8_LDB(B1, 1, 1); PG8_SCHED; PG8_LDA(At, 1, 0); PG8_STAGE(PG8_SA(0, 1), a2 + hstep, voffA);
            PG8_WAIT_V(8); PG8_WAIT_L(0); PG8_BAR; PG8_MMA(0, 0, At, B0); PG8_MMA(0, 1, At, B1); PG8_BAR; PG8_SCHED;
            PG8_LDA(At, 1, 1); PG8_STAGE(PG8_SB(1, 0), b3, voffB); PG8_STAGE(PG8_SB(1, 1), b3 + hstep, voffB); PG8_STAGE(PG8_SA(1, 0), a3, voffA);
            PG8_WAIT_V(8); PG8_WAIT_L(0); PG8_BAR; PG8_MMA(1, 0, At, B0); PG8_MMA(1, 1, At, B1); PG8_BAR; PG8_SCHED;
            } else {
            PG8_LDB(B0, 0, 0); PG8_SCHED; PG8_LDA(At, 0, 0); PG8_STAGE(PG8_SA(1, 1), a1 + hstep, voffA);
            PG8_WAIT_L(8); PG8_BAR; PG8_WAIT_L(0); PG8_MMA(0, 0, At, B0); PG8_BAR; PG8_SCHED;
            PG8_LDB(B1, 0, 1); PG8_STAGE(PG8_SB(0, 0), b2, voffB);
            PG8_BAR; PG8_WAIT_L(0); PG8_MMA(0, 1, At, B1); PG8_BAR;
            PG8_LDA(At, 0, 1); PG8_STAGE(PG8_SA(0, 0), a2, voffA);
            PG8_BAR; PG8_WAIT_L(0); PG8_MMA(1, 0, At, B0); PG8_BAR; PG8_SCHED;
            PG8_STAGE(PG8_SB(0, 1), b2 + hstep, voffB);
            PG8_WAIT_V(6); PG8_BAR; PG8_MMA(1, 1, At, B1); PG8_BAR;
            PG8_LDB(B0, 1, 0); PG8_SCHED; PG8_LDA(At, 1, 0); PG8_STAGE(PG8_SA(0, 1), a2 + hstep, voffA);
            PG8_WAIT_L(8); PG8_BAR; PG8_WAIT_L(0); PG8_MMA(0, 0, At, B0); PG8_BAR; PG8_SCHED;
            PG8_LDB(B1, 1, 1); PG8_STAGE(PG8_SB(1, 0), b3, voffB);
            PG8_BAR; PG8_WAIT_L(0); PG8_MMA(0, 1, At, B1); PG8_BAR;
            PG8_LDA(At, 1, 1); PG8_STAGE(PG8_SA(1, 0), a3, voffA);
            PG8_BAR; PG8_WAIT_L(0); PG8_MMA(1, 0, At, B0); PG8_BAR; PG8_SCHED;
            PG8_STAGE(PG8_SB(1, 1), b3 + hstep, voffB);
            PG8_WAIT_V(6); PG8_BAR; PG8_MMA(1, 1, At, B1); PG8_BAR;
            }
        }
        if constexpr (ALIGN_EPI) { if (wr == 0) PG8_BAR; }
        if constexpr (!Epi::AFTER_DRAIN) { E(acc, cur, wr, wc, fr, fq); S.done(cur); }
        if (!has_next) break;
#pragma unroll
        for (int a = 0; a < 2; ++a)
#pragma unroll
            for (int b = 0; b < 2; ++b)
#pragma unroll
                for (int m = 0; m < 4; ++m)
#pragma unroll
                    for (int n = 0; n < 2; ++n) acc[a][b][m][n] = (f32x4){0.f, 0.f, 0.f, 0.f};
        cur = nxt; cA = nA; cB = nB; ++ui;
        if constexpr (ALIGN_EPI) { if (wr == 1) PG8_BAR; }
    }
    PG8_WAIT_V(0);
    if constexpr (!ALIGN_EPI) { if (wr == 0) PG8_BAR; }
    PG8_BAR;
    if constexpr (Epi::AFTER_DRAIN) { E.fused(acc, cur, wr, wc, fr, fq, lds, wid, lane); S.done(cur); }
#undef PG8_SA
#undef PG8_SB
#undef PG8_STAGE
#undef PG8_LDA
#undef PG8_LDB
#undef PG8_MMA
#undef PG8_WAIT_V
#undef PG8_WAIT_L
#undef PG8_BAR
#undef PG8_SCHED
}
}

#ifndef PG8_SP2
#define PG8_SP2 true
#endif
#ifndef PG8_ALIGN
#define PG8_ALIGN true
#endif
namespace attn_body {
using bf16=__hip_bfloat16;
using bf16x8=__attribute__((ext_vector_type(8)))short;
using s16x4=__attribute__((ext_vector_type(4)))short;
using f32x16=__attribute__((ext_vector_type(16)))float;
using u32x4=__attribute__((ext_vector_type(4)))unsigned;
constexpr int BATCH=4,NHEAD=8,SEQ=4096,D=64,DV=128,PIN=3072,POUT=1024;
constexpr int NW=8,QBLK=32,QB=QBLK*NW,KVBLK=64,NQB=SEQ/QB;
constexpr int ATTN_UNIT_ROWS=QB;
__device__ __forceinline__ int crow(int r,int hi){return (r&3)+8*(r>>2)+4*hi;}
#define SBAR() __builtin_amdgcn_sched_barrier(0)
__device__ __forceinline__ void cmask(f32x16&p0,f32x16&p1,int jb,int qrel,int hi){
  const float NEG=-INFINITY; int kb=64*jb+4*hi;
  #pragma unroll
  for(int r=0;r<16;++r){int kv=kb+(r&3)+8*(r>>2); if(kv>qrel)p0[r]=NEG; if(kv+32>qrel)p1[r]=NEG;}
}

constexpr int NSLOT=3, SLOTB=8192;
constexpr int LDS_K=0, LDS_V=NSLOT*SLOTB, LDS_WS=3*NSLOT*SLOTB, LDS_OST=LDS_WS+NW*64*4, LDS_BYTES=LDS_OST+NW*8192;
constexpr float C2=0.125f*1.4426950408889634f;
__device__ __forceinline__ void glds16(const void*gsrc,unsigned lds_dst){unsigned keep;
  asm volatile("s_mov_b32 %0, m0\n\ts_mov_b32 m0, %2\n\ts_nop 0\n\tglobal_load_lds_dwordx4 %1, off\n\ts_mov_b32 m0, %0":"=&s"(keep):"v"(gsrc),"s"(lds_dst):"memory");}
__device__ __forceinline__ float max3f(float a,float b,float c){float r;asm("v_max3_f32 %0, %1, %2, %3":"=v"(r):"v"(a),"v"(b),"v"(c));return r;}
__device__ __forceinline__ float max2f(float a,float b){float r;asm("v_max_f32_e32 %0, %1, %2":"=v"(r):"v"(a),"v"(b));return r;}
__device__ __forceinline__ float fadd_s(float a,float b){float r;asm("v_add_f32_e32 %0, %1, %2":"=v"(r):"v"(a),"v"(b));return r;}
__device__ __forceinline__ float fsub_s(float a,float b){float r;asm("v_sub_f32_e32 %0, %1, %2":"=v"(r):"v"(a),"v"(b));return r;}
typedef float f32x2_t __attribute__((ext_vector_type(2))); typedef __bf16 bf16x2_t __attribute__((ext_vector_type(2)));
__device__ __forceinline__ unsigned cvtpk_s(float lo,float hi){f32x2_t v={lo,hi};bf16x2_t b=__builtin_convertvector(v,bf16x2_t);return __builtin_bit_cast(unsigned,b);}
#define WAIT_BAR(N) asm volatile("s_waitcnt vmcnt(" #N ") lgkmcnt(0)\n\ts_barrier":::"memory")

__device__ __forceinline__ void qkt(f32x16&p0,f32x16&p1,const char*Kslot,const bf16x8*qr,const f32x16&negm,int r32,int hi){
  const char*kb=Kslot+hi*1024+r32*16;
  #pragma unroll
  for(int d0=0;d0<4;++d0){
    const bf16x8 b0=*reinterpret_cast<const bf16x8*>(kb+d0*2048);
    const bf16x8 b1=*reinterpret_cast<const bf16x8*>(kb+d0*2048+512);
    if(d0==0){p0=__builtin_amdgcn_mfma_f32_32x32x16_bf16(b0,qr[0],negm,0,0,0);p1=__builtin_amdgcn_mfma_f32_32x32x16_bf16(b1,qr[0],negm,0,0,0);}
    else{p0=__builtin_amdgcn_mfma_f32_32x32x16_bf16(b0,qr[d0],p0,0,0,0);p1=__builtin_amdgcn_mfma_f32_32x32x16_bf16(b1,qr[d0],p1,0,0,0);}}
}
typedef __attribute__((address_space(3))) const char* lds_cptr;
typedef short v4i16_t __attribute__((ext_vector_type(4)));
__device__ __forceinline__ void kload8(bf16x8*kf,lds_cptr kp){
  kf[0]=*(const __attribute__((address_space(3))) bf16x8*)(kp);      kf[1]=*(const __attribute__((address_space(3))) bf16x8*)(kp+512);
  kf[2]=*(const __attribute__((address_space(3))) bf16x8*)(kp+2048); kf[3]=*(const __attribute__((address_space(3))) bf16x8*)(kp+2560);
  kf[4]=*(const __attribute__((address_space(3))) bf16x8*)(kp+4096); kf[5]=*(const __attribute__((address_space(3))) bf16x8*)(kp+4608);
  kf[6]=*(const __attribute__((address_space(3))) bf16x8*)(kp+6144); kf[7]=*(const __attribute__((address_space(3))) bf16x8*)(kp+6656);
}
__device__ __forceinline__ void kload2(bf16x8*kf,lds_cptr kp,int j){ kf[2*j]=*(const __attribute__((address_space(3))) bf16x8*)(kp+j*2048); kf[2*j+1]=*(const __attribute__((address_space(3))) bf16x8*)(kp+j*2048+512); }
__device__ __forceinline__ s16x4 vtr(lds_cptr p){ return __builtin_bit_cast(s16x4,__builtin_amdgcn_ds_read_tr16_b64_v4i16((__attribute__((address_space(3))) v4i16_t*)p)); }
__device__ __forceinline__ float rowmax(const f32x16&p0,const f32x16&p1){
  float a=max3f(p0[0],p0[1],p1[0]),b=max3f(p0[2],p0[3],p1[1]);a=max3f(a,p1[2],p1[3]);
  #pragma unroll
  for(int r=4;r<16;r+=4){a=max3f(a,p0[r],p0[r+1]);b=max3f(b,p0[r+2],p0[r+3]);a=max3f(a,p1[r],p1[r+1]);b=max3f(b,p1[r+2],p1[r+3]);}
  const float m=max2f(a,b);
  auto rr=__builtin_amdgcn_permlane32_swap(__float_as_uint(m),__float_as_uint(m),false,false);
  return max2f(__uint_as_float(rr[0]),__uint_as_float(rr[1]));
}
__device__ __forceinline__ void pv(f32x16*o,int vb,bf16x8 pa0,bf16x8 pa1,bf16x8 pa2,bf16x8 pa3){
  #pragma unroll
  for(int d0=0;d0<4;++d0){s16x4 lo[4],hi[4];
    #pragma unroll
    for(int ks=0;ks<4;++ks){
      asm volatile("ds_read_b64_tr_b16 %0,%1 offset:%c2":"=&v"(lo[ks]):"v"(vb),"i"(d0*4096+ks*1024):"memory");
      asm volatile("ds_read_b64_tr_b16 %0,%1 offset:%c2":"=&v"(hi[ks]):"v"(vb),"i"(d0*4096+ks*1024+512):"memory");}
    asm volatile("s_waitcnt lgkmcnt(0)":::"memory");SBAR();
    #define PK(k) (bf16x8){lo[k][0],lo[k][1],lo[k][2],lo[k][3],hi[k][0],hi[k][1],hi[k][2],hi[k][3]}
    o[d0]=__builtin_amdgcn_mfma_f32_32x32x16_bf16(pa0,PK(0),o[d0],0,0,0);
    o[d0]=__builtin_amdgcn_mfma_f32_32x32x16_bf16(pa1,PK(1),o[d0],0,0,0);
    o[d0]=__builtin_amdgcn_mfma_f32_32x32x16_bf16(pa2,PK(2),o[d0],0,0,0);
    o[d0]=__builtin_amdgcn_mfma_f32_32x32x16_bf16(pa3,PK(3),o[d0],0,0,0);
    #undef PK
  }
}

#ifndef ATTN_STORE16
#define ATTN_STORE16(p,v) (*(u32x4*)(p)=(v))
#endif
template<int THRL> __device__ __forceinline__ void attn_unit(int b,int vh,int qb,const bf16*P,bf16*O,char*shm){
  int tid_=threadIdx.x; asm volatile("":"+v"(tid_)); const int tid=tid_,lane=tid&63,r32=lane&31,hi=lane>>5; const int wid=__builtin_amdgcn_readfirstlane(tid>>6);
  const long rowbase=(long)b*SEQ; const int q0=qb*QB;
  const bf16*Qw=P+(rowbase+q0+wid*QBLK)*PIN+vh*D;
  const bf16*Kh=P+rowbase*PIN+512+vh*D,*Vh=P+rowbase*PIN+1024+(vh>>1)*DV;
  const unsigned lds0=(unsigned)(uintptr_t)shm;
  float*wsf=(float*)(shm+LDS_WS)+wid*64;
  const bf16*ksrc=Kh+(long)lane*PIN+wid*8;
  const bf16*vsrc=Vh+(long)(16*(wid&3)+(lane>>2))*PIN+(wid>>2)*32+(lane&3)*8;
  const unsigned kdst=lds0+LDS_K+wid*1024, vdst=lds0+LDS_V+wid*1024;
  #define DMA_K(t,slot) glds16(ksrc+(long)(t)*KVBLK*PIN,(unsigned)__builtin_amdgcn_readfirstlane(kdst+(slot)))
  #define DMA_V(t,slot) do{ glds16(vsrc+(long)(t)*KVBLK*PIN,(unsigned)__builtin_amdgcn_readfirstlane(vdst+2*(slot))); glds16(vsrc+(long)(t)*KVBLK*PIN+64,(unsigned)__builtin_amdgcn_readfirstlane(vdst+2*(slot)+8192)); }while(0)
  const int vb0=(int)(lds0+LDS_V)+((lane>>4)&1)*32+(lane&3)*8+(4*hi+((lane&15)>>2))*64;
  const char*Kbase=shm+LDS_K; bf16x8 kf[8];
  const lds_cptr shm3=(lds_cptr)shm; const lds_cptr kp0=shm3+LDS_K+hi*1024+r32*16; const lds_cptr vp0=shm3+LDS_V+((lane>>4)&1)*32+(lane&3)*8+(4*hi+((lane&15)>>2))*64;
  const int NT=(q0+QB)/KVBLK;
  DMA_K(0,0);DMA_V(0,0);DMA_K(1,SLOTB);
  bf16x8 qr[4];
  #pragma unroll
  for(int d0=0;d0<4;++d0)qr[d0]=*reinterpret_cast<const bf16x8*>(&Qw[(long)r32*PIN+d0*16+hi*8]);
  float mhat=0.f,l_reg=0.f;f32x16 o[4];o[0]=f32x16{};o[1]=f32x16{};o[2]=f32x16{};o[3]=f32x16{};f32x16 negm;{float nz_=0.f;asm volatile("":"+v"(nz_));_Pragma("unroll") for(int r=0;r<16;++r)negm[r]=nz_;}asm volatile("":"+v"(negm));
  const int qrel=wid*QBLK+r32;
  #define CMASK(P0,P1,t) do{int jb_=(t)-(NT-4); if(jb_>=0)cmask(P0,P1,jb_,qrel,hi);}while(0)
  bool resc=false;
  #define START(P0,P1) do{ const float rm=rowmax(P0,P1); resc=false; \
    { const float dl=rm; mhat=fadd_s(mhat,dl); \
      _Pragma("unroll") for(int r=0;r<16;++r){P0[r]=fsub_s(P0[r],dl);P1[r]=fsub_s(P1[r],dl);} \
      _Pragma("unroll") for(int r=0;r<16;++r)negm[r]=-mhat; asm volatile("":"+v"(negm)); } \
    _Pragma("unroll") for(int r=0;r<16;++r)P0[r]=__builtin_amdgcn_exp2f(P0[r]); }while(0)
  #define RESC() do{ if(resc){ asm volatile("s_waitcnt lgkmcnt(0)":::"memory"); \
      _Pragma("unroll") for(int d_=0;d_<4;++d_) _Pragma("unroll") for(int r=0;r<16;++r)o[d_][r]*=wsf[crow(r,hi)]; } }while(0)
  f32x16 pA0,pA1,pB0,pB1;
  int sl_prev=0,sl_cur=0,sl_next=SLOTB;
  #define ROT() do{sl_prev=sl_cur;sl_cur=sl_next;sl_next=(sl_next==(NSLOT-1)*SLOTB)?0:sl_next+SLOTB;}while(0)
  DMA_K(2,2*SLOTB);
  WAIT_BAR(3);
  qkt(pA0,pA1,Kbase,qr,negm,r32,hi);asm volatile("s_nop 15\n\ts_nop 7":"+v"(pA0),"+v"(pA1));CMASK(pA0,pA1,0);
  START(pA0,pA1);
  _Pragma("unroll") for(int r=0;r<16;++r)pA1[r]=__builtin_amdgcn_exp2f(pA1[r]);
  WAIT_BAR(0);
  DMA_K(3,0);DMA_V(1,SLOTB);
  ROT();
  kload8(kf,kp0+sl_cur);
  WAIT_BAR(3);
  s16x4 vlo[4],vhi[4]; u32x4 pw0,pw1,pw2,pw3;
  #define PKW(P,B) cvtpk_s(P[B],P[B+1])
  #define PAF(k) __builtin_bit_cast(bf16x8,pw##k)
  #define VFR(i) (bf16x8){vlo[i][0],vlo[i][1],vlo[i][2],vlo[i][3],vhi[i][0],vhi[i][1],vhi[i][2],vhi[i][3]}
  #define PIN(x) asm volatile("":"+v"(x))
  #define MX3(a,b,c) __builtin_fmaxf(__builtin_fmaxf((a),(b)),(c))
  #define GAPA(MF,A0,A1,A2,A3,W0,W1,PW) do{ MF; sacc+=A0; sacc+=A1; sacc+=A2; sacc+=A3; PIN(sacc); W0; W1; PIN(PW); SBAR(); }while(0)
  #define EX(v) __builtin_amdgcn_exp2f(v)
  #define VRD(dq,ks) do{ vlo[dq]=vtr(vp_+((dq)*4096+(ks)*1024)); vhi[dq]=vtr(vp_+((dq)*4096+(ks)*1024+512)); }while(0)
  #define GAPB(DQ,KS,X,B) do{ o[DQ]=__builtin_amdgcn_mfma_f32_32x32x16_bf16(PAF(KS),VFR(DQ),o[DQ],0,0,0); if((KS)<3){ VRD(DQ,(KS)+1); } X[B]=EX(X[B]); X[B+1]=EX(X[B+1]); PIN(X); SBAR(); }while(0)
  #define KRD(G,j) do{ if(G){ kload2(kf,kp0+sl_next,j); SBAR(); } }while(0)
  #define STEP(C0,C1,P0,P1,t,GK,GV,GL) do{ SBAR(); \
    const lds_cptr vp_=vp0+2*sl_prev; \
    float sacc=(P0[0]+P0[1]); \
    GAPA(C0=__builtin_amdgcn_mfma_f32_32x32x16_bf16(kf[0],qr[0],negm,0,0,0), P0[2],P0[3],P0[4],P0[5],     pw0[0]=PKW(P0,0), pw0[1]=PKW(P0,2), pw0); \
    GAPA(C1=__builtin_amdgcn_mfma_f32_32x32x16_bf16(kf[1],qr[0],negm,0,0,0), P0[6],P0[7],P0[8],P0[9],     pw0[2]=PKW(P0,4), pw0[3]=PKW(P0,6), pw0); \
    GAPA(C0=__builtin_amdgcn_mfma_f32_32x32x16_bf16(kf[2],qr[1],C0,0,0,0),   P0[10],P0[11],P0[12],P0[13], pw1[0]=PKW(P0,8), pw1[1]=PKW(P0,10), pw1); \
    GAPA(C1=__builtin_amdgcn_mfma_f32_32x32x16_bf16(kf[3],qr[1],C1,0,0,0),   P0[14],P0[15],P1[0],P1[1],   pw1[2]=PKW(P0,12),pw1[3]=PKW(P0,14), pw1); \
    VRD(0,0); SBAR(); GAPA(C0=__builtin_amdgcn_mfma_f32_32x32x16_bf16(kf[4],qr[2],C0,0,0,0),   P1[2],P1[3],P1[4],P1[5],     pw2[0]=PKW(P1,0), pw2[1]=PKW(P1,2), pw2); \
    VRD(1,0); SBAR(); GAPA(C1=__builtin_amdgcn_mfma_f32_32x32x16_bf16(kf[5],qr[2],C1,0,0,0),   P1[6],P1[7],P1[8],P1[9],     pw2[2]=PKW(P1,4), pw2[3]=PKW(P1,6), pw2); \
    VRD(2,0); SBAR(); GAPA(C0=__builtin_amdgcn_mfma_f32_32x32x16_bf16(kf[6],qr[3],C0,0,0,0),   P1[10],P1[11],P1[12],P1[13], pw3[0]=PKW(P1,8), pw3[1]=PKW(P1,10), pw3); \
    VRD(3,0); SBAR(); GAPA(C1=__builtin_amdgcn_mfma_f32_32x32x16_bf16(kf[7],qr[3],C1,0,0,0),   P1[14],P1[15],0.f,0.f,       pw3[2]=PKW(P1,12),pw3[3]=PKW(P1,14), pw3); \
    l_reg+=sacc; \
    if(GK){DMA_K((t)+3,sl_cur);} if(GV){DMA_V((t)+1,sl_next);} \
    CMASK(C0,C1,t); \
    { float a=MX3(C0[0],C0[1],C1[0]),b=MX3(C0[2],C0[3],C1[1]); a=MX3(a,C1[2],C1[3]); \
      _Pragma("unroll") for(int r=4;r<16;r+=4){a=MX3(a,C0[r],C0[r+1]);b=MX3(b,C0[r+2],C0[r+3]);a=MX3(a,C1[r],C1[r+1]);b=MX3(b,C1[r+2],C1[r+3]);} \
      float rm=__builtin_fmaxf(a,b); { auto rr=__builtin_amdgcn_permlane32_swap(__float_as_uint(rm),__float_as_uint(rm),false,false); rm=__builtin_fmaxf(__uint_as_float(rr[0]),__uint_as_float(rr[1])); } \
      resc=false; \
      if(__builtin_expect(__any(rm>(float)THRL),0)){ const float dl=__builtin_fmaxf(rm,0.f); mhat+=dl; \
        _Pragma("unroll") for(int r=0;r<16;++r){C0[r]-=dl;C1[r]-=dl;} \
        _Pragma("unroll") for(int r=0;r<16;++r)negm[r]=-mhat; asm volatile("":"+v"(negm)); \
        const float f=__builtin_amdgcn_exp2f(-dl); l_reg*=f; if(hi==0)wsf[r32]=f; resc=true; } } \
    SBAR(); \
    GAPB(0,0,C0,0);  GAPB(1,0,C0,2);  GAPB(2,0,C0,4);  GAPB(3,0,C0,6); \
    KRD(GL,0); GAPB(0,1,C0,8);  GAPB(1,1,C0,10); KRD(GL,1); GAPB(2,1,C0,12); GAPB(3,1,C0,14); \
    KRD(GL,2); GAPB(0,2,C1,0);  GAPB(1,2,C1,2);  KRD(GL,3); GAPB(2,2,C1,4);  GAPB(3,2,C1,6); \
    GAPB(0,3,C1,8);  GAPB(1,3,C1,10); GAPB(2,3,C1,12); GAPB(3,3,C1,14); \
    }while(0)
  int t=1;
  #undef CMASK
  #define CMASK(P0,P1,t) do{}while(0)
  for(;t+5<NT;t+=2){
    STEP(pB0,pB1,pA0,pA1,t,true,true,true);     WAIT_BAR(3); RESC(); ROT();
    STEP(pA0,pA1,pB0,pB1,t+1,true,true,true);   WAIT_BAR(3); RESC(); ROT();
  }
  #undef CMASK
  #define CMASK(P0,P1,t) do{int jb_=(t)-(NT-4); if(jb_>=0)cmask(P0,P1,jb_,qrel,hi);}while(0)
  #define ENDW(tt) do{ if((tt)+3<NT){WAIT_BAR(3);} else if((tt)+2<NT){WAIT_BAR(2);} else {WAIT_BAR(0);} }while(0)
  for(;t+1<NT;t+=2){
    STEP(pB0,pB1,pA0,pA1,t,(t+3<NT),(t+1<NT),(t+1<NT));       ENDW(t);   RESC(); ROT();
    STEP(pA0,pA1,pB0,pB1,t+1,(t+4<NT),(t+2<NT),(t+2<NT));     ENDW(t+1); RESC(); ROT();
  }
  STEP(pB0,pB1,pA0,pA1,NT-1,false,false,false); RESC();
  { float sacc=pB0[0]+pB0[1]; _Pragma("unroll") for(int r=2;r<16;++r)sacc+=pB0[r]; _Pragma("unroll") for(int r=0;r<16;++r)sacc+=pB1[r]; l_reg+=sacc;
    pw0=(u32x4){PKW(pB0,0),PKW(pB0,2),PKW(pB0,4),PKW(pB0,6)};pw1=(u32x4){PKW(pB0,8),PKW(pB0,10),PKW(pB0,12),PKW(pB0,14)};pw2=(u32x4){PKW(pB1,0),PKW(pB1,2),PKW(pB1,4),PKW(pB1,6)};pw3=(u32x4){PKW(pB1,8),PKW(pB1,10),PKW(pB1,12),PKW(pB1,14)};
    SBAR(); pv(o,vb0+2*sl_cur,PAF(0),PAF(1),PAF(2),PAF(3)); }
  #undef PKW
  #undef PAF
  #undef VFR
  #undef PIN
  #undef MX3
  #undef GAPA
  #undef GAPB
  #undef EX
  #undef VRD
  #undef KRD
  #undef STEP
  #undef ENDW
  {auto rr=__builtin_amdgcn_permlane32_swap(__float_as_uint(l_reg),__float_as_uint(l_reg),false,false);l_reg=__uint_as_float(rr[0])+__uint_as_float(rr[1]);}
  if(hi==0)wsf[32+r32]=l_reg;asm volatile("s_waitcnt lgkmcnt(0)":::"memory");
  float rli[16];
  #pragma unroll
  for(int r=0;r<16;++r)rli[r]=__builtin_amdgcn_rcpf(wsf[32+crow(r,hi)]);
  bf16*Ow=O+(rowbase+q0+wid*QBLK)*POUT+vh*DV;
  { bf16*stg=(bf16*)(shm+LDS_OST)+wid*4096;
    #pragma unroll
    for(int r=0;r<16;++r){const int orow=crow(r,hi);
      #pragma unroll
      for(int d0=0;d0<4;++d0)stg[orow*128+d0*32+r32]=__float2bfloat16(o[d0][r]*rli[r]);}
    asm volatile("s_waitcnt lgkmcnt(0)":::"memory");
    #pragma unroll
    for(int i=0;i<8;++i){const int row=i*4+(lane>>4),ch=lane&15; const u32x4 v=*(const u32x4*)(stg+row*128+ch*8); ATTN_STORE16(Ow+(long)row*POUT+ch*8,v);} }
  asm volatile("s_waitcnt lgkmcnt(0)\n\ts_barrier":::"memory");
  #undef DMA_K
  #undef DMA_V
  #undef CMASK
  #undef START
  #undef RESC
  #undef ROT
}
constexpr int ATTN_LDS_BYTES=LDS_BYTES;
struct AttnUnit { int bh; int qb; };
struct StaticOrder {
  int vcu;
  __device__ __forceinline__ explicit StaticOrder(int grid,int block):vcu((block%8)*(grid/8)+block/8){}
  __device__ __forceinline__ bool next(int i,AttnUnit&u)const{ if(i>=2)return false; const int s=vcu&7; u.bh=vcu>>3; u.qb=(i==0)?15-s:s; return true; }
};
template<class Sched,int THRL=8> __device__ __forceinline__ void attn_phase(char*lds,const bf16*P,bf16*O,const Sched&S){
  AttnUnit u;
  for(int i=0;S.next(i,u);++i){ attn_unit<THRL>(u.bh/NHEAD,u.bh%NHEAD,u.qb,P,O,lds); }
}
#undef SBAR
#undef WAIT_BAR
}
constexpr int NWAVES = 8;
constexpr int NB = 4, SEQ = 4096, D = 1024, T = NB * SEQ, NPROJ = 3072, NE = 256, FF = 256, KSEL = 8, NSLOT9 = 9;
constexpr float NORM_EPS = 1e-6f;
constexpr size_t MiB = 1u << 20;
constexpr size_t WS_CTL = 0, CTL_ZERO_BYTES = 65536;
constexpr size_t WS_MOD = 1 * MiB;
constexpr size_t WS_COS = 2 * MiB, WS_SIN = 4 * MiB;
constexpr size_t WS_WIN = 6 * MiB, WS_WOUT = 12 * MiB, WS_WR = 14 * MiB;
constexpr size_t WS_XN = 16 * MiB;
constexpr size_t WS_PROJ = 48 * MiB;
constexpr size_t WS_SVT = 144 * MiB;
constexpr size_t WS_ORAW = 160 * MiB;
constexpr size_t WS_MIXED = 192 * MiB;
constexpr size_t WS_R = 224 * MiB;
constexpr size_t WS_LTOK = 304 * MiB, WS_LW = 321 * MiB;
constexpr size_t WS_H2 = 338 * MiB;
constexpr size_t WS_ACT = 372 * MiB;
constexpr size_t WS_Y = 416 * MiB;
constexpr size_t WS_END = WS_Y + (size_t)T * NSLOT9 * D * 2;
constexpr int CW_QUEUE = 8192;
constexpr int CW_COUNT = 1024;
constexpr int CW_BAR = 4096;
constexpr int RING_OFF = 0, RING_BYTES = 151552;
constexpr int LDSCTL_OFF = RING_BYTES, MISC_OFF = LDSCTL_OFF + 320;
constexpr int LDS_BYTES = 152576;
static_assert(MISC_OFF + 128 <= LDS_BYTES, "LDS map");

#define GAS __attribute__((address_space(1)))
#define LAS __attribute__((address_space(3)))
typedef unsigned short bf16;
typedef unsigned v4u __attribute__((ext_vector_type(4)));
typedef unsigned v2u __attribute__((ext_vector_type(2)));
typedef float f32x4 __attribute__((ext_vector_type(4)));
typedef float f32x16 __attribute__((ext_vector_type(16)));
typedef short bf16x8 __attribute__((ext_vector_type(8)));
typedef GAS unsigned gu32;
#define RLX_AGENT __ATOMIC_RELAXED, __HIP_MEMORY_SCOPE_AGENT
#define LDS_WAIT() asm volatile("s_waitcnt lgkmcnt(0)" ::: "memory")
#define VM_WAIT() asm volatile("s_waitcnt vmcnt(0)" ::: "memory")
__device__ __forceinline__ unsigned pk2(float lo, float hi) { return pg8::cvt_pk_bf16(lo, hi); }
__device__ __forceinline__ float bflo(unsigned w) { return __uint_as_float(w << 16); }
__device__ __forceinline__ float bfhi(unsigned w) { return __uint_as_float(w & 0xffff0000u); }

#define XB_TMO      128
#define XB_XCNT(j)  (256  + 64 * (j))
#define XB_XSUB(j)  (1280 + 64 * (j))
#define XB_XGEN(j)  (2304 + 64 * (j))
#define XB_TOP      3328
#define XB_TOPGEN   3392
#define XCD_BAR_WORDS 3456
#define XB_SPIN_CAP (1u << 18)

__device__ __forceinline__ unsigned xb_ld(unsigned* p)              { return __hip_atomic_load(p, __ATOMIC_RELAXED, __HIP_MEMORY_SCOPE_AGENT); }
__device__ __forceinline__ unsigned xb_add(unsigned* p, unsigned v) { return __hip_atomic_fetch_add(p, v, __ATOMIC_RELAXED, __HIP_MEMORY_SCOPE_AGENT); }
__device__ __forceinline__ unsigned xb_xcc_id() { return (unsigned)__builtin_amdgcn_s_getreg((3 << 11) | 20) & 0xFu; }
#define XB_SPIN(cond, bar) do { unsigned _sp = 0; while (cond) { __builtin_amdgcn_s_sleep(1); \
    if ((++_sp & 255u) == 0u) { if (xb_ld(&(bar)[XB_TMO])) break; if (_sp > XB_SPIN_CAP) { atomicAdd(&(bar)[XB_TMO], 1u); break; } } } } while (0)

struct XcdBarrier {
    unsigned* bar; unsigned x;
    volatile LAS unsigned* st;
};

__device__ __forceinline__ XcdBarrier xcd_barrier_post(unsigned* bar, volatile LAS unsigned* st) {
    XcdBarrier b; b.bar = bar; b.x = xb_xcc_id(); b.st = st;
    if (threadIdx.x == 0) (void)xb_add(&bar[XB_XCNT(b.x)], 1u);
    return b;
}
__device__ __forceinline__ void xcd_barrier_complete(unsigned* bar, unsigned x, unsigned& nloc, unsigned& nx) {
    const unsigned G = gridDim.x * gridDim.y * gridDim.z;
    unsigned sum, cnt, mine, sp = 0u;
    for (;;) {
        sum = 0u; cnt = 0u; mine = 0u;
#pragma unroll
        for (unsigned j = 0; j < 16; ++j) { const unsigned c = xb_ld(&bar[XB_XCNT(j)]); sum += c; cnt += (c > 0u) ? 1u : 0u; mine = (j == x) ? c : mine; }
        if (sum == G) break;
        __builtin_amdgcn_s_sleep(1);
        if ((++sp & 255u) == 0u) { if (xb_ld(&bar[XB_TMO])) break; if (sp > XB_SPIN_CAP) { atomicAdd(&bar[XB_TMO], 1u); break; } }
    }
    nloc = mine > 0u ? mine : 1u; nx = cnt > 0u ? cnt : 1u;
}

__device__ __forceinline__ void xcd_barrier(const XcdBarrier& b) {
    asm volatile("s_waitcnt vmcnt(0)" ::: "memory");
    __syncthreads();
    if (threadIdx.x == 0) {
        unsigned* bar = b.bar;
        __builtin_amdgcn_s_waitcnt(0);
        unsigned nloc = b.st[0], nx = b.st[1];
        if (nloc == 0u) { xcd_barrier_complete(bar, b.x, nloc, nx); b.st[0] = nloc; b.st[1] = nx; }
        const unsigned old = xb_add(&bar[XB_XSUB(b.x)], 1u);
        const unsigned gen = old / nloc;
        if (old + 1u == (gen + 1u) * nloc) {
            __builtin_amdgcn_fence(__ATOMIC_RELEASE, "agent");
            asm volatile("s_waitcnt vmcnt(0)" ::: "memory");
            const unsigned og = xb_add(&bar[XB_TOP], 1u);
            const unsigned tg = og / nx;
            if (og + 1u == (tg + 1u) * nx) xb_add(&bar[XB_TOPGEN], 1u);
            else XB_SPIN(xb_ld(&bar[XB_TOPGEN]) == tg, bar);
            __builtin_amdgcn_fence(__ATOMIC_ACQUIRE, "agent");
            xb_add(&bar[XB_XGEN(b.x)], 1u);
            asm volatile("s_waitcnt vmcnt(0)" ::: "memory");
        } else {
            XB_SPIN(xb_ld(&bar[XB_XGEN(b.x)]) == gen, bar);
            __builtin_amdgcn_fence(__ATOMIC_ACQUIRE, "agent");
            asm volatile("s_waitcnt vmcnt(0)" ::: "memory");
        }
    }
    __syncthreads();
}


struct Frame {
    LAS unsigned char* lds;
    volatile LAS unsigned* MISC;
    unsigned* ctl;
    int tid, lane, wave;
    int vcu, G;
    const float *x, *c, *w_ada, *b_ada, *g_mix, *w_in, *g_q, *g_k, *lam, *g_sub, *w_out, *g_ffn, *w_router, *e_bias, *w_sh_gu, *w_sh_down, *w_gu, *w_down;
    const int* positions;
    float* out;
    float *MOD, *RCOS, *RSIN, *LW;
    bf16 *WIN, *WOUT, *WR, *XN, *PROJ, *SVT, *ORAW, *MIXED, *H2, *Y, *ACT, *DLT;
    unsigned* LTOK;
};
__device__ __forceinline__ float wave_sum(float v) {
#pragma unroll
    for (int o = 1; o < 64; o <<= 1) v += __shfl_xor(v, o);
    return v;
}
__device__ __forceinline__ float wave_max(float v) {
#pragma unroll
    for (int o = 1; o < 64; o <<= 1) v = fmaxf(v, __shfl_xor(v, o));
    return v;
}
__device__ __forceinline__ void p0_transpose_item(const float* W, int K, int N, bf16* WT, int k0, int n0, int dst_row0, LAS float* scr, int lane) {
#pragma unroll 8
    for (int i = 0; i < 32; ++i) { const int kk = 2 * i + (lane >> 5); scr[kk * 33 + (lane & 31)] = W[(size_t)(k0 + kk) * N + n0 + (lane & 31)]; }
    LDS_WAIT(); asm volatile("" ::: "memory");
    const int c = lane & 7;
#pragma unroll
    for (int j = 0; j < 4; ++j) { const int n = (lane >> 3) + 8 * j; const LAS float* s = scr + (8 * c) * 33 + n;
        v4u o; o.x = pk2(s[0 * 33], s[1 * 33]); o.y = pk2(s[2 * 33], s[3 * 33]); o.z = pk2(s[4 * 33], s[5 * 33]); o.w = pk2(s[6 * 33], s[7 * 33]);
        *(GAS v4u*)(WT + (size_t)(dst_row0 + n) * K + k0 + 8 * c) = o; }
    LDS_WAIT(); asm volatile("" ::: "memory");
}
__device__ __forceinline__ void p0_prologue(Frame& F) {
    LAS float* sc = (LAS float*)(F.lds + RING_OFF);
    LAS float* red = (LAS float*)(F.lds + RING_OFF + 16384);
    if (F.vcu < 192) {
        for (int i = F.tid; i < NB * D; i += NWAVES * 64) { const float v = F.c[i]; sc[i] = v / (1.0f + __expf(-v)); }
        __syncthreads();
        const int kr = F.lane >> 3, ch = F.lane & 7, n0 = 32 * F.vcu + 4 * ch;
        float a[4][4];
#pragma unroll
        for (int b = 0; b < 4; ++b)
#pragma unroll
            for (int j = 0; j < 4; ++j) a[b][j] = 0.f;
#pragma unroll 4
        for (int it = 0; it < 16; ++it) { const int k = 128 * F.wave + 8 * it + kr; const f32x4 wv = *(const f32x4*)(F.w_ada + (size_t)k * 6144 + n0);
#pragma unroll
            for (int b = 0; b < 4; ++b) { const float s = sc[b * D + k];
#pragma unroll
                for (int j = 0; j < 4; ++j) a[b][j] += s * wv[j]; } }
#pragma unroll
        for (int b = 0; b < 4; ++b)
#pragma unroll
            for (int j = 0; j < 4; ++j) { float v = a[b][j]; v += __shfl_xor(v, 8); v += __shfl_xor(v, 16); v += __shfl_xor(v, 32); a[b][j] = v; }
        if (kr == 0) {
#pragma unroll
            for (int b = 0; b < 4; ++b)
#pragma unroll
                for (int j = 0; j < 4; ++j) red[(F.wave * 4 + b) * 32 + 4 * ch + j] = a[b][j]; }
        __syncthreads();
        if (F.tid < 128) { const int b = F.tid >> 5, col = F.tid & 31; float s = F.b_ada[32 * F.vcu + col];
#pragma unroll
            for (int w = 0; w < 8; ++w) s += red[(w * 4 + b) * 32 + col];
            F.MOD[b * 6144 + 32 * F.vcu + col] = s; }
        __syncthreads();
    }
    LAS float* scr = (LAS float*)(F.lds + RING_OFF + 32768 + F.wave * 9216);
    const int gw = F.vcu * NWAVES + F.wave, NGW = F.G * NWAVES;
    constexpr int I_IN = (D / 64) * (NPROJ / 32), I_OUT = (D / 64) * (D / 32), I_R = (D / 64) * (NE / 32);
    for (int it = gw; it < I_IN + I_OUT + I_R; it += NGW) {
        int r = it;
        if (r < I_IN) { const int nblk = NPROJ / 32, kb = r / nblk, nb = r % nblk, n0 = 32 * nb;
            const int cl = n0 & 255, dst = (n0 & ~255) + 128 * ((cl >> 5) & 1) + 32 * (cl >> 6);
            p0_transpose_item(F.w_in, D, NPROJ, F.WIN, 64 * kb, n0, dst, scr, F.lane); continue; }
        r -= I_IN;
        if (r < I_OUT) { const int nblk = D / 32, kb = r / nblk, nb = r % nblk; p0_transpose_item(F.w_out, D, D, F.WOUT, 64 * kb, 32 * nb, 32 * nb, scr, F.lane); continue; }
        r -= I_OUT;
        { const int nblk = NE / 32, kb = r / nblk, nb = r % nblk; p0_transpose_item(F.w_router, D, NE, F.WR, 64 * kb, 32 * nb, 32 * nb, scr, F.lane); }
    }
    for (int idx = (int)blockIdx.x * (NWAVES * 64) + F.tid; idx < T * 32; idx += F.G * NWAVES * 64) {
        const int t = idx >> 5, i = idx & 31;
        const float inv = exp2f(-(float)i * (13.287712379549449f / 32.0f));
        const float ang = (float)F.positions[t] * inv;
        F.RCOS[idx] = cosf(ang); F.RSIN[idx] = sinf(ang);
    }
}
__device__ __forceinline__ void rows_adaln(Frame& F, const float* src, const float* g, const float* shift, const float* scale, bf16* dst) {
    const int gw = F.vcu * NWAVES + F.wave, NGW = F.G * NWAVES;
    for (int m = gw; m < T; m += NGW) {
        const int b = m >> 12;
        const GAS f32x4* xr = (const GAS f32x4*)(src + (size_t)m * D) + F.lane;
        f32x4 v[4]; float s2 = 0.f;
#pragma unroll
        for (int j = 0; j < 4; ++j) { v[j] = xr[64 * j]; s2 += (v[j].x * v[j].x + v[j].y * v[j].y) + (v[j].z * v[j].z + v[j].w * v[j].w); }
        const float rstd = 1.f / sqrtf(wave_sum(s2) * (1.f / D) + NORM_EPS);
        GAS v2u* o8 = (GAS v2u*)(dst + (size_t)m * D) + F.lane;
#pragma unroll
        for (int j = 0; j < 4; ++j) { const int c = 4 * F.lane + 256 * j;
            const f32x4 gv = *(const f32x4*)(g + c), sh = *(const f32x4*)(shift + b * 6144 + c), sc = *(const f32x4*)(scale + b * 6144 + c);
            const f32x4 y = v[j] * rstd * gv * (sc + 1.0f) + sh;
            v2u w; w.x = pk2(y.x, y.y); w.y = pk2(y.z, y.w); o8[64 * j] = w; }
    }
}
constexpr float SB_EXIT_LOG2 = 48.0f;
__device__ __forceinline__ int crow16(int r, int h) { return (r & 3) + 8 * (r >> 2) + 4 * h; }
__device__ __forceinline__ void sb_wave_tile(const bf16* PROJ, const bf16* SVT, bf16* MIXED, int b, int hd, int qt, int lane) {
    const int r32 = lane & 31, hi = lane >> 5;
    const bf16* Qp = PROJ + (size_t)(b * SEQ + 32 * qt + r32) * NPROJ + 1536 + hd * 64 + 8 * hi;
    bf16x8 qf[4];
#pragma unroll
    for (int s = 0; s < 4; ++s) qf[s] = *(const bf16x8*)(Qp + 16 * s);
    bf16x8 tf[2];
#pragma unroll
    for (int s = 0; s < 2; ++s)
#pragma unroll
        for (int j = 0; j < 8; ++j) tf[s][j] = (16 * s + 8 * (j >> 2) + 4 * hi + (j & 3)) >= r32 ? (short)0x3F80 : (short)0;
    f32x16 oT[2];
#pragma unroll
    for (int i = 0; i < 16; ++i) { oT[0][i] = 0.f; oT[1][i] = 0.f; }
    float R = 0.f;
    const bf16* Kb = PROJ + (size_t)(b * SEQ + r32) * NPROJ + 2048 + hd * 64 + 8 * hi;
    const bf16* Vb = SVT + ((size_t)(b * 8 + hd) * 64 + r32) * SEQ + 4 * hi;
    for (int kt = qt; kt >= 0; --kt) {
        const bf16* Kp = Kb + (size_t)(32 * kt) * NPROJ;
        bf16x8 kf[4];
#pragma unroll
        for (int s = 0; s < 4; ++s) kf[s] = *(const bf16x8*)(Kp + 16 * s);
        v2u vlo[2][2], vhi[2][2];
#pragma unroll
        for (int dt = 0; dt < 2; ++dt)
#pragma unroll
            for (int s = 0; s < 2; ++s) { const bf16* vp = Vb + (size_t)(32 * dt) * SEQ + 32 * kt + 16 * s; vlo[dt][s] = *(const v2u*)vp; vhi[dt][s] = *(const v2u*)(vp + 8); }
        f32x16 z;
#pragma unroll
        for (int i = 0; i < 16; ++i) z[i] = 0.f;
#pragma unroll
        for (int s = 0; s < 4; ++s) z = __builtin_amdgcn_mfma_f32_32x32x16_bf16(kf[s], qf[s], z, 0, 0, 0);
        const bool diag = (kt == qt);
        float sp[16];
#pragma unroll
        for (int i = 0; i < 16; ++i) { const float zz = z[i]; float v = fmaxf(zz, 0.f) + __builtin_amdgcn_logf(1.0f + __builtin_amdgcn_exp2f(-fabsf(zz)));
            if (diag && crow16(i, hi) >= r32) v = 0.f; sp[i] = v; }
        v4u p0, p1; p0.x = pk2(sp[0], sp[1]); p0.y = pk2(sp[2], sp[3]); p0.z = pk2(sp[4], sp[5]); p0.w = pk2(sp[6], sp[7]);
        p1.x = pk2(sp[8], sp[9]); p1.y = pk2(sp[10], sp[11]); p1.z = pk2(sp[12], sp[13]); p1.w = pk2(sp[14], sp[15]);
        f32x16 cs;
#pragma unroll
        for (int i = 0; i < 16; ++i) cs[i] = R;
        cs = __builtin_amdgcn_mfma_f32_32x32x16_bf16(tf[0], __builtin_bit_cast(bf16x8, p0), cs, 0, 0, 0);
        cs = __builtin_amdgcn_mfma_f32_32x32x16_bf16(tf[1], __builtin_bit_cast(bf16x8, p1), cs, 0, 0, 0);
        float w[16];
#pragma unroll
        for (int i = 0; i < 16; ++i) { float v = __builtin_amdgcn_exp2f(z[i] - cs[i]); if (diag && crow16(i, hi) >= r32) v = 0.f; w[i] = v; }
        R = __shfl(cs[0], r32);
        const bool done_ = __all(R > SB_EXIT_LOG2) != 0;
        v4u w0, w1; w0.x = pk2(w[0], w[1]); w0.y = pk2(w[2], w[3]); w0.z = pk2(w[4], w[5]); w0.w = pk2(w[6], w[7]);
        w1.x = pk2(w[8], w[9]); w1.y = pk2(w[10], w[11]); w1.z = pk2(w[12], w[13]); w1.w = pk2(w[14], w[15]);
#pragma unroll
        for (int dt = 0; dt < 2; ++dt) {
            v4u a0; a0.x = vlo[dt][0].x; a0.y = vlo[dt][0].y; a0.z = vhi[dt][0].x; a0.w = vhi[dt][0].y;
            v4u a1; a1.x = vlo[dt][1].x; a1.y = vlo[dt][1].y; a1.z = vhi[dt][1].x; a1.w = vhi[dt][1].y;
            oT[dt] = __builtin_amdgcn_mfma_f32_32x32x16_bf16(__builtin_bit_cast(bf16x8, a0), __builtin_bit_cast(bf16x8, w0), oT[dt], 0, 0, 0);
            oT[dt] = __builtin_amdgcn_mfma_f32_32x32x16_bf16(__builtin_bit_cast(bf16x8, a1), __builtin_bit_cast(bf16x8, w1), oT[dt], 0, 0, 0);
        }
        if (done_) break;
    }
    bf16* Op = MIXED + (size_t)(b * SEQ + 32 * qt + r32) * D + 512 + hd * 64 + 4 * hi;
#pragma unroll
    for (int dt = 0; dt < 2; ++dt)
#pragma unroll
        for (int g = 0; g < 4; ++g) { v2u o; o.x = pk2(oT[dt][4 * g], oT[dt][4 * g + 1]); o.y = pk2(oT[dt][4 * g + 2], oT[dt][4 * g + 3]); *(v2u*)(Op + 32 * dt + 8 * g) = o; }
}
__device__ __forceinline__ void sb_phase(Frame& F) {
    const int bh = F.vcu >> 3, s = F.vcu & 7;
    if (bh >= NB * 8) return;
#pragma unroll 1
    for (int i = 0; i < 2; ++i) { const int qb = i == 0 ? 15 - s : s; sb_wave_tile(F.PROJ, F.SVT, F.MIXED, bh >> 3, bh & 7, 8 * qb + F.wave, F.lane); }
}
__device__ __forceinline__ void combine_phase(Frame& F) {
    const int gw = F.vcu * NWAVES + F.wave, NGW = F.G * NWAVES;
    const float l01 = wave_sum(F.lam[F.lane] * F.lam[64 + F.lane]), l23 = wave_sum(F.lam[128 + F.lane] * F.lam[192 + F.lane]);
    const float lmbda = expf(l01) - expf(l23) + 0.2f;
    const float g0 = F.g_sub[2 * F.lane] * 0.8f, g1 = F.g_sub[2 * F.lane + 1] * 0.8f;
    for (int m = gw; m < T; m += NGW) {
        const unsigned* orow = (const unsigned*)(F.ORAW + (size_t)m * D);
        unsigned* mrow = (unsigned*)(F.MIXED + (size_t)m * D);
#pragma unroll
        for (int h = 0; h < 4; ++h) {
            const unsigned a = orow[h * 128 + F.lane], c = orow[h * 128 + 64 + F.lane];
            const float o0 = bflo(a) - lmbda * bflo(c), o1 = bfhi(a) - lmbda * bfhi(c);
            const float rstd = 1.f / sqrtf(wave_sum(o0 * o0 + o1 * o1) * (1.f / 128.f) + NORM_EPS);
            mrow[h * 64 + F.lane] = pk2(o0 * rstd * g0, o1 * rstd * g1);
        }
    }
}
constexpr int RT_ROWS = 64, RT_HP = 2064, RT_LP = 1040;
static_assert(RT_ROWS * RT_HP <= RING_BYTES && T / RT_ROWS == 256, "router phase LDS map / one tile per workgroup");
__device__ __forceinline__ void route_phase(Frame& F) {
    LAS unsigned char* lds = F.lds + RING_OFF;
    const int tid = F.tid, lane = F.lane, wid = F.wave;
    const float NEG = -INFINITY;
    for (int tile = F.vcu; tile < T / RT_ROWS; tile += F.G) {
        const int row0 = tile * RT_ROWS, b = row0 >> 12;
        __syncthreads();
        const float* shift = F.MOD + b * 6144 + 3 * 1024; const float* scale = F.MOD + b * 6144 + 4 * 1024;
#pragma unroll 1
        for (int r0 = 0; r0 < 8; r0 += 4) {
            f32x4 v[4][4]; v2u dd[4][4];
#pragma unroll
            for (int r = 0; r < 4; ++r) { const int m = row0 + 8 * wid + r0 + r;
                const GAS f32x4* xr = (const GAS f32x4*)(F.x + (size_t)m * D) + lane; const GAS v2u* dr = (const GAS v2u*)(F.DLT + (size_t)m * D) + lane;
#pragma unroll
                for (int j = 0; j < 4; ++j) { v[r][j] = xr[64 * j]; dd[r][j] = dr[64 * j]; } }
#pragma unroll
            for (int r = 0; r < 4; ++r) { const int lr = 8 * wid + r0 + r, m = row0 + lr; float s2 = 0.f;
#pragma unroll
                for (int j = 0; j < 4; ++j) { const v2u d = dd[r][j]; v[r][j].x += bflo(d.x); v[r][j].y += bfhi(d.x); v[r][j].z += bflo(d.y); v[r][j].w += bfhi(d.y);
                    s2 += (v[r][j].x * v[r][j].x + v[r][j].y * v[r][j].y) + (v[r][j].z * v[r][j].z + v[r][j].w * v[r][j].w); }
                const float rstd = 1.f / sqrtf(wave_sum(s2) * (1.f / D) + NORM_EPS);
                GAS v2u* o8 = (GAS v2u*)(F.H2 + (size_t)m * D) + lane;
#pragma unroll
                for (int j = 0; j < 4; ++j) { const int c = 4 * lane + 256 * j;
                    const f32x4 gv = *(const f32x4*)(F.g_ffn + c), sh = *(const f32x4*)(shift + c), sc = *(const f32x4*)(scale + c);
                    const f32x4 y = v[r][j] * rstd * gv * (sc + 1.0f) + sh;
                    v2u w; w.x = pk2(y.x, y.y); w.y = pk2(y.z, y.w); o8[64 * j] = w; *(LAS v2u*)(lds + lr * RT_HP + c * 2) = w; } }
        }
        __syncthreads();
        const int fr = lane & 15, fq = lane >> 4;
        f32x4 acc[4][2];
#pragma unroll
        for (int mt = 0; mt < 4; ++mt)
#pragma unroll
            for (int nt = 0; nt < 2; ++nt) acc[mt][nt] = (f32x4){0.f, 0.f, 0.f, 0.f};
        const bf16* wr0 = F.WR + (size_t)(32 * wid + fr) * D + 8 * fq;
#pragma unroll 8
        for (int ks = 0; ks < D / 32; ++ks) {
            const bf16x8 b0 = *(const bf16x8*)(wr0 + 32 * ks), b1 = *(const bf16x8*)(wr0 + (size_t)16 * D + 32 * ks);
#pragma unroll
            for (int mt = 0; mt < 4; ++mt) { const bf16x8 a = *(const LAS bf16x8*)(lds + (16 * mt + fr) * RT_HP + (32 * ks + 8 * fq) * 2);
                acc[mt][0] = __builtin_amdgcn_mfma_f32_16x16x32_bf16(a, b0, acc[mt][0], 0, 0, 0); acc[mt][1] = __builtin_amdgcn_mfma_f32_16x16x32_bf16(a, b1, acc[mt][1], 0, 0, 0); }
        }
        __syncthreads();
#pragma unroll
        for (int mt = 0; mt < 4; ++mt)
#pragma unroll
            for (int nt = 0; nt < 2; ++nt)
#pragma unroll
                for (int j = 0; j < 4; ++j) *(LAS float*)(lds + (16 * mt + 4 * fq + j) * RT_LP + (32 * wid + 16 * nt + fr) * 4) = acc[mt][nt][j];
        __syncthreads();
        const int tl = lane >> 3, g = lane & 7, t = row0 + 8 * wid + tl;
        float s[32], bz[32];
#pragma unroll
        for (int i4 = 0; i4 < 8; ++i4) { const f32x4 lg = *(const LAS f32x4*)(lds + (8 * wid + tl) * RT_LP + (32 * g + 4 * i4) * 4); const f32x4 eb = *(const f32x4*)(F.e_bias + 32 * g + 4 * i4);
#pragma unroll
            for (int j = 0; j < 4; ++j) { const float sg = __builtin_amdgcn_rcpf(1.0f + __expf(-lg[j])); s[4 * i4 + j] = sg; bz[4 * i4 + j] = sg + eb[j]; } }
        float m1 = NEG, m2 = NEG;
#pragma unroll
        for (int i = 0; i < 32; ++i) { const float v = bz[i]; m2 = fmaxf(m2, fminf(m1, v)); m1 = fmaxf(m1, v); }
        const float gs = m1 + m2; int rank = 0;
#pragma unroll
        for (int gp = 0; gp < 8; ++gp) { const float og = __shfl(gs, (lane & ~7) + gp); rank += (og > gs || (og == gs && gp < g)) ? 1 : 0; }
        unsigned taken = rank < 4 ? 0u : 0xffffffffu;
        int my_e = 0; float my_s = 0.f, ssum = 0.f;
#pragma unroll 1
        for (int k = 0; k < KSEL; ++k) {
            float lm = NEG, ls = 0.f; int li = 0;
#pragma unroll
            for (int i = 0; i < 32; ++i) { const float v = ((taken >> i) & 1u) ? NEG : bz[i]; const bool up = v > lm; lm = up ? v : lm; li = up ? i : li; ls = up ? s[i] : ls; }
            float wm = lm, ws = ls; int we = 32 * g + li;
#pragma unroll
            for (int off = 1; off < 8; off <<= 1) { const float ov = __shfl_xor(wm, off), os = __shfl_xor(ws, off); const int oe = __shfl_xor(we, off);
                const bool take = ov > wm || (ov == wm && oe < we); wm = take ? ov : wm; ws = take ? os : ws; we = take ? oe : we; }
            if ((we >> 5) == g) taken |= 1u << (we & 31);
            if (g == k) { my_e = we; my_s = ws; }
            ssum += ws;
        }
        { unsigned* cnt = F.ctl + CW_COUNT; const unsigned rk = atomicAdd(cnt + my_e, 1u); const size_t p = (size_t)my_e * T + rk; F.LTOK[p] = (unsigned)t | ((unsigned)g << 16); F.LW[p] = my_s / ssum * 2.5f; }
        if (g == 0) { const size_t p = (size_t)NE * T + t; F.LTOK[p] = (unsigned)t | (8u << 16); F.LW[p] = 1.0f; }
    }
}
constexpr int EX_TOK = 0, EX_WGT = 1024, EX_PFX = 2048, EX_QW = 3584, EX_ST0 = 4096, EX_WB = 32768, EX_AB = 16384, EX_STB = EX_WB + EX_AB, EX_NST = 3;
static_assert(EX_ST0 + EX_NST * EX_STB <= RING_BYTES, "expert LDS map");
constexpr int EX_ROWS = 256, EX_XQ = 34;
__device__ __forceinline__ v4u ex_gld16v(const char* sbase, unsigned voff) { v4u v; asm volatile("global_load_dwordx4 %0, %1, %2" : "=v"(v) : "v"(voff), "s"(sbase) : "memory"); return v; }
template <int AUX> __device__ __forceinline__ void ex_dma(const void* g, LAS unsigned char* l) { __builtin_amdgcn_global_load_lds((const unsigned*)g, (LAS unsigned*)l, 16, 0, AUX); }
template <int MODE>
__device__ __forceinline__ void ex_tile(Frame& F, LAS unsigned char* lds, int tid_, const float* W, int j, int nrows, bf16* ACT) {
    int tid = tid_; asm volatile("" : "+v"(tid));
    LAS unsigned* tokL = (LAS unsigned*)(lds + EX_TOK); LAS float* wgtL = (LAS float*)(lds + EX_WGT);
    const int lane = tid & 63, wid = __builtin_amdgcn_readfirstlane(tid >> 6), wr = wid >> 2, wc = wid & 3, fr = lane & 15, fq = lane >> 4;
    constexpr int K = MODE == 0 ? D : FF, ldw = MODE == 0 ? 512 : D, NK = K / 32;
    const int wcol = MODE == 0 ? (((lane & 3) >> 1) * 256 + 128 * j + 32 * (lane >> 4) + 8 * ((lane >> 2) & 3) + 4 * (lane & 1)) : (256 * j + 4 * lane);
    const char* wsrc = (const char*)(W + (size_t)(4 * wid) * ldw);
    const unsigned wvoff = 4u * (unsigned)wcol;
    const char* abase = MODE == 0 ? (const char*)F.H2 : (const char*)ACT;
    const int arow0 = 32 * wid + (lane >> 3), ac = lane & 7;
    const int awoff0 = EX_ST0 + EX_WB + arow0 * 64 + (((ac & 3) ^ ((0 - (lane >> 5)) & 3)) * 16), awoff1 = EX_ST0 + EX_WB + arow0 * 64 + (((ac & 3) ^ ((0 - (2 + (lane >> 5))) & 3)) * 16);
    const int ahalf = (lane & 7) >> 2;
#define EX_ISSUE_W(ks, st) do { LAS unsigned char* sb_ = lds + EX_ST0 + (st) * EX_STB; \
        _Pragma("unroll") for (int i_ = 0; i_ < 4; ++i_) ex_dma<0>(wsrc + (size_t)(32 * (ks) + i_) * (ldw * 4) + wvoff, sb_ + (4 * wid + i_) * 1024); } while (0)
#define EX_LOAD_A(b) do { _Pragma("unroll") for (int i_ = 0; i_ < 4; ++i_) { const int r_ = arow0 + 8 * i_; \
        const unsigned o_ = (MODE == 0 ? (tokL[r_] & 0xffffu) * (unsigned)(D * 2) : (unsigned)r_ * (unsigned)(FF * 2)) + 16u * (unsigned)ac + 128u * (unsigned)(b); ar[i_] = ex_gld16v(abase, o_); } } while (0)
#define EX_WRITE_A(stb) do {   \
        const int st_ = (stb) + ahalf >= EX_NST ? (stb) + ahalf - EX_NST : (stb) + ahalf; \
        _Pragma("unroll") for (int i_ = 0; i_ < 4; ++i_) *(LAS v4u*)(lds + ((i_ & 1) ? awoff1 : awoff0) + 512 * i_ + st_ * EX_STB) = ar[i_]; } while (0)
    v4u ar[4];
    f32x4 acc[8][4];
#pragma unroll
    for (int m = 0; m < 8; ++m)
#pragma unroll
        for (int q = 0; q < 4; ++q) acc[m][q] = (f32x4){0.f, 0.f, 0.f, 0.f};
    const bool active = 128 * wr < nrows;
    const int boff = fq * 8192 + wc * 256 + fr * 16;
    const int aoff_r = EX_WB + (128 * wr + fr) * 64 + ((fq ^ ((0 - (fr >> 2)) & 3)) * 16);
    EX_LOAD_A(0); EX_ISSUE_W(0, 0); EX_ISSUE_W(1, 1);
    asm volatile("s_waitcnt vmcnt(8)" : "+v"(ar[0]), "+v"(ar[1]), "+v"(ar[2]), "+v"(ar[3]) :: "memory");
    EX_WRITE_A(0);
    if (1 < NK / 2) EX_LOAD_A(1);
    int st = 0;
#pragma unroll 2
    for (int ks = 0; ks < NK; ++ks) {
        if (ks + 2 < NK) asm volatile("s_waitcnt vmcnt(8)" ::: "memory"); else if (ks + 2 == NK) asm volatile("s_waitcnt vmcnt(4)" ::: "memory"); else asm volatile("s_waitcnt vmcnt(0)" ::: "memory");
        asm volatile("s_waitcnt lgkmcnt(0)" ::: "memory");
        __builtin_amdgcn_s_barrier();
        asm volatile("" ::: "memory");
        const LAS unsigned char* sb = lds + EX_ST0 + st * EX_STB;
        f32x4 xw[8]; bf16x8 af[8];
        if (active) {
#pragma unroll
            for (int jj = 0; jj < 8; ++jj) xw[jj] = *(const LAS f32x4*)(sb + boff + jj * 1024);
#pragma unroll
            for (int m = 0; m < 8; ++m) af[m] = *(const LAS bf16x8*)(sb + aoff_r + m * 1024);
        }
        const int s1 = st + 1 >= EX_NST ? st + 1 - EX_NST : st + 1, s2 = st + 2 >= EX_NST ? st + 2 - EX_NST : st + 2;
        if (ks + 2 < NK) EX_ISSUE_W(ks + 2, s2);
        if (active) {
            bf16x8 bfr[4];
#pragma unroll
            for (int jp = 0; jp < 4; ++jp)
#pragma unroll
                for (int q = 0; q < 4; ++q) { const unsigned p = pk2(xw[2 * jp][q], xw[2 * jp + 1][q]); bfr[q][2 * jp] = (short)(p & 0xffffu); bfr[q][2 * jp + 1] = (short)(p >> 16); }
#pragma unroll
            for (int m = 0; m < 8; ++m)
#pragma unroll
                for (int q = 0; q < 4; ++q) acc[m][q] = __builtin_amdgcn_mfma_f32_16x16x32_bf16(bfr[q], af[m], acc[m][q], 0, 0, 0);
        }
        if ((ks & 1) && ks + 1 < NK) {
            if (ks + 2 < NK) asm volatile("s_waitcnt vmcnt(8)" : "+v"(ar[0]), "+v"(ar[1]), "+v"(ar[2]), "+v"(ar[3]) :: "memory");
            else asm volatile("s_waitcnt vmcnt(4)" : "+v"(ar[0]), "+v"(ar[1]), "+v"(ar[2]), "+v"(ar[3]) :: "memory");
            EX_WRITE_A(s1);
            if ((ks + 3) / 2 < NK / 2) EX_LOAD_A((ks + 3) / 2);
        }
        st = st + 1 >= EX_NST ? 0 : st + 1;
    }
#undef EX_ISSUE_W
#undef EX_LOAD_A
#undef EX_WRITE_A
    if (active) {
        if (MODE == 0) {
#pragma unroll
            for (int m = 0; m < 8; ++m) { float o[8];
#pragma unroll
                for (int rg = 0; rg < 2; ++rg)
#pragma unroll
                    for (int q = 0; q < 4; ++q) { const float g = acc[m][q][rg], u = acc[m][q][rg + 2]; o[4 * rg + q] = g * __builtin_amdgcn_rcpf(1.0f + __expf(-g)) * u; }
                v4u w; w.x = pk2(o[0], o[1]); w.y = pk2(o[2], o[3]); w.z = pk2(o[4], o[5]); w.w = pk2(o[6], o[7]);
                *(v4u*)(ACT + (size_t)(128 * wr + 16 * m + fr) * FF + 128 * j + 32 * wc + 8 * fq) = w; }
        } else {
#pragma unroll
            for (int m = 0; m < 8; ++m) { const int row = 128 * wr + 16 * m + fr;
                if (row < nrows) { const unsigned ti = tokL[row]; const float wv = wgtL[row];
                    bf16* yp = F.Y + ((size_t)(ti & 0xffffu) * NSLOT9 + (ti >> 16)) * D + 256 * j + 64 * wc + 16 * fq;
#pragma unroll
                    for (int rg = 0; rg < 4; rg += 2) { v4u w; w.x = pk2(acc[m][0][rg] * wv, acc[m][1][rg] * wv); w.y = pk2(acc[m][2][rg] * wv, acc[m][3][rg] * wv);
                        w.z = pk2(acc[m][0][rg + 1] * wv, acc[m][1][rg + 1] * wv); w.w = pk2(acc[m][2][rg + 1] * wv, acc[m][3][rg + 1] * wv); *(v4u*)(yp + 4 * rg) = w; } } }
        }
    }
    __builtin_amdgcn_s_barrier();
    asm volatile("" ::: "memory");
}
__device__ __forceinline__ void expert_unit(Frame& F, int e, int chunk, int nrows) {
    LAS unsigned char* lds = F.lds + RING_OFF;
    LAS unsigned* tokL = (LAS unsigned*)(lds + EX_TOK); LAS float* wgtL = (LAS float*)(lds + EX_WGT);
    const int tid = F.tid;
    if (tid < EX_ROWS) { const bool ok = tid < nrows; const size_t p = (size_t)e * T + (size_t)chunk * EX_ROWS + tid; tokL[tid] = ok ? F.LTOK[p] : 0u; wgtL[tid] = ok ? F.LW[p] : 0.f; }
    __syncthreads();
    const float* Wgu = e < NE ? F.w_gu + (size_t)e * D * 512 : F.w_sh_gu;
    const float* Wdn = e < NE ? F.w_down + (size_t)e * FF * D : F.w_sh_down;
    bf16* ACT = F.ACT + (size_t)F.vcu * EX_ROWS * FF;
#pragma unroll 1
    for (int j = 0; j < 2; ++j) ex_tile<0>(F, lds, tid, Wgu, j, nrows, ACT);
    VM_WAIT(); __syncthreads();
#pragma unroll 1
    for (int j = 0; j < 4; ++j) ex_tile<1>(F, lds, tid, Wdn, j, nrows, ACT);
}
__device__ __forceinline__ void expert_phase(Frame& F) {
    LAS unsigned char* lds = F.lds + RING_OFF;
    LAS unsigned* pfx = (LAS unsigned*)(lds + EX_PFX);
    LAS unsigned* qw = (LAS unsigned*)(lds + EX_QW);
    __syncthreads();
    LAS unsigned* cntL = (LAS unsigned*)(lds + EX_ST0);
    if (F.tid < NE) cntL[F.tid] = __hip_atomic_load(F.ctl + CW_COUNT + F.tid, RLX_AGENT);
    __syncthreads();
    if (F.tid < 8) { const int x = F.tid; unsigned run = 0;
        for (int i = 0; i < 32; ++i) { pfx[x * EX_XQ + i] = run; run += (cntL[8 * i + x] + EX_ROWS - 1) / EX_ROWS; }
        pfx[x * EX_XQ + 32] = run; run += (T / EX_ROWS) / 8; pfx[x * EX_XQ + 33] = run; }
    __syncthreads();
    const int myx = (int)(xb_xcc_id() & 7u);
    if (F.wave >= 4) __builtin_amdgcn_s_setprio(1);
    int hop = 0;
#pragma unroll 1
    for (;;) {
        __syncthreads();
        if (F.tid == 0) { unsigned u = 0xffffffffu; int h = hop;
            for (; h < 8; ++h) { const int x = (myx + h) & 7; u = __hip_atomic_fetch_add(F.ctl + CW_QUEUE + 64 * x, 1u, RLX_AGENT); if (u < pfx[x * EX_XQ + 33]) break; }
            qw[0] = u; qw[1] = (unsigned)h; }
        __syncthreads();
        const int u = (int)qw[0]; hop = (int)qw[1];
        if (hop >= 8) { __builtin_amdgcn_s_setprio(0); break; }
        const int x = (myx + hop) & 7;
        const LAS unsigned* px = pfx + x * EX_XQ;
        int lo = 0, hi = 32;
        while (lo < hi) { const int mid = (lo + hi + 1) >> 1; if ((int)px[mid] <= u) lo = mid; else hi = mid - 1; }
        int e, chunk, cnt;
        if (lo < 32) { e = 8 * lo + x; chunk = u - (int)px[lo]; cnt = (int)__hip_atomic_load(F.ctl + CW_COUNT + e, RLX_AGENT); }
        else { e = NE; chunk = 8 * x + (u - (int)px[32]); cnt = T; }
        const int nrows = min(EX_ROWS, cnt - EX_ROWS * chunk);
        expert_unit(F, e, chunk, nrows);
    }
}
__device__ __forceinline__ void final_phase(Frame& F) {
    const int gw = F.vcu * NWAVES + F.wave, NGW = F.G * NWAVES;
    for (int m = gw; m < T; m += NGW) {
        const float* gm = F.MOD + (size_t)(m >> 12) * 6144 + 5 * 1024;
#pragma unroll
        for (int jj = 0; jj < 2; ++jj) { const int c = 8 * F.lane + 512 * jj; float a[8];
#pragma unroll
            for (int i = 0; i < 8; ++i) a[i] = 0.f;
#pragma unroll
            for (int k = 0; k < NSLOT9; ++k) { const v4u y = __builtin_nontemporal_load((const v4u*)(F.Y + ((size_t)m * NSLOT9 + k) * D + c));
                a[0] += bflo(y.x); a[1] += bfhi(y.x); a[2] += bflo(y.y); a[3] += bfhi(y.y); a[4] += bflo(y.z); a[5] += bfhi(y.z); a[6] += bflo(y.w); a[7] += bfhi(y.w); }
            f32x4 r0 = __builtin_nontemporal_load((const f32x4*)(F.x + (size_t)m * D + c)), r1 = __builtin_nontemporal_load((const f32x4*)(F.x + (size_t)m * D + c + 4));
            { const v4u d = __builtin_nontemporal_load((const v4u*)(F.DLT + (size_t)m * D + c)); r0.x += bflo(d.x); r0.y += bfhi(d.x); r0.z += bflo(d.y); r0.w += bfhi(d.y); r1.x += bflo(d.z); r1.y += bfhi(d.z); r1.z += bflo(d.w); r1.w += bfhi(d.w); }
            const f32x4 g0 = *(const f32x4*)(gm + c), g1 = *(const f32x4*)(gm + c + 4);
            f32x4 o0, o1; o0.x = r0.x + g0.x * a[0]; o0.y = r0.y + g0.y * a[1]; o0.z = r0.z + g0.z * a[2]; o0.w = r0.w + g0.w * a[3];
            o1.x = r1.x + g1.x * a[4]; o1.y = r1.y + g1.y * a[5]; o1.z = r1.z + g1.z * a[6]; o1.w = r1.w + g1.w * a[7];
            __builtin_nontemporal_store(o0, (f32x4*)(F.out + (size_t)m * D + c)); __builtin_nontemporal_store(o1, (f32x4*)(F.out + (size_t)m * D + c + 4)); }
    }
}
struct Args { const void* in[19]; float* out; unsigned char* ws; };
static_assert(sizeof(Args) == 21 * 8, "Args has no padding bytes");
__global__ void __launch_bounds__(NWAVES * 64, 2) hybrid_fwd(Args args) {
    extern __shared__ __attribute__((aligned(16))) unsigned char lds[];
    Frame F;
    F.lds = (LAS unsigned char*)lds;
    F.MISC = (volatile LAS unsigned*)(F.lds + MISC_OFF);
    F.tid = threadIdx.x; F.lane = F.tid & 63; F.wave = __builtin_amdgcn_readfirstlane(F.tid >> 6);
    F.G = gridDim.x; { const int bx = blockIdx.x; F.vcu = (F.G % 8 == 0) ? (bx % 8) * (F.G / 8) + bx / 8 : bx; }
    unsigned char* ws = args.ws;
    F.ctl = (unsigned*)(ws + WS_CTL);
    F.x = (const float*)args.in[0]; F.c = (const float*)args.in[1]; F.positions = (const int*)args.in[2]; F.w_ada = (const float*)args.in[3]; F.b_ada = (const float*)args.in[4];
    F.g_mix = (const float*)args.in[5]; F.w_in = (const float*)args.in[6]; F.g_q = (const float*)args.in[7]; F.g_k = (const float*)args.in[8]; F.lam = (const float*)args.in[9];
    F.g_sub = (const float*)args.in[10]; F.w_out = (const float*)args.in[11]; F.g_ffn = (const float*)args.in[12]; F.w_router = (const float*)args.in[13]; F.e_bias = (const float*)args.in[14];
    F.w_sh_gu = (const float*)args.in[15]; F.w_sh_down = (const float*)args.in[16]; F.w_gu = (const float*)args.in[17]; F.w_down = (const float*)args.in[18];
    F.out = args.out;
    F.MOD = (float*)(ws + WS_MOD); F.RCOS = (float*)(ws + WS_COS); F.RSIN = (float*)(ws + WS_SIN); F.DLT = (bf16*)(ws + WS_R); F.LW = (float*)(ws + WS_LW);
    F.WIN = (bf16*)(ws + WS_WIN); F.WOUT = (bf16*)(ws + WS_WOUT); F.WR = (bf16*)(ws + WS_WR); F.XN = (bf16*)(ws + WS_XN); F.PROJ = (bf16*)(ws + WS_PROJ); F.SVT = (bf16*)(ws + WS_SVT);
    F.ORAW = (bf16*)(ws + WS_ORAW); F.MIXED = (bf16*)(ws + WS_MIXED); F.H2 = (bf16*)(ws + WS_H2); F.Y = (bf16*)(ws + WS_Y); F.ACT = (bf16*)(ws + WS_ACT); F.LTOK = (unsigned*)(ws + WS_LTOK);
    for (int u = F.tid; u < (LDS_BYTES - LDSCTL_OFF) / 4; u += NWAVES * 64) ((LAS unsigned*)(F.lds + LDSCTL_OFF))[u] = 0u;
    __syncthreads();
    XcdBarrier bar = xcd_barrier_post(F.ctl + CW_BAR, F.MISC + 8);
#define GRID_BAR() xcd_barrier(bar)
#define PHASE_BEGIN() do { int t_ = threadIdx.x; asm volatile("" : "+v"(t_)); F.tid = t_; F.lane = t_ & 63; } while (0)

    PHASE_BEGIN(); p0_prologue(F);
    GRID_BAR();
    PHASE_BEGIN(); rows_adaln(F, F.x, F.g_mix, F.MOD + 0 * 1024, F.MOD + 1 * 1024, F.XN);
    GRID_BAR();
    {   pg8::Gemm g{F.XN, F.WIN, T, NPROJ, D}; pg8::StaticOrder S; S.init(T, NPROJ, F.G, (int)blockIdx.x);
        pg8::EpiProj E{F.PROJ, F.SVT, F.RCOS, F.RSIN, F.g_q, F.g_k};
        pg8::gemm_phase<pg8::EpiProj, pg8::StaticOrder, PG8_ALIGN, PG8_SP2>(F.lds + RING_OFF, g, S, E); }
    GRID_BAR();
    {   const attn_body::StaticOrder S((int)F.G, (int)blockIdx.x);
        attn_body::attn_phase<attn_body::StaticOrder>((char*)lds + RING_OFF, (const attn_body::bf16*)F.PROJ, (attn_body::bf16*)F.ORAW, S); }
    PHASE_BEGIN(); sb_phase(F);
    GRID_BAR();
    PHASE_BEGIN(); combine_phase(F);
    GRID_BAR();
    {   pg8::Gemm g{F.MIXED, F.WOUT, T, D, D}; pg8::StaticOrder S; S.init(T, D, F.G, (int)blockIdx.x);
        pg8::EpiGateBf16 E{F.MOD + 2 * 1024, F.DLT};
        pg8::gemm_phase<pg8::EpiGateBf16, pg8::StaticOrder, PG8_ALIGN, PG8_SP2>(F.lds + RING_OFF, g, S, E); }
    GRID_BAR();
    PHASE_BEGIN(); route_phase(F);
    GRID_BAR();
    PHASE_BEGIN(); expert_phase(F);
    GRID_BAR();
    PHASE_BEGIN(); final_phase(F);
}

extern "C" void kernel_launch(void* const* d_in, const int* in_sizes, int n_in, void* d_out, int out_size, void* d_ws, size_t ws_size, hipStream_t stream) {
    static int grid = 0;
    if (grid == 0) {
        if (n_in != 19 || out_size != T * D || ws_size < WS_END) { fprintf(stderr, "kernel_launch: unexpected problem shape (n_in %d, out %d, ws %zu); nothing launched\n", n_in, out_size, ws_size); grid = -1; return; }
        int dev = 0, cus = 0, per_cu = 0;
        if (hipGetDevice(&dev) != hipSuccess || hipDeviceGetAttribute(&cus, hipDeviceAttributeMultiprocessorCount, dev) != hipSuccess) { grid = -1; return; }
        if (hipFuncSetAttribute((const void*)hybrid_fwd, hipFuncAttributeMaxDynamicSharedMemorySize, LDS_BYTES) != hipSuccess) { fprintf(stderr, "kernel_launch: hipFuncSetAttribute failed\n"); grid = -1; return; }
        if (hipOccupancyMaxActiveBlocksPerMultiprocessor(&per_cu, (const void*)hybrid_fwd, NWAVES * 64, LDS_BYTES) != hipSuccess || per_cu < 1)
            fprintf(stderr, "kernel_launch: note: the occupancy query reports %d workgroups per CU\n", per_cu);
        (void)hipGetLastError();
        grid = cus;
        if (grid != 256) fprintf(stderr, "kernel_launch: %d CUs (expected 256)\n", grid);
    }
    if (grid < 0) return;
    if (hipMemsetAsync((char*)d_ws + WS_CTL, 0, CTL_ZERO_BYTES, stream) != hipSuccess) { fprintf(stderr, "kernel_launch: hipMemsetAsync failed\n"); return; }
    Args a{};
    for (int i = 0; i < 19; ++i) a.in[i] = d_in[i];
    a.out = (float*)d_out; a.ws = (unsigned char*)d_ws;
    hipLaunchKernelGGL(hybrid_fwd, dim3(grid), dim3(NWAVES * 64), LDS_BYTES, stream, a);
    const hipError_t le = hipPeekAtLastError();
    if (le != hipSuccess) fprintf(stderr, "kernel_launch: launch failed: %s\n", hipGetErrorName(le));
}
```

```cpp
#include <hip/hip_runtime.h>
#include <hip/hip_bf16.h>
#include <cstdio>
#include <cstdint>
#include <cmath>
namespace pg8 {
#define PG8_LAS __attribute__((address_space(3)))
typedef unsigned short bf16_t;
typedef short bf16x8 __attribute__((ext_vector_type(8)));
typedef float f32x4 __attribute__((ext_vector_type(4)));
typedef unsigned u32x4 __attribute__((ext_vector_type(4)));
constexpr int BM = 256, BK = 64, HALF = 128, HTB = HALF * BK * 2  , STAGE_BYTES = 8 * HTB, NXCD = 8, WGM = 8;

__host__ __device__ __forceinline__ int lds_byte(int r, int c) { const int st = (r >> 4) * 2 + (c >> 5), rr = r & 15, cc = c & 31, ob = rr * 64 + cc * 2; return st * 1024 + (ob ^ (((ob >> 9) & 1) << 5)); }
__host__ __device__ __forceinline__ void stage_rc(int b, int& R, int& C) { const int st = b / 1024, sb = b % 1024, swz = sb ^ (((sb >> 9) & 1) << 5); R = (st >> 1) * 16 + swz / 64; C = (st & 1) * 32 + (swz % 64) / 2; }
__host__ __device__ __forceinline__ int perm32(int rho) { const int n = rho >> 4, i = rho & 15; return 8 * (i >> 2) + 4 * n + (i & 3); }

struct Unit { int pm, pn; };
struct Gemm { const bf16_t* A; const bf16_t* Bt; int M, N, K; };

struct StaticOrder {
    int nM, nN, nwg, G, c;
    __host__ __device__ void init(int M, int N, int G_, int c_) { nM = M / BM; nN = N / BM; nwg = nM * nN; G = G_; c = c_; }
    __host__ __device__ bool next(int i, Unit& u) const {
        const long L = (long)i * G + c; if (L >= nwg) return false;
        int wgid = (int)L; { const int q = nwg / NXCD, r = nwg % NXCD, xcd = wgid % NXCD, off = wgid / NXCD; wgid = (xcd < r ? xcd * (q + 1) : r * (q + 1) + (xcd - r) * q) + off; }
        const int nig = WGM * nN, gid = wgid / nig, fm = gid * WGM, gsz = (nM - fm) < WGM ? (nM - fm) : WGM;
        u.pm = fm + ((wgid % nig) % gsz); u.pn = (wgid % nig) / gsz; return true;
    }
    __device__ __forceinline__ void a_ready(const Unit&) const {}
    __device__ __forceinline__ void done(const Unit&) const {}
};

__device__ __forceinline__ unsigned cvt_pk_bf16(float lo, float hi) { typedef float f2_t __attribute__((ext_vector_type(2))); typedef __bf16 b2_t __attribute__((ext_vector_type(2)));
    f2_t v = {lo, hi}; b2_t b = __builtin_convertvector(v, b2_t); return __builtin_bit_cast(unsigned, b); }
typedef unsigned u32x2 __attribute__((ext_vector_type(2)));
constexpr float QK_C2 = 0.125f * 1.4426950408889634f;

struct EpiGateBf16 {
    static constexpr bool PERM = false, AFTER_DRAIN = false;
    const float* gate; bf16_t* DLT;
    __device__ __forceinline__ void operator()(const f32x4 (&acc)[2][2][4][2], const Unit& u, int wr, int wc, int fr, int fq) const {
        const int row0 = u.pm * BM + wr * 64 + fr, col0 = u.pn * BM + wc * 32 + 4 * fq;
        const float* gb = gate + (size_t)(u.pm >> 4) * 6144 + col0;
        f32x4 gv[2][2];
#pragma unroll
        for (int bj = 0; bj < 2; ++bj)
#pragma unroll
            for (int n = 0; n < 2; ++n) gv[bj][n] = *(const f32x4*)(gb + bj * HALF + n * 16);
#pragma unroll
        for (int ai = 0; ai < 2; ++ai)
#pragma unroll
            for (int m = 0; m < 4; ++m) { bf16_t* rowp = DLT + (size_t)(row0 + ai * HALF + m * 16) * 1024 + col0;
#pragma unroll
                for (int bj = 0; bj < 2; ++bj)
#pragma unroll
                    for (int n = 0; n < 2; ++n) { const f32x4 v = gv[bj][n] * acc[ai][bj][m][n]; u32x2 w; w.x = cvt_pk_bf16(v[0], v[1]); w.y = cvt_pk_bf16(v[2], v[3]); *(u32x2*)(rowp + bj * HALF + n * 16) = w; } }
    }
};
struct EpiProj {
    static constexpr bool PERM = false, AFTER_DRAIN = false;
    bf16_t* P; bf16_t* SVT; const float* rcos; const float* rsin; const float* gq; const float* gk;
    __device__ __forceinline__ void operator()(const f32x4 (&acc)[2][2][4][2], const Unit& u, int wr, int wc, int fr, int fq) const {
        const int row0 = u.pm * BM + wr * 64 + fr, pn = u.pn;
        const int cbase = pn * BM + 64 * wc + 4 * fq;
        if (pn < 4) {
            const float* g = pn < 2 ? gq : gk; const float osc = pn < 2 ? QK_C2 : 1.0f;
            f32x4 gv[2][2];
#pragma unroll
            for (int bj = 0; bj < 2; ++bj)
#pragma unroll
                for (int n = 0; n < 2; ++n) gv[bj][n] = *(const f32x4*)(g + 32 * bj + 16 * n + 4 * fq);
#pragma unroll
            for (int ai = 0; ai < 2; ++ai)
#pragma unroll
                for (int m = 0; m < 4; ++m) { const int row = row0 + ai * HALF + m * 16; float ss = 0.f;
#pragma unroll
                    for (int bj = 0; bj < 2; ++bj)
#pragma unroll
                        for (int n = 0; n < 2; ++n) { const f32x4 v = acc[ai][bj][m][n]; ss += (v[0] * v[0] + v[1] * v[1]) + (v[2] * v[2] + v[3] * v[3]); }
                    ss += __shfl_xor(ss, 16); ss += __shfl_xor(ss, 32);
                    const float rstd = 1.0f / sqrtf(ss * (1.0f / 64.0f) + 1e-6f);
                    bf16_t* prow = P + (size_t)row * 3072 + cbase;
#pragma unroll
                    for (int n = 0; n < 2; ++n) { const f32x4 cs = *(const f32x4*)(rcos + (size_t)row * 32 + 16 * n + 4 * fq), sn = *(const f32x4*)(rsin + (size_t)row * 32 + 16 * n + 4 * fq);
                        const f32x4 lo = acc[ai][0][m][n] * rstd * gv[0][n], hi = acc[ai][1][m][n] * rstd * gv[1][n];
                        const f32x4 olo = (lo * cs - hi * sn) * osc, ohi = (hi * cs + lo * sn) * osc;
                        u32x2 w0, w1; w0.x = cvt_pk_bf16(olo[0], olo[1]); w0.y = cvt_pk_bf16(olo[2], olo[3]); w1.x = cvt_pk_bf16(ohi[0], ohi[1]); w1.y = cvt_pk_bf16(ohi[2], ohi[3]);
                        *(u32x2*)(prow + 16 * n) = w0; *(u32x2*)(prow + 32 + 16 * n) = w1; } }
        } else if (pn < 10) {
            const float osc = (pn == 6 || pn == 7) ? QK_C2 : 1.0f;
#pragma unroll
            for (int ai = 0; ai < 2; ++ai)
#pragma unroll
                for (int m = 0; m < 4; ++m) { bf16_t* prow = P + (size_t)(row0 + ai * HALF + m * 16) * 3072 + cbase;
#pragma unroll
                    for (int bj = 0; bj < 2; ++bj)
#pragma unroll
                        for (int n = 0; n < 2; ++n) { const f32x4 v = acc[ai][bj][m][n] * osc; u32x2 w; w.x = cvt_pk_bf16(v[0], v[1]); w.y = cvt_pk_bf16(v[2], v[3]); *(u32x2*)(prow + 32 * bj + 16 * n) = w; } }
        } else {
            const int hd = 4 * (pn - 10) + wc;
#pragma unroll
            for (int ai = 0; ai < 2; ++ai)
#pragma unroll
                for (int m = 0; m < 4; ++m) { const int row = row0 + ai * HALF + m * 16, b = row >> 12, t = row & 4095;
                    bf16_t* vb = SVT + ((size_t)(b * 8 + hd) * 64 + 4 * fq) * 4096 + t;
#pragma unroll
                    for (int bj = 0; bj < 2; ++bj)
#pragma unroll
                        for (int n = 0; n < 2; ++n) { const f32x4 v = acc[ai][bj][m][n]; const unsigned p0 = cvt_pk_bf16(v[0], v[1]), p1 = cvt_pk_bf16(v[2], v[3]);
                            bf16_t* d = vb + (size_t)(32 * bj + 16 * n) * 4096;
                            d[0] = (bf16_t)(p0 & 0xffffu); d[4096] = (bf16_t)(p0 >> 16); d[2 * 4096] = (bf16_t)(p1 & 0xffffu); d[3 * 4096] = (bf16_t)(p1 >> 16); } }
        }
    }
};

template <class Epi, class Sched, bool ALIGN_EPI = false, bool SP2 = false>
__device__ __forceinline__ void gemm_phase(PG8_LAS unsigned char* lds, const Gemm g, const Sched& S, const Epi& E) {
    int tid_ = threadIdx.x; asm volatile("" : "+v"(tid_));
    const int tid = tid_, wid = __builtin_amdgcn_readfirstlane(tid >> 6), lane = tid & 63, wr = wid >> 2, wc = wid & 3, fr = lane & 15, fq = lane >> 4;
    const int K = g.K, nt = K / BK;
    unsigned voffA[2], voffB[2];
#pragma unroll
    for (int i = 0; i < 2; ++i) { int R, C; stage_rc(tid * 16 + i * 8192, R, C); const int Rb = Epi::PERM ? ((R & ~31) + perm32(R & 31)) : R;
        voffA[i] = (unsigned)(R * K + C) * 2u; voffB[i] = (unsigned)(Rb * K + C) * 2u; }
    const size_t kstep = (size_t)(BK * 2);
    const size_t hstep = (size_t)HALF * K * 2;
    const size_t tstep = 2 * hstep;
    const unsigned ldsw = (unsigned)wid * 1024u;
    const int aoff = lds_byte(wr * 64 + fr, fq * 8), boff = lds_byte(wc * 32 + fr, fq * 8);
#define PG8_SA(b, h) (((b) * 2 + (h)) * HTB)
#define PG8_SB(b, h) ((4 + (b) * 2 + (h)) * HTB)
#define PG8_STAGE(bufoff, gbase, voff) do { _Pragma("unroll") for (int _i = 0; _i < 2; ++_i) \
        __builtin_amdgcn_global_load_lds((const unsigned*)((const char*)(gbase) + (voff)[_i]), (PG8_LAS unsigned*)(lds + (bufoff) + ldsw + _i * 8192), 16, 0, 0); } while (0)
#define PG8_LDA(dst, b, h) do { _Pragma("unroll") for (int m = 0; m < 4; ++m) _Pragma("unroll") for (int k = 0; k < 2; ++k) dst[m][k] = *(const PG8_LAS bf16x8*)(lds + PG8_SA(b, h) + aoff + m * 2048 + k * 1024); } while (0)
#define PG8_LDB(dst, b, h) do { _Pragma("unroll") for (int n = 0; n < 2; ++n) _Pragma("unroll") for (int k = 0; k < 2; ++k) dst[n][k] = *(const PG8_LAS bf16x8*)(lds + PG8_SB(b, h) + boff + n * 2048 + k * 1024); } while (0)
#define PG8_MMA(ai, bj, At, Bt) do { __builtin_amdgcn_s_setprio(1); _Pragma("unroll") for (int m = 0; m < 4; ++m) _Pragma("unroll") for (int n = 0; n < 2; ++n) _Pragma("unroll") for (int k = 0; k < 2; ++k) \
        acc[ai][bj][m][n] = __builtin_amdgcn_mfma_f32_16x16x32_bf16(Bt[n][k], At[m][k], acc[ai][bj][m][n], 0, 0, 0); __builtin_amdgcn_s_setprio(0); } while (0)
#define PG8_WAIT_V(n) asm volatile("s_waitcnt vmcnt(" #n ")" ::: "memory")
#define PG8_WAIT_L(n) asm volatile("s_waitcnt lgkmcnt(" #n ")" ::: "memory")
#define PG8_BAR __builtin_amdgcn_s_barrier()
#define PG8_SCHED __builtin_amdgcn_sched_barrier(0)
    Unit cur, nxt; int ui = 0;
    if (!S.next(0, cur)) return;
    f32x4 acc[2][2][4][2];
#pragma unroll
    for (int a = 0; a < 2; ++a)
#pragma unroll
        for (int b = 0; b < 2; ++b)
#pragma unroll
            for (int m = 0; m < 4; ++m)
#pragma unroll
                for (int n = 0; n < 2; ++n) acc[a][b][m][n] = (f32x4){0.f, 0.f, 0.f, 0.f};
    bf16x8 At[4][2], B0[2][2], B1[2][2];
    const char* cA = (const char*)g.A + (size_t)cur.pm * tstep; const char* cB = (const char*)g.Bt + (size_t)cur.pn * tstep;
    S.a_ready(cur);
    if constexpr (SP2) {
        PG8_STAGE(PG8_SB(0, 0), cB, voffB); PG8_STAGE(PG8_SB(0, 1), cB + hstep, voffB); PG8_STAGE(PG8_SA(0, 0), cA, voffA); PG8_STAGE(PG8_SA(0, 1), cA + hstep, voffA);
        if (wr == 1) PG8_BAR;
        PG8_WAIT_V(2); PG8_BAR;
        PG8_STAGE(PG8_SB(1, 0), cB + kstep, voffB); PG8_STAGE(PG8_SA(1, 0), cA + kstep, voffA); PG8_STAGE(PG8_SB(1, 1), cB + hstep + kstep, voffB);
        PG8_WAIT_V(6); PG8_BAR;
    } else {
        PG8_STAGE(PG8_SB(0, 0), cB, voffB); PG8_STAGE(PG8_SA(0, 0), cA, voffA); PG8_STAGE(PG8_SB(0, 1), cB + hstep, voffB); PG8_STAGE(PG8_SA(0, 1), cA + hstep, voffA);
        if (wr == 1) PG8_BAR;
        PG8_WAIT_V(4); PG8_BAR;
        PG8_STAGE(PG8_SB(1, 0), cB + kstep, voffB); PG8_STAGE(PG8_SA(1, 0), cA + kstep, voffA); PG8_STAGE(PG8_SB(1, 1), cB + hstep + kstep, voffB);
        PG8_WAIT_V(6); PG8_BAR;
    }
    for (;;) {
        const bool has_next = S.next(ui + 1, nxt);
        const char* nA = has_next ? (const char*)g.A + (size_t)nxt.pm * tstep : cA; const char* nB = has_next ? (const char*)g.Bt + (size_t)nxt.pn * tstep : cB;
        for (int t = 0; t < nt; t += 2) {
            const bool last = (t == nt - 2);
            const char* a1 = cA + (size_t)(t + 1) * kstep;
            const char* a2 = last ? nA : cA + (size_t)(t + 2) * kstep; const char* b2 = last ? nB : cB + (size_t)(t + 2) * kstep;
            const char* a3 = a2 + kstep; const char* b3 = b2 + kstep;
            if (last && has_next) S.a_ready(nxt);
            if constexpr (SP2) {
            PG8_LDB(B0, 0, 0); PG8_LDB(B1, 0, 1); PG8_SCHED; PG8_LDA(At, 0, 0); PG8_STAGE(PG8_SA(1, 1), a1 + hstep, voffA);
            PG8_WAIT_V(8); PG8_WAIT_L(0); PG8_BAR; PG8_MMA(0, 0, At, B0); PG8_MMA(0, 1, At, B1); PG8_BAR; PG8_SCHED;
            PG8_LDA(At, 0, 1); PG8_STAGE(PG8_SB(0, 0), b2, voffB); PG8_STAGE(PG8_SB(0, 1), b2 + hstep, voffB); PG8_STAGE(PG8_SA(0, 0), a2, voffA);
            PG8_WAIT_V(8); PG8_WAIT_L(0); PG8_BAR; PG8_MMA(1, 0, At, B0); PG8_MMA(1, 1, At, B1); PG8_BAR; PG8_SCHED;
            PG8_LDB(B0, 1, 0); PG8_LDB(B1, 1, 1); PG8_SCHED; PG8_LDA(At, 1, 0); PG8_STAGE(PG8_SA(0, 1), a2 + hstep, voffA);
            PG8_WAIT_V(8); PG8_WAIT_L(0); PG8_BAR; PG8_MMA(0, 0, At, B0); PG8_MMA(0, 1, At, B1); PG8_BAR; PG8_SCHED;
            PG8_LDA(At, 1, 1); PG8_STAGE(PG8_SB(1, 0), b3, voffB); PG8_STAGE(PG8_SB(1, 1), b3 + hstep, voffB); PG8_STAGE(PG8_SA(1, 0), a3, voffA);
            PG8_WAIT_V(8); PG8_WAIT_L(0); PG8_BAR; PG8_MMA(1, 0, At, B0); PG8_MMA(1, 1, At, B1); PG8_BAR; PG8_SCHED;
            } else {
            PG8_LDB(B0, 0, 0); PG8_SCHED; PG8_LDA(At, 0, 0); PG8_STAGE(PG8_SA(1, 1), a1 + hstep, voffA);
            PG8_WAIT_L(8); PG8_BAR; PG8_WAIT_L(0); PG8_MMA(0, 0, At, B0); PG8_BAR; PG8_SCHED;
            PG8_LDB(B1, 0, 1); PG8_STAGE(PG8_SB(0, 0), b2, voffB);
            PG8_BAR; PG8_WAIT_L(0); PG8_MMA(0, 1, At, B1); PG8_BAR;
            PG8_LDA(At, 0, 1); PG8_STAGE(PG8_SA(0, 0), a2, voffA);
            PG8_BAR; PG8_WAIT_L(0); PG8_MMA(1, 0, At, B0); PG8_BAR; PG8_SCHED;
            PG8_STAGE(PG8_SB(0, 1), b2 + hstep, voffB);
            PG8_WAIT_V(6); PG8_BAR; PG8_MMA(1, 1, At, B1); PG8_BAR;
            PG8_LDB(B0, 1, 0); PG8_SCHED; PG8_LDA(At, 1, 0); PG8_STAGE(PG8_SA(0, 1), a2 + hstep, voffA);
            PG8_WAIT_L(8); PG8_BAR; PG8_WAIT_L(0); PG8_MMA(0, 0, At, B0); PG8_BAR; PG8_SCHED;
            PG8_LDB(B1, 1, 1); PG8_STAGE(PG8_SB(1, 0), b3, voffB);
            PG8_BAR; PG8_WAIT_L(0); PG8_MMA(0, 1, At, B1); PG8_BAR;
            PG8_LDA(At, 1, 1); PG8_STAGE(PG8_SA(1, 0), a3, voffA);
            PG8_BAR; PG8_WAIT_L(0); PG8_MMA(1, 0, At, B0); PG8_BAR; PG8_SCHED;
            PG8_STAGE(PG8_SB(1, 1), b3 + hstep, voffB);
            PG8_WAIT_V(6); PG8_BAR; PG8_MMA(1, 1, At, B1); PG8_BAR;
            }
        }
        if constexpr (ALIGN_EPI) { if (wr == 0) PG8_BAR; }
        if constexpr (!Epi::AFTER_DRAIN) { E(acc, cur, wr, wc, fr, fq); S.done(cur); }
        if (!has_next) break;
#pragma unroll
        for (int a = 0; a < 2; ++a)
#pragma unroll
            for (int b = 0; b < 2; ++b)
#pragma unroll
                for (int m = 0; m < 4; ++m)
#pragma unroll
                    for (int n = 0; n < 2; ++n) acc[a][b][m][n] = (f32x4){0.f, 0.f, 0.f, 0.f};
        cur = nxt; cA = nA; cB = nB; ++ui;
        if constexpr (ALIGN_EPI) { if (wr == 1) PG8_BAR; }
    }
    PG8_WAIT_V(0);
    if constexpr (!ALIGN_EPI) { if (wr == 0) PG8_BAR; }
    PG8_BAR;
    if constexpr (Epi::AFTER_DRAIN) { E.fused(acc, cur, wr, wc, fr, fq, lds, wid, lane); S.done(cur); }
#undef PG8_SA
#undef PG8_SB
#undef PG8_STAGE
#undef PG8_LDA
#undef PG8_LDB
#undef PG8_MMA
#undef PG8_WAIT_V
#undef PG8_WAIT_L
#undef PG8_BAR
#undef PG8_SCHED
}
}

#ifndef PG8_SP2
#define PG8_SP2 true
#endif
#ifndef PG8_ALIGN
#define PG8_ALIGN true
#endif
namespace attn_body {
using bf16=__hip_bfloat16;
using bf16x8=__attribute__((ext_vector_type(8)))short;
using s16x4=__attribute__((ext_vector_type(4)))short;
using f32x16=__attribute__((ext_vector_type(16)))float;
using u32x4=__attribute__((ext_vector_type(4)))unsigned;
constexpr int BATCH=4,NHEAD=8,SEQ=4096,D=64,DV=128,PIN=3072,POUT=1024;
constexpr int NW=8,QBLK=32,QB=QBLK*NW,KVBLK=64,NQB=SEQ/QB;
constexpr int ATTN_UNIT_ROWS=QB;
__device__ __forceinline__ int crow(int r,int hi){return (r&3)+8*(r>>2)+4*hi;}
#define SBAR() __builtin_amdgcn_sched_barrier(0)
__device__ __forceinline__ void cmask(f32x16&p0,f32x16&p1,int jb,int qrel,int hi){
  const float NEG=-INFINITY; int kb=64*jb+4*hi;
  #pragma unroll
  for(int r=0;r<16;++r){int kv=kb+(r&3)+8*(r>>2); if(kv>qrel)p0[r]=NEG; if(kv+32>qrel)p1[r]=NEG;}
}

constexpr int NSLOT=3, SLOTB=8192;
constexpr int LDS_K=0, LDS_V=NSLOT*SLOTB, LDS_WS=3*NSLOT*SLOTB, LDS_OST=LDS_WS+NW*64*4, LDS_BYTES=LDS_OST+NW*8192;
constexpr float C2=0.125f*1.4426950408889634f;
__device__ __forceinline__ void glds16(const void*gsrc,unsigned lds_dst){unsigned keep;
  asm volatile("s_mov_b32 %0, m0\n\ts_mov_b32 m0, %2\n\ts_nop 0\n\tglobal_load_lds_dwordx4 %1, off\n\ts_mov_b32 m0, %0":"=&s"(keep):"v"(gsrc),"s"(lds_dst):"memory");}
__device__ __forceinline__ float max3f(float a,float b,float c){float r;asm("v_max3_f32 %0, %1, %2, %3":"=v"(r):"v"(a),"v"(b),"v"(c));return r;}
__device__ __forceinline__ float max2f(float a,float b){float r;asm("v_max_f32_e32 %0, %1, %2":"=v"(r):"v"(a),"v"(b));return r;}
__device__ __forceinline__ float fadd_s(float a,float b){float r;asm("v_add_f32_e32 %0, %1, %2":"=v"(r):"v"(a),"v"(b));return r;}
__device__ __forceinline__ float fsub_s(float a,float b){float r;asm("v_sub_f32_e32 %0, %1, %2":"=v"(r):"v"(a),"v"(b));return r;}
typedef float f32x2_t __attribute__((ext_vector_type(2))); typedef __bf16 bf16x2_t __attribute__((ext_vector_type(2)));
__device__ __forceinline__ unsigned cvtpk_s(float lo,float hi){f32x2_t v={lo,hi};bf16x2_t b=__builtin_convertvector(v,bf16x2_t);return __builtin_bit_cast(unsigned,b);}
#define WAIT_BAR(N) asm volatile("s_waitcnt vmcnt(" #N ") lgkmcnt(0)\n\ts_barrier":::"memory")

__device__ __forceinline__ void qkt(f32x16&p0,f32x16&p1,const char*Kslot,const bf16x8*qr,const f32x16&negm,int r32,int hi){
  const char*kb=Kslot+hi*1024+r32*16;
  #pragma unroll
  for(int d0=0;d0<4;++d0){
    const bf16x8 b0=*reinterpret_cast<const bf16x8*>(kb+d0*2048);
    const bf16x8 b1=*reinterpret_cast<const bf16x8*>(kb+d0*2048+512);
    if(d0==0){p0=__builtin_amdgcn_mfma_f32_32x32x16_bf16(b0,qr[0],negm,0,0,0);p1=__builtin_amdgcn_mfma_f32_32x32x16_bf16(b1,qr[0],negm,0,0,0);}
    else{p0=__builtin_amdgcn_mfma_f32_32x32x16_bf16(b0,qr[d0],p0,0,0,0);p1=__builtin_amdgcn_mfma_f32_32x32x16_bf16(b1,qr[d0],p1,0,0,0);}}
}
typedef __attribute__((address_space(3))) const char* lds_cptr;
typedef short v4i16_t __attribute__((ext_vector_type(4)));
__device__ __forceinline__ void kload8(bf16x8*kf,lds_cptr kp){
  kf[0]=*(const __attribute__((address_space(3))) bf16x8*)(kp);      kf[1]=*(const __attribute__((address_space(3))) bf16x8*)(kp+512);
  kf[2]=*(const __attribute__((address_space(3))) bf16x8*)(kp+2048); kf[3]=*(const __attribute__((address_space(3))) bf16x8*)(kp+2560);
  kf[4]=*(const __attribute__((address_space(3))) bf16x8*)(kp+4096); kf[5]=*(const __attribute__((address_space(3))) bf16x8*)(kp+4608);
  kf[6]=*(const __attribute__((address_space(3))) bf16x8*)(kp+6144); kf[7]=*(const __attribute__((address_space(3))) bf16x8*)(kp+6656);
}
__device__ __forceinline__ void kload2(bf16x8*kf,lds_cptr kp,int j){ kf[2*j]=*(const __attribute__((address_space(3))) bf16x8*)(kp+j*2048); kf[2*j+1]=*(const __attribute__((address_space(3))) bf16x8*)(kp+j*2048+512); }
__device__ __forceinline__ s16x4 vtr(lds_cptr p){ return __builtin_bit_cast(s16x4,__builtin_amdgcn_ds_read_tr16_b64_v4i16((__attribute__((address_space(3))) v4i16_t*)p)); }
__device__ __forceinline__ float rowmax(const f32x16&p0,const f32x16&p1){
  float a=max3f(p0[0],p0[1],p1[0]),b=max3f(p0[2],p0[3],p1[1]);a=max3f(a,p1[2],p1[3]);
  #pragma unroll
  for(int r=4;r<16;r+=4){a=max3f(a,p0[r],p0[r+1]);b=max3f(b,p0[r+2],p0[r+3]);a=max3f(a,p1[r],p1[r+1]);b=max3f(b,p1[r+2],p1[r+3]);}
  const float m=max2f(a,b);
  auto rr=__builtin_amdgcn_permlane32_swap(__float_as_uint(m),__float_as_uint(m),false,false);
  return max2f(__uint_as_float(rr[0]),__uint_as_float(rr[1]));
}
__device__ __forceinline__ void pv(f32x16*o,int vb,bf16x8 pa0,bf16x8 pa1,bf16x8 pa2,bf16x8 pa3){
  #pragma unroll
  for(int d0=0;d0<4;++d0){s16x4 lo[4],hi[4];
    #pragma unroll
    for(int ks=0;ks<4;++ks){
      asm volatile("ds_read_b64_tr_b16 %0,%1 offset:%c2":"=&v"(lo[ks]):"v"(vb),"i"(d0*4096+ks*1024):"memory");
      asm volatile("ds_read_b64_tr_b16 %0,%1 offset:%c2":"=&v"(hi[ks]):"v"(vb),"i"(d0*4096+ks*1024+512):"memory");}
    asm volatile("s_waitcnt lgkmcnt(0)":::"memory");SBAR();
    #define PK(k) (bf16x8){lo[k][0],lo[k][1],lo[k][2],lo[k][3],hi[k][0],hi[k][1],hi[k][2],hi[k][3]}
    o[d0]=__builtin_amdgcn_mfma_f32_32x32x16_bf16(pa0,PK(0),o[d0],0,0,0);
    o[d0]=__builtin_amdgcn_mfma_f32_32x32x16_bf16(pa1,PK(1),o[d0],0,0,0);
    o[d0]=__builtin_amdgcn_mfma_f32_32x32x16_bf16(pa2,PK(2),o[d0],0,0,0);
    o[d0]=__builtin_amdgcn_mfma_f32_32x32x16_bf16(pa3,PK(3),o[d0],0,0,0);
    #undef PK
  }
}

#ifndef ATTN_STORE16
#define ATTN_STORE16(p,v) (*(u32x4*)(p)=(v))
#endif
template<int THRL> __device__ __forceinline__ void attn_unit(int b,int vh,int qb,const bf16*P,bf16*O,char*shm){
  int tid_=threadIdx.x; asm volatile("":"+v"(tid_)); const int tid=tid_,lane=tid&63,r32=lane&31,hi=lane>>5; const int wid=__builtin_amdgcn_readfirstlane(tid>>6);
  const long rowbase=(long)b*SEQ; const int q0=qb*QB;
  const bf16*Qw=P+(rowbase+q0+wid*QBLK)*PIN+vh*D;
  const bf16*Kh=P+rowbase*PIN+512+vh*D,*Vh=P+rowbase*PIN+1024+(vh>>1)*DV;
  const unsigned lds0=(unsigned)(uintptr_t)shm;
  float*wsf=(float*)(shm+LDS_WS)+wid*64;
  const bf16*ksrc=Kh+(long)lane*PIN+wid*8;
  const bf16*vsrc=Vh+(long)(16*(wid&3)+(lane>>2))*PIN+(wid>>2)*32+(lane&3)*8;
  const unsigned kdst=lds0+LDS_K+wid*1024, vdst=lds0+LDS_V+wid*1024;
  #define DMA_K(t,slot) glds16(ksrc+(long)(t)*KVBLK*PIN,(unsigned)__builtin_amdgcn_readfirstlane(kdst+(slot)))
  #define DMA_V(t,slot) do{ glds16(vsrc+(long)(t)*KVBLK*PIN,(unsigned)__builtin_amdgcn_readfirstlane(vdst+2*(slot))); glds16(vsrc+(long)(t)*KVBLK*PIN+64,(unsigned)__builtin_amdgcn_readfirstlane(vdst+2*(slot)+8192)); }while(0)
  const int vb0=(int)(lds0+LDS_V)+((lane>>4)&1)*32+(lane&3)*8+(4*hi+((lane&15)>>2))*64;
  const char*Kbase=shm+LDS_K; bf16x8 kf[8];
  const lds_cptr shm3=(lds_cptr)shm; const lds_cptr kp0=shm3+LDS_K+hi*1024+r32*16; const lds_cptr vp0=shm3+LDS_V+((lane>>4)&1)*32+(lane&3)*8+(4*hi+((lane&15)>>2))*64;
  const int NT=(q0+QB)/KVBLK;
  DMA_K(0,0);DMA_V(0,0);DMA_K(1,SLOTB);
  bf16x8 qr[4];
  #pragma unroll
  for(int d0=0;d0<4;++d0)qr[d0]=*reinterpret_cast<const bf16x8*>(&Qw[(long)r32*PIN+d0*16+hi*8]);
  float mhat=0.f,l_reg=0.f;f32x16 o[4];o[0]=f32x16{};o[1]=f32x16{};o[2]=f32x16{};o[3]=f32x16{};f32x16 negm;{float nz_=0.f;asm volatile("":"+v"(nz_));_Pragma("unroll") for(int r=0;r<16;++r)negm[r]=nz_;}asm volatile("":"+v"(negm));
  const int qrel=wid*QBLK+r32;
  #define CMASK(P0,P1,t) do{int jb_=(t)-(NT-4); if(jb_>=0)cmask(P0,P1,jb_,qrel,hi);}while(0)
  bool resc=false;
  #define START(P0,P1) do{ const float rm=rowmax(P0,P1); resc=false; \
    { const float dl=rm; mhat=fadd_s(mhat,dl); \
      _Pragma("unroll") for(int r=0;r<16;++r){P0[r]=fsub_s(P0[r],dl);P1[r]=fsub_s(P1[r],dl);} \
      _Pragma("unroll") for(int r=0;r<16;++r)negm[r]=-mhat; asm volatile("":"+v"(negm)); } \
    _Pragma("unroll") for(int r=0;r<16;++r)P0[r]=__builtin_amdgcn_exp2f(P0[r]); }while(0)
  #define RESC() do{ if(resc){ asm volatile("s_waitcnt lgkmcnt(0)":::"memory"); \
      _Pragma("unroll") for(int d_=0;d_<4;++d_) _Pragma("unroll") for(int r=0;r<16;++r)o[d_][r]*=wsf[crow(r,hi)]; } }while(0)
  f32x16 pA0,pA1,pB0,pB1;
  int sl_prev=0,sl_cur=0,sl_next=SLOTB;
  #define ROT() do{sl_prev=sl_cur;sl_cur=sl_next;sl_next=(sl_next==(NSLOT-1)*SLOTB)?0:sl_next+SLOTB;}while(0)
  DMA_K(2,2*SLOTB);
  WAIT_BAR(3);
  qkt(pA0,pA1,Kbase,qr,negm,r32,hi);asm volatile("s_nop 15\n\ts_nop 7":"+v"(pA0),"+v"(pA1));CMASK(pA0,pA1,0);
  START(pA0,pA1);
  _Pragma("unroll") for(int r=0;r<16;++r)pA1[r]=__builtin_amdgcn_exp2f(pA1[r]);
  WAIT_BAR(0);
  DMA_K(3,0);DMA_V(1,SLOTB);
  ROT();
  kload8(kf,kp0+sl_cur);
  WAIT_BAR(3);
  s16x4 vlo[4],vhi[4]; u32x4 pw0,pw1,pw2,pw3;
  #define PKW(P,B) cvtpk_s(P[B],P[B+1])
  #define PAF(k) __builtin_bit_cast(bf16x8,pw##k)
  #define VFR(i) (bf16x8){vlo[i][0],vlo[i][1],vlo[i][2],vlo[i][3],vhi[i][0],vhi[i][1],vhi[i][2],vhi[i][3]}
  #define PIN(x) asm volatile("":"+v"(x))
  #define MX3(a,b,c) __builtin_fmaxf(__builtin_fmaxf((a),(b)),(c))
  #define GAPA(MF,A0,A1,A2,A3,W0,W1,PW) do{ MF; sacc+=A0; sacc+=A1; sacc+=A2; sacc+=A3; PIN(sacc); W0; W1; PIN(PW); SBAR(); }while(0)
  #define EX(v) __builtin_amdgcn_exp2f(v)
  #define VRD(dq,ks) do{ vlo[dq]=vtr(vp_+((dq)*4096+(ks)*1024)); vhi[dq]=vtr(vp_+((dq)*4096+(ks)*1024+512)); }while(0)
  #define GAPB(DQ,KS,X,B) do{ o[DQ]=__builtin_amdgcn_mfma_f32_32x32x16_bf16(PAF(KS),VFR(DQ),o[DQ],0,0,0); if((KS)<3){ VRD(DQ,(KS)+1); } X[B]=EX(X[B]); X[B+1]=EX(X[B+1]); PIN(X); SBAR(); }while(0)
  #define KRD(G,j) do{ if(G){ kload2(kf,kp0+sl_next,j); SBAR(); } }while(0)
  #define STEP(C0,C1,P0,P1,t,GK,GV,GL) do{ SBAR(); \
    const lds_cptr vp_=vp0+2*sl_prev; \
    float sacc=(P0[0]+P0[1]); \
    GAPA(C0=__builtin_amdgcn_mfma_f32_32x32x16_bf16(kf[0],qr[0],negm,0,0,0), P0[2],P0[3],P0[4],P0[5],     pw0[0]=PKW(P0,0), pw0[1]=PKW(P0,2), pw0); \
    GAPA(C1=__builtin_amdgcn_mfma_f32_32x32x16_bf16(kf[1],qr[0],negm,0,0,0), P0[6],P0[7],P0[8],P0[9],     pw0[2]=PKW(P0,4), pw0[3]=PKW(P0,6), pw0); \
    GAPA(C0=__builtin_amdgcn_mfma_f32_32x32x16_bf16(kf[2],qr[1],C0,0,0,0),   P0[10],P0[11],P0[12],P0[13], pw1[0]=PKW(P0,8), pw1[1]=PKW(P0,10), pw1); \
    GAPA(C1=__builtin_amdgcn_mfma_f32_32x32x16_bf16(kf[3],qr[1],C1,0,0,0),   P0[14],P0[15],P1[0],P1[1],   pw1[2]=PKW(P0,12),pw1[3]=PKW(P0,14), pw1); \
    VRD(0,0); SBAR(); GAPA(C0=__builtin_amdgcn_mfma_f32_32x32x16_bf16(kf[4],qr[2],C0,0,0,0),   P1[2],P1[3],P1[4],P1[5],     pw2[0]=PKW(P1,0), pw2[1]=PKW(P1,2), pw2); \
    VRD(1,0); SBAR(); GAPA(C1=__builtin_amdgcn_mfma_f32_32x32x16_bf16(kf[5],qr[2],C1,0,0,0),   P1[6],P1[7],P1[8],P1[9],     pw2[2]=PKW(P1,4), pw2[3]=PKW(P1,6), pw2); \
    VRD(2,0); SBAR(); GAPA(C0=__builtin_amdgcn_mfma_f32_32x32x16_bf16(kf[6],qr[3],C0,0,0,0),   P1[10],P1[11],P1[12],P1[13], pw3[0]=PKW(P1,8), pw3[1]=PKW(P1,10), pw3); \
    VRD(3,0); SBAR(); GAPA(C1=__builtin_amdgcn_mfma_f32_32x32x16_bf16(kf[7],qr[3],C1,0,0,0),   P1[14],P1[15],0.f,0.f,       pw3[2]=PKW(P1,12),pw3[3]=PKW(P1,14), pw3); \
    l_reg+=sacc; \
    if(GK){DMA_K((t)+3,sl_cur);} if(GV){DMA_V((t)+1,sl_next);} \
    CMASK(C0,C1,t); \
    { float a=MX3(C0[0],C0[1],C1[0]),b=MX3(C0[2],C0[3],C1[1]); a=MX3(a,C1[2],C1[3]); \
      _Pragma("unroll") for(int r=4;r<16;r+=4){a=MX3(a,C0[r],C0[r+1]);b=MX3(b,C0[r+2],C0[r+3]);a=MX3(a,C1[r],C1[r+1]);b=MX3(b,C1[r+2],C1[r+3]);} \
      float rm=__builtin_fmaxf(a,b); { auto rr=__builtin_amdgcn_permlane32_swap(__float_as_uint(rm),__float_as_uint(rm),false,false); rm=__builtin_fmaxf(__uint_as_float(rr[0]),__uint_as_float(rr[1])); } \
      resc=false; \
      if(__builtin_expect(__any(rm>(float)THRL),0)){ const float dl=__builtin_fmaxf(rm,0.f); mhat+=dl; \
        _Pragma("unroll") for(int r=0;r<16;++r){C0[r]-=dl;C1[r]-=dl;} \
        _Pragma("unroll") for(int r=0;r<16;++r)negm[r]=-mhat; asm volatile("":"+v"(negm)); \
        const float f=__builtin_amdgcn_exp2f(-dl); l_reg*=f; if(hi==0)wsf[r32]=f; resc=true; } } \
    SBAR(); \
    GAPB(0,0,C0,0);  GAPB(1,0,C0,2);  GAPB(2,0,C0,4);  GAPB(3,0,C0,6); \
    KRD(GL,0); GAPB(0,1,C0,8);  GAPB(1,1,C0,10); KRD(GL,1); GAPB(2,1,C0,12); GAPB(3,1,C0,14); \
    KRD(GL,2); GAPB(0,2,C1,0);  GAPB(1,2,C1,2);  KRD(GL,3); GAPB(2,2,C1,4);  GAPB(3,2,C1,6); \
    GAPB(0,3,C1,8);  GAPB(1,3,C1,10); GAPB(2,3,C1,12); GAPB(3,3,C1,14); \
    }while(0)
  int t=1;
  #undef CMASK
  #define CMASK(P0,P1,t) do{}while(0)
  for(;t+5<NT;t+=2){
    STEP(pB0,pB1,pA0,pA1,t,true,true,true);     WAIT_BAR(3); RESC(); ROT();
    STEP(pA0,pA1,pB0,pB1,t+1,true,true,true);   WAIT_BAR(3); RESC(); ROT();
  }
  #undef CMASK
  #define CMASK(P0,P1,t) do{int jb_=(t)-(NT-4); if(jb_>=0)cmask(P0,P1,jb_,qrel,hi);}while(0)
  #define ENDW(tt) do{ if((tt)+3<NT){WAIT_BAR(3);} else if((tt)+2<NT){WAIT_BAR(2);} else {WAIT_BAR(0);} }while(0)
  for(;t+1<NT;t+=2){
    STEP(pB0,pB1,pA0,pA1,t,(t+3<NT),(t+1<NT),(t+1<NT));       ENDW(t);   RESC(); ROT();
    STEP(pA0,pA1,pB0,pB1,t+1,(t+4<NT),(t+2<NT),(t+2<NT));     ENDW(t+1); RESC(); ROT();
  }
  STEP(pB0,pB1,pA0,pA1,NT-1,false,false,false); RESC();
  { float sacc=pB0[0]+pB0[1]; _Pragma("unroll") for(int r=2;r<16;++r)sacc+=pB0[r]; _Pragma("unroll") for(int r=0;r<16;++r)sacc+=pB1[r]; l_reg+=sacc;
    pw0=(u32x4){PKW(pB0,0),PKW(pB0,2),PKW(pB0,4),PKW(pB0,6)};pw1=(u32x4){PKW(pB0,8),PKW(pB0,10),PKW(pB0,12),PKW(pB0,14)};pw2=(u32x4){PKW(pB1,0),PKW(pB1,2),PKW(pB1,4),PKW(pB1,6)};pw3=(u32x4){PKW(pB1,8),PKW(pB1,10),PKW(pB1,12),PKW(pB1,14)};
    SBAR(); pv(o,vb0+2*sl_cur,PAF(0),PAF(1),PAF(2),PAF(3)); }
  #undef PKW
  #undef PAF
  #undef VFR
  #undef PIN
  #undef MX3
  #undef GAPA
  #undef GAPB
  #undef EX
  #undef VRD
  #undef KRD
  #undef STEP
  #undef ENDW
  {auto rr=__builtin_amdgcn_permlane32_swap(__float_as_uint(l_reg),__float_as_uint(l_reg),false,false);l_reg=__uint_as_float(rr[0])+__uint_as_float(rr[1]);}
  if(hi==0)wsf[32+r32]=l_reg;asm volatile("s_waitcnt lgkmcnt(0)":::"memory");
  float rli[16];
  #pragma unroll
  for(int r=0;r<16;++r)rli[r]=__builtin_amdgcn_rcpf(wsf[32+crow(r,hi)]);
  bf16*Ow=O+(rowbase+q0+wid*QBLK)*POUT+vh*DV;
  { bf16*stg=(bf16*)(shm+LDS_OST)+wid*4096;
    #pragma unroll
    for(int r=0;r<16;++r){const int orow=crow(r,hi);
      #pragma unroll
      for(int d0=0;d0<4;++d0)stg[orow*128+d0*32+r32]=__float2bfloat16(o[d0][r]*rli[r]);}
    asm volatile("s_waitcnt lgkmcnt(0)":::"memory");
    #pragma unroll
    for(int i=0;i<8;++i){const int row=i*4+(lane>>4),ch=lane&15; const u32x4 v=*(const u32x4*)(stg+row*128+ch*8); ATTN_STORE16(Ow+(long)row*POUT+ch*8,v);} }
  asm volatile("s_waitcnt lgkmcnt(0)\n\ts_barrier":::"memory");
  #undef DMA_K
  #undef DMA_V
  #undef CMASK
  #undef START
  #undef RESC
  #undef ROT
}
constexpr int ATTN_LDS_BYTES=LDS_BYTES;
struct AttnUnit { int bh; int qb; };
struct StaticOrder {
  int vcu;
  __device__ __forceinline__ explicit StaticOrder(int grid,int block):vcu((block%8)*(grid/8)+block/8){}
  __device__ __forceinline__ bool next(int i,AttnUnit&u)const{ if(i>=2)return false; const int s=vcu&7; u.bh=vcu>>3; u.qb=(i==0)?15-s:s; return true; }
};
template<class Sched,int THRL=8> __device__ __forceinline__ void attn_phase(char*lds,const bf16*P,bf16*O,const Sched&S){
  AttnUnit u;
  for(int i=0;S.next(i,u);++i){ attn_unit<THRL>(u.bh/NHEAD,u.bh%NHEAD,u.qb,P,O,lds); }
}
#undef SBAR
#undef WAIT_BAR
}
constexpr int NWAVES = 8;
constexpr int NB = 4, SEQ = 4096, D = 1024, T = NB * SEQ, NPROJ = 3072, NE = 256, FF = 256, KSEL = 8, NSLOT9 = 9;
constexpr float NORM_EPS = 1e-6f;
constexpr size_t MiB = 1u << 20;
constexpr size_t WS_CTL = 0, CTL_ZERO_BYTES = 65536;
constexpr size_t WS_MOD = 1 * MiB;
constexpr size_t WS_COS = 2 * MiB, WS_SIN = 4 * MiB;
constexpr size_t WS_WIN = 6 * MiB, WS_WOUT = 12 * MiB, WS_WR = 14 * MiB;
constexpr size_t WS_XN = 16 * MiB;
constexpr size_t WS_PROJ = 48 * MiB;
constexpr size_t WS_SVT = 144 * MiB;
constexpr size_t WS_ORAW = 160 * MiB;
constexpr size_t WS_MIXED = 192 * MiB;
constexpr size_t WS_R = 224 * MiB;
constexpr size_t WS_LTOK = 304 * MiB, WS_LW = 321 * MiB;
constexpr size_t WS_H2 = 338 * MiB;
constexpr size_t WS_ACT = 372 * MiB;
constexpr size_t WS_Y = 416 * MiB;
constexpr size_t WS_END = WS_Y + (size_t)T * NSLOT9 * D * 2;
constexpr int CW_QUEUE = 8192;
constexpr int CW_COUNT = 1024;
constexpr int CW_BAR = 4096;
constexpr int RING_OFF = 0, RING_BYTES = 151552;
constexpr int LDSCTL_OFF = RING_BYTES, MISC_OFF = LDSCTL_OFF + 320;
constexpr int LDS_BYTES = 152576;
static_assert(MISC_OFF + 128 <= LDS_BYTES, "LDS map");

#define GAS __attribute__((address_space(1)))
#define LAS __attribute__((address_space(3)))
typedef unsigned short bf16;
typedef unsigned v4u __attribute__((ext_vector_type(4)));
typedef unsigned v2u __attribute__((ext_vector_type(2)));
typedef float f32x4 __attribute__((ext_vector_type(4)));
typedef float f32x16 __attribute__((ext_vector_type(16)));
typedef short bf16x8 __attribute__((ext_vector_type(8)));
typedef GAS unsigned gu32;
#define RLX_AGENT __ATOMIC_RELAXED, __HIP_MEMORY_SCOPE_AGENT
#define LDS_WAIT() asm volatile("s_waitcnt lgkmcnt(0)" ::: "memory")
#define VM_WAIT() asm volatile("s_waitcnt vmcnt(0)" ::: "memory")
__device__ __forceinline__ unsigned pk2(float lo, float hi) { return pg8::cvt_pk_bf16(lo, hi); }
__device__ __forceinline__ float bflo(unsigned w) { return __uint_as_float(w << 16); }
__device__ __forceinline__ float bfhi(unsigned w) { return __uint_as_float(w & 0xffff0000u); }

#define XB_TMO      128
#define XB_XCNT(j)  (256  + 64 * (j))
#define XB_XSUB(j)  (1280 + 64 * (j))
#define XB_XGEN(j)  (2304 + 64 * (j))
#define XB_TOP      3328
#define XB_TOPGEN   3392
#define XCD_BAR_WORDS 3456
#define XB_SPIN_CAP (1u << 18)

__device__ __forceinline__ unsigned xb_ld(unsigned* p)              { return __hip_atomic_load(p, __ATOMIC_RELAXED, __HIP_MEMORY_SCOPE_AGENT); }
__device__ __forceinline__ unsigned xb_add(unsigned* p, unsigned v) { return __hip_atomic_fetch_add(p, v, __ATOMIC_RELAXED, __HIP_MEMORY_SCOPE_AGENT); }
__device__ __forceinline__ unsigned xb_xcc_id() { return (unsigned)__builtin_amdgcn_s_getreg((3 << 11) | 20) & 0xFu; }
#define XB_SPIN(cond, bar) do { unsigned _sp = 0; while (cond) { __builtin_amdgcn_s_sleep(1); \
    if ((++_sp & 255u) == 0u) { if (xb_ld(&(bar)[XB_TMO])) break; if (_sp > XB_SPIN_CAP) { atomicAdd(&(bar)[XB_TMO], 1u); break; } } } } while (0)

struct XcdBarrier {
    unsigned* bar; unsigned x;
    volatile LAS unsigned* st;
};

__device__ __forceinline__ XcdBarrier xcd_barrier_post(unsigned* bar, volatile LAS unsigned* st) {
    XcdBarrier b; b.bar = bar; b.x = xb_xcc_id(); b.st = st;
    if (threadIdx.x == 0) (void)xb_add(&bar[XB_XCNT(b.x)], 1u);
    return b;
}
__device__ __forceinline__ void xcd_barrier_complete(unsigned* bar, unsigned x, unsigned& nloc, unsigned& nx) {
    const unsigned G = gridDim.x * gridDim.y * gridDim.z;
    unsigned sum, cnt, mine, sp = 0u;
    for (;;) {
        sum = 0u; cnt = 0u; mine = 0u;
#pragma unroll
        for (unsigned j = 0; j < 16; ++j) { const unsigned c = xb_ld(&bar[XB_XCNT(j)]); sum += c; cnt += (c > 0u) ? 1u : 0u; mine = (j == x) ? c : mine; }
        if (sum == G) break;
        __builtin_amdgcn_s_sleep(1);
        if ((++sp & 255u) == 0u) { if (xb_ld(&bar[XB_TMO])) break; if (sp > XB_SPIN_CAP) { atomicAdd(&bar[XB_TMO], 1u); break; } }
    }
    nloc = mine > 0u ? mine : 1u; nx = cnt > 0u ? cnt : 1u;
}

__device__ __forceinline__ void xcd_barrier(const XcdBarrier& b) {
    asm volatile("s_waitcnt vmcnt(0)" ::: "memory");
    __syncthreads();
    if (threadIdx.x == 0) {
        unsigned* bar = b.bar;
        __builtin_amdgcn_s_waitcnt(0);
        unsigned nloc = b.st[0], nx = b.st[1];
        if (nloc == 0u) { xcd_barrier_complete(bar, b.x, nloc, nx); b.st[0] = nloc; b.st[1] = nx; }
        const unsigned old = xb_add(&bar[XB_XSUB(b.x)], 1u);
        const unsigned gen = old / nloc;
        if (old + 1u == (gen + 1u) * nloc) {
            __builtin_amdgcn_fence(__ATOMIC_RELEASE, "agent");
            asm volatile("s_waitcnt vmcnt(0)" ::: "memory");
            const unsigned og = xb_add(&bar[XB_TOP], 1u);
            const unsigned tg = og / nx;
            if (og + 1u == (tg + 1u) * nx) xb_add(&bar[XB_TOPGEN], 1u);
            else XB_SPIN(xb_ld(&bar[XB_TOPGEN]) == tg, bar);
            __builtin_amdgcn_fence(__ATOMIC_ACQUIRE, "agent");
            xb_add(&bar[XB_XGEN(b.x)], 1u);
            asm volatile("s_waitcnt vmcnt(0)" ::: "memory");
        } else {
            XB_SPIN(xb_ld(&bar[XB_XGEN(b.x)]) == gen, bar);
            __builtin_amdgcn_fence(__ATOMIC_ACQUIRE, "agent");
            asm volatile("s_waitcnt vmcnt(0)" ::: "memory");
        }
    }
    __syncthreads();
}


struct Frame {
    LAS unsigned char* lds;
    volatile LAS unsigned* MISC;
    unsigned* ctl;
    int tid, lane, wave;
    int vcu, G;
    const float *x, *c, *w_ada, *b_ada, *g_mix, *w_in, *g_q, *g_k, *lam, *g_sub, *w_out, *g_ffn, *w_router, *e_bias, *w_sh_gu, *w_sh_down, *w_gu, *w_down;
    const int* positions;
    float* out;
    float *MOD, *RCOS, *RSIN, *LW;
    bf16 *WIN, *WOUT, *WR, *XN, *PROJ, *SVT, *ORAW, *MIXED, *H2, *Y, *ACT, *DLT;
    unsigned* LTOK;
};
__device__ __forceinline__ float wave_sum(float v) {
#pragma unroll
    for (int o = 1; o < 64; o <<= 1) v += __shfl_xor(v, o);
    return v;
}
__device__ __forceinline__ float wave_max(float v) {
#pragma unroll
    for (int o = 1; o < 64; o <<= 1) v = fmaxf(v, __shfl_xor(v, o));
    return v;
}
__device__ __forceinline__ void p0_transpose_item(const float* W, int K, int N, bf16* WT, int k0, int n0, int dst_row0, LAS float* scr, int lane) {
#pragma unroll 8
    for (int i = 0; i < 32; ++i) { const int kk = 2 * i + (lane >> 5); scr[kk * 33 + (lane & 31)] = W[(size_t)(k0 + kk) * N + n0 + (lane & 31)]; }
    LDS_WAIT(); asm volatile("" ::: "memory");
    const int c = lane & 7;
#pragma unroll
    for (int j = 0; j < 4; ++j) { const int n = (lane >> 3) + 8 * j; const LAS float* s = scr + (8 * c) * 33 + n;
        v4u o; o.x = pk2(s[0 * 33], s[1 * 33]); o.y = pk2(s[2 * 33], s[3 * 33]); o.z = pk2(s[4 * 33], s[5 * 33]); o.w = pk2(s[6 * 33], s[7 * 33]);
        *(GAS v4u*)(WT + (size_t)(dst_row0 + n) * K + k0 + 8 * c) = o; }
    LDS_WAIT(); asm volatile("" ::: "memory");
}
__device__ __forceinline__ void p0_prologue(Frame& F) {
    LAS float* sc = (LAS float*)(F.lds + RING_OFF);
    LAS float* red = (LAS float*)(F.lds + RING_OFF + 16384);
    if (F.vcu < 192) {
        for (int i = F.tid; i < NB * D; i += NWAVES * 64) { const float v = F.c[i]; sc[i] = v / (1.0f + __expf(-v)); }
        __syncthreads();
        const int kr = F.lane >> 3, ch = F.lane & 7, n0 = 32 * F.vcu + 4 * ch;
        float a[4][4];
#pragma unroll
        for (int b = 0; b < 4; ++b)
#pragma unroll
            for (int j = 0; j < 4; ++j) a[b][j] = 0.f;
#pragma unroll 4
        for (int it = 0; it < 16; ++it) { const int k = 128 * F.wave + 8 * it + kr; const f32x4 wv = *(const f32x4*)(F.w_ada + (size_t)k * 6144 + n0);
#pragma unroll
            for (int b = 0; b < 4; ++b) { const float s = sc[b * D + k];
#pragma unroll
                for (int j = 0; j < 4; ++j) a[b][j] += s * wv[j]; } }
#pragma unroll
        for (int b = 0; b < 4; ++b)
#pragma unroll
            for (int j = 0; j < 4; ++j) { float v = a[b][j]; v += __shfl_xor(v, 8); v += __shfl_xor(v, 16); v += __shfl_xor(v, 32); a[b][j] = v; }
        if (kr == 0) {
#pragma unroll
            for (int b = 0; b < 4; ++b)
#pragma unroll
                for (int j = 0; j < 4; ++j) red[(F.wave * 4 + b) * 32 + 4 * ch + j] = a[b][j]; }
        __syncthreads();
        if (F.tid < 128) { const int b = F.tid >> 5, col = F.tid & 31; float s = F.b_ada[32 * F.vcu + col];
#pragma unroll
            for (int w = 0; w < 8; ++w) s += red[(w * 4 + b) * 32 + col];
            F.MOD[b * 6144 + 32 * F.vcu + col] = s; }
        __syncthreads();
    }
    LAS float* scr = (LAS float*)(F.lds + RING_OFF + 32768 + F.wave * 9216);
    const int gw = F.vcu * NWAVES + F.wave, NGW = F.G * NWAVES;
    constexpr int I_IN = (D / 64) * (NPROJ / 32), I_OUT = (D / 64) * (D / 32), I_R = (D / 64) * (NE / 32);
    for (int it = gw; it < I_IN + I_OUT + I_R; it += NGW) {
        int r = it;
        if (r < I_IN) { const int nblk = NPROJ / 32, kb = r / nblk, nb = r % nblk, n0 = 32 * nb;
            const int cl = n0 & 255, dst = (n0 & ~255) + 128 * ((cl >> 5) & 1) + 32 * (cl >> 6);
            p0_transpose_item(F.w_in, D, NPROJ, F.WIN, 64 * kb, n0, dst, scr, F.lane); continue; }
        r -= I_IN;
        if (r < I_OUT) { const int nblk = D / 32, kb = r / nblk, nb = r % nblk; p0_transpose_item(F.w_out, D, D, F.WOUT, 64 * kb, 32 * nb, 32 * nb, scr, F.lane); continue; }
        r -= I_OUT;
        { const int nblk = NE / 32, kb = r / nblk, nb = r % nblk; p0_transpose_item(F.w_router, D, NE, F.WR, 64 * kb, 32 * nb, 32 * nb, scr, F.lane); }
    }
    for (int idx = (int)blockIdx.x * (NWAVES * 64) + F.tid; idx < T * 32; idx += F.G * NWAVES * 64) {
        const int t = idx >> 5, i = idx & 31;
        const float inv = exp2f(-(float)i * (13.287712379549449f / 32.0f));
        const float ang = (float)F.positions[t] * inv;
        F.RCOS[idx] = cosf(ang); F.RSIN[idx] = sinf(ang);
    }
}
__device__ __forceinline__ void rows_adaln(Frame& F, const float* src, const float* g, const float* shift, const float* scale, bf16* dst) {
    const int gw = F.vcu * NWAVES + F.wave, NGW = F.G * NWAVES;
    for (int m = gw; m < T; m += NGW) {
        const int b = m >> 12;
        const GAS f32x4* xr = (const GAS f32x4*)(src + (size_t)m * D) + F.lane;
        f32x4 v[4]; float s2 = 0.f;
#pragma unroll
        for (int j = 0; j < 4; ++j) { v[j] = xr[64 * j]; s2 += (v[j].x * v[j].x + v[j].y * v[j].y) + (v[j].z * v[j].z + v[j].w * v[j].w); }
        const float rstd = 1.f / sqrtf(wave_sum(s2) * (1.f / D) + NORM_EPS);
        GAS v2u* o8 = (GAS v2u*)(dst + (size_t)m * D) + F.lane;
#pragma unroll
        for (int j = 0; j < 4; ++j) { const int c = 4 * F.lane + 256 * j;
            const f32x4 gv = *(const f32x4*)(g + c), sh = *(const f32x4*)(shift + b * 6144 + c), sc = *(const f32x4*)(scale + b * 6144 + c);
            const f32x4 y = v[j] * rstd * gv * (sc + 1.0f) + sh;
            v2u w; w.x = pk2(y.x, y.y); w.y = pk2(y.z, y.w); o8[64 * j] = w; }
    }
}
constexpr float SB_EXIT_LOG2 = 48.0f;
__device__ __forceinline__ int crow16(int r, int h) { return (r & 3) + 8 * (r >> 2) + 4 * h; }
__device__ __forceinline__ void sb_wave_tile(const bf16* PROJ, const bf16* SVT, bf16* MIXED, int b, int hd, int qt, int lane) {
    const int r32 = lane & 31, hi = lane >> 5;
    const bf16* Qp = PROJ + (size_t)(b * SEQ + 32 * qt + r32) * NPROJ + 1536 + hd * 64 + 8 * hi;
    bf16x8 qf[4];
#pragma unroll
    for (int s = 0; s < 4; ++s) qf[s] = *(const bf16x8*)(Qp + 16 * s);
    bf16x8 tf[2];
#pragma unroll
    for (int s = 0; s < 2; ++s)
#pragma unroll
        for (int j = 0; j < 8; ++j) tf[s][j] = (16 * s + 8 * (j >> 2) + 4 * hi + (j & 3)) >= r32 ? (short)0x3F80 : (short)0;
    f32x16 oT[2];
#pragma unroll
    for (int i = 0; i < 16; ++i) { oT[0][i] = 0.f; oT[1][i] = 0.f; }
    float R = 0.f;
    const bf16* Kb = PROJ + (size_t)(b * SEQ + r32) * NPROJ + 2048 + hd * 64 + 8 * hi;
    const bf16* Vb = SVT + ((size_t)(b * 8 + hd) * 64 + r32) * SEQ + 4 * hi;
    for (int kt = qt; kt >= 0; --kt) {
        const bf16* Kp = Kb + (size_t)(32 * kt) * NPROJ;
        bf16x8 kf[4];
#pragma unroll
        for (int s = 0; s < 4; ++s) kf[s] = *(const bf16x8*)(Kp + 16 * s);
        v2u vlo[2][2], vhi[2][2];
#pragma unroll
        for (int dt = 0; dt < 2; ++dt)
#pragma unroll
            for (int s = 0; s < 2; ++s) { const bf16* vp = Vb + (size_t)(32 * dt) * SEQ + 32 * kt + 16 * s; vlo[dt][s] = *(const v2u*)vp; vhi[dt][s] = *(const v2u*)(vp + 8); }
        f32x16 z;
#pragma unroll
        for (int i = 0; i < 16; ++i) z[i] = 0.f;
#pragma unroll
        for (int s = 0; s < 4; ++s) z = __builtin_amdgcn_mfma_f32_32x32x16_bf16(kf[s], qf[s], z, 0, 0, 0);
        const bool diag = (kt == qt);
        float sp[16];
#pragma unroll
        for (int i = 0; i < 16; ++i) { const float zz = z[i]; float v = fmaxf(zz, 0.f) + __builtin_amdgcn_logf(1.0f + __builtin_amdgcn_exp2f(-fabsf(zz)));
            if (diag && crow16(i, hi) >= r32) v = 0.f; sp[i] = v; }
        v4u p0, p1; p0.x = pk2(sp[0], sp[1]); p0.y = pk2(sp[2], sp[3]); p0.z = pk2(sp[4], sp[5]); p0.w = pk2(sp[6], sp[7]);
        p1.x = pk2(sp[8], sp[9]); p1.y = pk2(sp[10], sp[11]); p1.z = pk2(sp[12], sp[13]); p1.w = pk2(sp[14], sp[15]);
        f32x16 cs;
#pragma unroll
        for (int i = 0; i < 16; ++i) cs[i] = R;
        cs = __builtin_amdgcn_mfma_f32_32x32x16_bf16(tf[0], __builtin_bit_cast(bf16x8, p0), cs, 0, 0, 0);
        cs = __builtin_amdgcn_mfma_f32_32x32x16_bf16(tf[1], __builtin_bit_cast(bf16x8, p1), cs, 0, 0, 0);
        float w[16];
#pragma unroll
        for (int i = 0; i < 16; ++i) { float v = __builtin_amdgcn_exp2f(z[i] - cs[i]); if (diag && crow16(i, hi) >= r32) v = 0.f; w[i] = v; }
        R = __shfl(cs[0], r32);
        const bool done_ = __all(R > SB_EXIT_LOG2) != 0;
        v4u w0, w1; w0.x = pk2(w[0], w[1]); w0.y = pk2(w[2], w[3]); w0.z = pk2(w[4], w[5]); w0.w = pk2(w[6], w[7]);
        w1.x = pk2(w[8], w[9]); w1.y = pk2(w[10], w[11]); w1.z = pk2(w[12], w[13]); w1.w = pk2(w[14], w[15]);
#pragma unroll
        for (int dt = 0; dt < 2; ++dt) {
            v4u a0; a0.x = vlo[dt][0].x; a0.y = vlo[dt][0].y; a0.z = vhi[dt][0].x; a0.w = vhi[dt][0].y;
            v4u a1; a1.x = vlo[dt][1].x; a1.y = vlo[dt][1].y; a1.z = vhi[dt][1].x; a1.w = vhi[dt][1].y;
            oT[dt] = __builtin_amdgcn_mfma_f32_32x32x16_bf16(__builtin_bit_cast(bf16x8, a0), __builtin_bit_cast(bf16x8, w0), oT[dt], 0, 0, 0);
            oT[dt] = __builtin_amdgcn_mfma_f32_32x32x16_bf16(__builtin_bit_cast(bf16x8, a1), __builtin_bit_cast(bf16x8, w1), oT[dt], 0, 0, 0);
        }
        if (done_) break;
    }
    bf16* Op = MIXED + (size_t)(b * SEQ + 32 * qt + r32) * D + 512 + hd * 64 + 4 * hi;
#pragma unroll
    for (int dt = 0; dt < 2; ++dt)
#pragma unroll
        for (int g = 0; g < 4; ++g) { v2u o; o.x = pk2(oT[dt][4 * g], oT[dt][4 * g + 1]); o.y = pk2(oT[dt][4 * g + 2], oT[dt][4 * g + 3]); *(v2u*)(Op + 32 * dt + 8 * g) = o; }
}
__device__ __forceinline__ void sb_phase(Frame& F) {
    const int bh = F.vcu >> 3, s = F.vcu & 7;
    if (bh >= NB * 8) return;
#pragma unroll 1
    for (int i = 0; i < 2; ++i) { const int qb = i == 0 ? 15 - s : s; sb_wave_tile(F.PROJ, F.SVT, F.MIXED, bh >> 3, bh & 7, 8 * qb + F.wave, F.lane); }
}
__device__ __forceinline__ void combine_phase(Frame& F) {
    const int gw = F.vcu * NWAVES + F.wave, NGW = F.G * NWAVES;
    const float l01 = wave_sum(F.lam[F.lane] * F.lam[64 + F.lane]), l23 = wave_sum(F.lam[128 + F.lane] * F.lam[192 + F.lane]);
    const float lmbda = expf(l01) - expf(l23) + 0.2f;
    const float g0 = F.g_sub[2 * F.lane] * 0.8f, g1 = F.g_sub[2 * F.lane + 1] * 0.8f;
    for (int m = gw; m < T; m += NGW) {
        const unsigned* orow = (const unsigned*)(F.ORAW + (size_t)m * D);
        unsigned* mrow = (unsigned*)(F.MIXED + (size_t)m * D);
#pragma unroll
        for (int h = 0; h < 4; ++h) {
            const unsigned a = orow[h * 128 + F.lane], c = orow[h * 128 + 64 + F.lane];
            const float o0 = bflo(a) - lmbda * bflo(c), o1 = bfhi(a) - lmbda * bfhi(c);
            const float rstd = 1.f / sqrtf(wave_sum(o0 * o0 + o1 * o1) * (1.f / 128.f) + NORM_EPS);
            mrow[h * 64 + F.lane] = pk2(o0 * rstd * g0, o1 * rstd * g1);
        }
    }
}
constexpr int RT_ROWS = 64, RT_HP = 2064, RT_LP = 1040;
static_assert(RT_ROWS * RT_HP <= RING_BYTES && T / RT_ROWS == 256, "router phase LDS map / one tile per workgroup");
__device__ __forceinline__ void route_phase(Frame& F) {
    LAS unsigned char* lds = F.lds + RING_OFF;
    const int tid = F.tid, lane = F.lane, wid = F.wave;
    const float NEG = -INFINITY;
    for (int tile = F.vcu; tile < T / RT_ROWS; tile += F.G) {
        const int row0 = tile * RT_ROWS, b = row0 >> 12;
        __syncthreads();
        const float* shift = F.MOD + b * 6144 + 3 * 1024; const float* scale = F.MOD + b * 6144 + 4 * 1024;
#pragma unroll 1
        for (int r0 = 0; r0 < 8; r0 += 4) {
            f32x4 v[4][4]; v2u dd[4][4];
#pragma unroll
            for (int r = 0; r < 4; ++r) { const int m = row0 + 8 * wid + r0 + r;
                const GAS f32x4* xr = (const GAS f32x4*)(F.x + (size_t)m * D) + lane; const GAS v2u* dr = (const GAS v2u*)(F.DLT + (size_t)m * D) + lane;
#pragma unroll
                for (int j = 0; j < 4; ++j) { v[r][j] = xr[64 * j]; dd[r][j] = dr[64 * j]; } }
#pragma unroll
            for (int r = 0; r < 4; ++r) { const int lr = 8 * wid + r0 + r, m = row0 + lr; float s2 = 0.f;
#pragma unroll
                for (int j = 0; j < 4; ++j) { const v2u d = dd[r][j]; v[r][j].x += bflo(d.x); v[r][j].y += bfhi(d.x); v[r][j].z += bflo(d.y); v[r][j].w += bfhi(d.y);
                    s2 += (v[r][j].x * v[r][j].x + v[r][j].y * v[r][j].y) + (v[r][j].z * v[r][j].z + v[r][j].w * v[r][j].w); }
                const float rstd = 1.f / sqrtf(wave_sum(s2) * (1.f / D) + NORM_EPS);
                GAS v2u* o8 = (GAS v2u*)(F.H2 + (size_t)m * D) + lane;
#pragma unroll
                for (int j = 0; j < 4; ++j) { const int c = 4 * lane + 256 * j;
                    const f32x4 gv = *(const f32x4*)(F.g_ffn + c), sh = *(const f32x4*)(shift + c), sc = *(const f32x4*)(scale + c);
                    const f32x4 y = v[r][j] * rstd * gv * (sc + 1.0f) + sh;
                    v2u w; w.x = pk2(y.x, y.y); w.y = pk2(y.z, y.w); o8[64 * j] = w; *(LAS v2u*)(lds + lr * RT_HP + c * 2) = w; } }
        }
        __syncthreads();
        const int fr = lane & 15, fq = lane >> 4;
        f32x4 acc[4][2];
#pragma unroll
        for (int mt = 0; mt < 4; ++mt)
#pragma unroll
            for (int nt = 0; nt < 2; ++nt) acc[mt][nt] = (f32x4){0.f, 0.f, 0.f, 0.f};
        const bf16* wr0 = F.WR + (size_t)(32 * wid + fr) * D + 8 * fq;
#pragma unroll 8
        for (int ks = 0; ks < D / 32; ++ks) {
            const bf16x8 b0 = *(const bf16x8*)(wr0 + 32 * ks), b1 = *(const bf16x8*)(wr0 + (size_t)16 * D + 32 * ks);
#pragma unroll
            for (int mt = 0; mt < 4; ++mt) { const bf16x8 a = *(const LAS bf16x8*)(lds + (16 * mt + fr) * RT_HP + (32 * ks + 8 * fq) * 2);
                acc[mt][0] = __builtin_amdgcn_mfma_f32_16x16x32_bf16(a, b0, acc[mt][0], 0, 0, 0); acc[mt][1] = __builtin_amdgcn_mfma_f32_16x16x32_bf16(a, b1, acc[mt][1], 0, 0, 0); }
        }
        __syncthreads();
#pragma unroll
        for (int mt = 0; mt < 4; ++mt)
#pragma unroll
            for (int nt = 0; nt < 2; ++nt)
#pragma unroll
                for (int j = 0; j < 4; ++j) *(LAS float*)(lds + (16 * mt + 4 * fq + j) * RT_LP + (32 * wid + 16 * nt + fr) * 4) = acc[mt][nt][j];
        __syncthreads();
        const int tl = lane >> 3, g = lane & 7, t = row0 + 8 * wid + tl;
        float s[32], bz[32];
#pragma unroll
        for (int i4 = 0; i4 < 8; ++i4) { const f32x4 lg = *(const LAS f32x4*)(lds + (8 * wid + tl) * RT_LP + (32 * g + 4 * i4) * 4); const f32x4 eb = *(const f32x4*)(F.e_bias + 32 * g + 4 * i4);
#pragma unroll
            for (int j = 0; j < 4; ++j) { const float sg = __builtin_amdgcn_rcpf(1.0f + __expf(-lg[j])); s[4 * i4 + j] = sg; bz[4 * i4 + j] = sg + eb[j]; } }
        float m1 = NEG, m2 = NEG;
#pragma unroll
        for (int i = 0; i < 32; ++i) { const float v = bz[i]; m2 = fmaxf(m2, fminf(m1, v)); m1 = fmaxf(m1, v); }
        const float gs = m1 + m2; int rank = 0;
#pragma unroll
        for (int gp = 0; gp < 8; ++gp) { const float og = __shfl(gs, (lane & ~7) + gp); rank += (og > gs || (og == gs && gp < g)) ? 1 : 0; }
        unsigned taken = rank < 4 ? 0u : 0xffffffffu;
        int my_e = 0; float my_s = 0.f, ssum = 0.f;
#pragma unroll 1
        for (int k = 0; k < KSEL; ++k) {
            float lm = NEG, ls = 0.f; int li = 0;
#pragma unroll
            for (int i = 0; i < 32; ++i) { const float v = ((taken >> i) & 1u) ? NEG : bz[i]; const bool up = v > lm; lm = up ? v : lm; li = up ? i : li; ls = up ? s[i] : ls; }
            float wm = lm, ws = ls; int we = 32 * g + li;
#pragma unroll
            for (int off = 1; off < 8; off <<= 1) { const float ov = __shfl_xor(wm, off), os = __shfl_xor(ws, off); const int oe = __shfl_xor(we, off);
                const bool take = ov > wm || (ov == wm && oe < we); wm = take ? ov : wm; ws = take ? os : ws; we = take ? oe : we; }
            if ((we >> 5) == g) taken |= 1u << (we & 31);
            if (g == k) { my_e = we; my_s = ws; }
            ssum += ws;
        }
        { unsigned* cnt = F.ctl + CW_COUNT; const unsigned rk = atomicAdd(cnt + my_e, 1u); const size_t p = (size_t)my_e * T + rk; F.LTOK[p] = (unsigned)t | ((unsigned)g << 16); F.LW[p] = my_s / ssum * 2.5f; }
        if (g == 0) { const size_t p = (size_t)NE * T + t; F.LTOK[p] = (unsigned)t | (8u << 16); F.LW[p] = 1.0f; }
    }
}
constexpr int EX_TOK = 0, EX_WGT = 1024, EX_PFX = 2048, EX_QW = 3584, EX_ST0 = 4096, EX_WB = 32768, EX_AB = 16384, EX_STB = EX_WB + EX_AB, EX_NST = 3;
static_assert(EX_ST0 + EX_NST * EX_STB <= RING_BYTES, "expert LDS map");
constexpr int EX_ROWS = 256, EX_XQ = 34;
__device__ __forceinline__ v4u ex_gld16v(const char* sbase, unsigned voff) { v4u v; asm volatile("global_load_dwordx4 %0, %1, %2" : "=v"(v) : "v"(voff), "s"(sbase) : "memory"); return v; }
template <int AUX> __device__ __forceinline__ void ex_dma(const void* g, LAS unsigned char* l) { __builtin_amdgcn_global_load_lds((const unsigned*)g, (LAS unsigned*)l, 16, 0, AUX); }
template <int MODE>
__device__ __forceinline__ void ex_tile(Frame& F, LAS unsigned char* lds, int tid_, const float* W, int j, int nrows, bf16* ACT) {
    int tid = tid_; asm volatile("" : "+v"(tid));
    LAS unsigned* tokL = (LAS unsigned*)(lds + EX_TOK); LAS float* wgtL = (LAS float*)(lds + EX_WGT);
    const int lane = tid & 63, wid = __builtin_amdgcn_readfirstlane(tid >> 6), wr = wid >> 2, wc = wid & 3, fr = lane & 15, fq = lane >> 4;
    constexpr int K = MODE == 0 ? D : FF, ldw = MODE == 0 ? 512 : D, NK = K / 32;
    const int wcol = MODE == 0 ? (((lane & 3) >> 1) * 256 + 128 * j + 32 * (lane >> 4) + 8 * ((lane >> 2) & 3) + 4 * (lane & 1)) : (256 * j + 4 * lane);
    const char* wsrc = (const char*)(W + (size_t)(4 * wid) * ldw);
    const unsigned wvoff = 4u * (unsigned)wcol;
    const char* abase = MODE == 0 ? (const char*)F.H2 : (const char*)ACT;
    const int arow0 = 32 * wid + (lane >> 3), ac = lane & 7;
    const int awoff0 = EX_ST0 + EX_WB + arow0 * 64 + (((ac & 3) ^ ((0 - (lane >> 5)) & 3)) * 16), awoff1 = EX_ST0 + EX_WB + arow0 * 64 + (((ac & 3) ^ ((0 - (2 + (lane >> 5))) & 3)) * 16);
    const int ahalf = (lane & 7) >> 2;
#define EX_ISSUE_W(ks, st) do { LAS unsigned char* sb_ = lds + EX_ST0 + (st) * EX_STB; \
        _Pragma("unroll") for (int i_ = 0; i_ < 4; ++i_) ex_dma<0>(wsrc + (size_t)(32 * (ks) + i_) * (ldw * 4) + wvoff, sb_ + (4 * wid + i_) * 1024); } while (0)
#define EX_LOAD_A(b) do { _Pragma("unroll") for (int i_ = 0; i_ < 4; ++i_) { const int r_ = arow0 + 8 * i_; \
        const unsigned o_ = (MODE == 0 ? (tokL[r_] & 0xffffu) * (unsigned)(D * 2) : (unsigned)r_ * (unsigned)(FF * 2)) + 16u * (unsigned)ac + 128u * (unsigned)(b); ar[i_] = ex_gld16v(abase, o_); } } while (0)
#define EX_WRITE_A(stb) do {   \
        const int st_ = (stb) + ahalf >= EX_NST ? (stb) + ahalf - EX_NST : (stb) + ahalf; \
        _Pragma("unroll") for (int i_ = 0; i_ < 4; ++i_) *(LAS v4u*)(lds + ((i_ & 1) ? awoff1 : awoff0) + 512 * i_ + st_ * EX_STB) = ar[i_]; } while (0)
    v4u ar[4];
    f32x4 acc[8][4];
#pragma unroll
    for (int m = 0; m < 8; ++m)
#pragma unroll
        for (int q = 0; q < 4; ++q) acc[m][q] = (f32x4){0.f, 0.f, 0.f, 0.f};
    const bool active = 128 * wr < nrows;
    const int boff = fq * 8192 + wc * 256 + fr * 16;
    const int aoff_r = EX_WB + (128 * wr + fr) * 64 + ((fq ^ ((0 - (fr >> 2)) & 3)) * 16);
    EX_LOAD_A(0); EX_ISSUE_W(0, 0); EX_ISSUE_W(1, 1);
    asm volatile("s_waitcnt vmcnt(8)" : "+v"(ar[0]), "+v"(ar[1]), "+v"(ar[2]), "+v"(ar[3]) :: "memory");
    EX_WRITE_A(0);
    if (1 < NK / 2) EX_LOAD_A(1);
    int st = 0;
#pragma unroll 2
    for (int ks = 0; ks < NK; ++ks) {
        if (ks + 2 < NK) asm volatile("s_waitcnt vmcnt(8)" ::: "memory"); else if (ks + 2 == NK) asm volatile("s_waitcnt vmcnt(4)" ::: "memory"); else asm volatile("s_waitcnt vmcnt(0)" ::: "memory");
        asm volatile("s_waitcnt lgkmcnt(0)" ::: "memory");
        __builtin_amdgcn_s_barrier();
        asm volatile("" ::: "memory");
        const LAS unsigned char* sb = lds + EX_ST0 + st * EX_STB;
        f32x4 xw[8]; bf16x8 af[8];
        if (active) {
#pragma unroll
            for (int jj = 0; jj < 8; ++jj) xw[jj] = *(const LAS f32x4*)(sb + boff + jj * 1024);
#pragma unroll
            for (int m = 0; m < 8; ++m) af[m] = *(const LAS bf16x8*)(sb + aoff_r + m * 1024);
        }
        const int s1 = st + 1 >= EX_NST ? st + 1 - EX_NST : st + 1, s2 = st + 2 >= EX_NST ? st + 2 - EX_NST : st + 2;
        if (ks + 2 < NK) EX_ISSUE_W(ks + 2, s2);
        if (active) {
            bf16x8 bfr[4];
#pragma unroll
            for (int jp = 0; jp < 4; ++jp)
#pragma unroll
                for (int q = 0; q < 4; ++q) { const unsigned p = pk2(xw[2 * jp][q], xw[2 * jp + 1][q]); bfr[q][2 * jp] = (short)(p & 0xffffu); bfr[q][2 * jp + 1] = (short)(p >> 16); }
            __builtin_amdgcn_s_setprio(1);
#pragma unroll
            for (int m = 0; m < 8; ++m)
#pragma unroll
                for (int q = 0; q < 4; ++q) acc[m][q] = __builtin_amdgcn_mfma_f32_16x16x32_bf16(bfr[q], af[m], acc[m][q], 0, 0, 0);
            __builtin_amdgcn_s_setprio(0);
        }
        if ((ks & 1) && ks + 1 < NK) {
            if (ks + 2 < NK) asm volatile("s_waitcnt vmcnt(8)" : "+v"(ar[0]), "+v"(ar[1]), "+v"(ar[2]), "+v"(ar[3]) :: "memory");
            else asm volatile("s_waitcnt vmcnt(4)" : "+v"(ar[0]), "+v"(ar[1]), "+v"(ar[2]), "+v"(ar[3]) :: "memory");
            EX_WRITE_A(s1);
            if ((ks + 3) / 2 < NK / 2) EX_LOAD_A((ks + 3) / 2);
        }
        st = st + 1 >= EX_NST ? 0 : st + 1;
    }
#undef EX_ISSUE_W
#undef EX_LOAD_A
#undef EX_WRITE_A
    if (active) {
        if (MODE == 0) {
#pragma unroll
            for (int m = 0; m < 8; ++m) { float o[8];
#pragma unroll
                for (int rg = 0; rg < 2; ++rg)
#pragma unroll
                    for (int q = 0; q < 4; ++q) { const float g = acc[m][q][rg], u = acc[m][q][rg + 2]; o[4 * rg + q] = g * __builtin_amdgcn_rcpf(1.0f + __expf(-g)) * u; }
                v4u w; w.x = pk2(o[0], o[1]); w.y = pk2(o[2], o[3]); w.z = pk2(o[4], o[5]); w.w = pk2(o[6], o[7]);
                *(v4u*)(ACT + (size_t)(128 * wr + 16 * m + fr) * FF + 128 * j + 32 * wc + 8 * fq) = w; }
        } else {
#pragma unroll
            for (int m = 0; m < 8; ++m) { const int row = 128 * wr + 16 * m + fr;
                if (row < nrows) { const unsigned ti = tokL[row]; const float wv = wgtL[row];
                    unsigned char* yp = (unsigned char*)F.Y + ((size_t)(ti & 0xffffu) * NSLOT9 + (ti >> 16)) * D + 256 * j + 64 * wc + 16 * fq;
                    v4u w;
#pragma unroll
                    for (int rg = 0; rg < 4; ++rg) { unsigned p = __builtin_amdgcn_cvt_pk_fp8_f32(acc[m][0][rg] * wv, acc[m][1][rg] * wv, 0, false);
                        w[rg] = __builtin_amdgcn_cvt_pk_fp8_f32(acc[m][2][rg] * wv, acc[m][3][rg] * wv, p, true); }
                    *(v4u*)yp = w; } }
        }
    }
    __builtin_amdgcn_s_barrier();
    asm volatile("" ::: "memory");
}
__device__ __forceinline__ void expert_unit(Frame& F, int e, int chunk, int nrows) {
    LAS unsigned char* lds = F.lds + RING_OFF;
    LAS unsigned* tokL = (LAS unsigned*)(lds + EX_TOK); LAS float* wgtL = (LAS float*)(lds + EX_WGT);
    const int tid = F.tid;
    if (tid < EX_ROWS) { const bool ok = tid < nrows; const size_t p = (size_t)e * T + (size_t)chunk * EX_ROWS + tid; tokL[tid] = ok ? F.LTOK[p] : 0u; wgtL[tid] = ok ? F.LW[p] : 0.f; }
    __syncthreads();
    const float* Wgu = e < NE ? F.w_gu + (size_t)e * D * 512 : F.w_sh_gu;
    const float* Wdn = e < NE ? F.w_down + (size_t)e * FF * D : F.w_sh_down;
    bf16* ACT = F.ACT + (size_t)F.vcu * EX_ROWS * FF;
#pragma unroll 1
    for (int j = 0; j < 2; ++j) ex_tile<0>(F, lds, tid, Wgu, j, nrows, ACT);
    VM_WAIT(); __syncthreads();
#pragma unroll 1
    for (int j = 0; j < 4; ++j) ex_tile<1>(F, lds, tid, Wdn, j, nrows, ACT);
}
__device__ __forceinline__ void expert_phase(Frame& F) {
    LAS unsigned char* lds = F.lds + RING_OFF;
    LAS unsigned* pfx = (LAS unsigned*)(lds + EX_PFX);
    LAS unsigned* qw = (LAS unsigned*)(lds + EX_QW);
    __syncthreads();
    LAS unsigned* cntL = (LAS unsigned*)(lds + EX_ST0);
    if (F.tid < NE) cntL[F.tid] = __hip_atomic_load(F.ctl + CW_COUNT + F.tid, RLX_AGENT);
    __syncthreads();
    if (F.tid < 8) { const int x = F.tid; unsigned run = 0;
        for (int i = 0; i < 32; ++i) { pfx[x * EX_XQ + i] = run; run += (cntL[8 * i + x] + EX_ROWS - 1) / EX_ROWS; }
        pfx[x * EX_XQ + 32] = run; run += (T / EX_ROWS) / 8; pfx[x * EX_XQ + 33] = run; }
    __syncthreads();
    const int myx = (int)(xb_xcc_id() & 7u);
    int hop = 0;
#pragma unroll 1
    for (;;) {
        __syncthreads();
        if (F.tid == 0) { unsigned u = 0xffffffffu; int h = hop;
            for (; h < 8; ++h) { const int x = (myx + h) & 7; u = __hip_atomic_fetch_add(F.ctl + CW_QUEUE + 64 * x, 1u, RLX_AGENT); if (u < pfx[x * EX_XQ + 33]) break; }
            qw[0] = u; qw[1] = (unsigned)h; }
        __syncthreads();
        const int u = (int)qw[0]; hop = (int)qw[1];
        if (hop >= 8) break;
        const int x = (myx + hop) & 7;
        const LAS unsigned* px = pfx + x * EX_XQ;
        int lo = 0, hi = 32;
        while (lo < hi) { const int mid = (lo + hi + 1) >> 1; if ((int)px[mid] <= u) lo = mid; else hi = mid - 1; }
        int e, chunk, cnt;
        if (lo < 32) { e = 8 * lo + x; chunk = u - (int)px[lo]; cnt = (int)__hip_atomic_load(F.ctl + CW_COUNT + e, RLX_AGENT); }
        else { e = NE; chunk = 8 * x + (u - (int)px[32]); cnt = T; }
        const int nrows = min(EX_ROWS, cnt - EX_ROWS * chunk);
        expert_unit(F, e, chunk, nrows);
    }
}
__device__ __forceinline__ void final_phase(Frame& F) {
    typedef float f32x2 __attribute__((ext_vector_type(2)));
    const int gw = F.vcu * NWAVES + F.wave, NGW = F.G * NWAVES;
    for (int m = gw; m < T; m += NGW) {
        const float* gm = F.MOD + (size_t)(m >> 12) * 6144 + 5 * 1024;
        const unsigned* yrow = (const unsigned*)((const unsigned char*)F.Y + (size_t)m * NSLOT9 * D) + F.lane;
#pragma unroll
        for (int i = 0; i < 4; ++i) { const int c = 4 * F.lane + 256 * i; float a0 = 0.f, a1 = 0.f, a2 = 0.f, a3 = 0.f;
#pragma unroll
            for (int k = 0; k < NSLOT9; ++k) { const unsigned y = __builtin_nontemporal_load(yrow + k * (D / 4) + 64 * i);
                const f32x2 lo = __builtin_amdgcn_cvt_pk_f32_fp8(y, false), hi = __builtin_amdgcn_cvt_pk_f32_fp8(y, true); a0 += lo[0]; a1 += lo[1]; a2 += hi[0]; a3 += hi[1]; }
            f32x4 r = __builtin_nontemporal_load((const f32x4*)(F.x + (size_t)m * D + c));
            { const v2u d = __builtin_nontemporal_load((const v2u*)(F.DLT + (size_t)m * D + c)); r.x += bflo(d.x); r.y += bfhi(d.x); r.z += bflo(d.y); r.w += bfhi(d.y); }
            const f32x4 g = *(const f32x4*)(gm + c);
            f32x4 o; o.x = r.x + g.x * a0; o.y = r.y + g.y * a1; o.z = r.z + g.z * a2; o.w = r.w + g.w * a3;
            __builtin_nontemporal_store(o, (f32x4*)(F.out + (size_t)m * D + c)); }
    }
}
struct Args { const void* in[19]; float* out; unsigned char* ws; };
static_assert(sizeof(Args) == 21 * 8, "Args has no padding bytes");
__global__ void __launch_bounds__(NWAVES * 64, 2) hybrid_fwd(Args args) {
    extern __shared__ __attribute__((aligned(16))) unsigned char lds[];
    Frame F;
    F.lds = (LAS unsigned char*)lds;
    F.MISC = (volatile LAS unsigned*)(F.lds + MISC_OFF);
    F.tid = threadIdx.x; F.lane = F.tid & 63; F.wave = __builtin_amdgcn_readfirstlane(F.tid >> 6);
    F.G = gridDim.x; { const int bx = blockIdx.x; F.vcu = (F.G % 8 == 0) ? (bx % 8) * (F.G / 8) + bx / 8 : bx; }
    unsigned char* ws = args.ws;
    F.ctl = (unsigned*)(ws + WS_CTL);
    F.x = (const float*)args.in[0]; F.c = (const float*)args.in[1]; F.positions = (const int*)args.in[2]; F.w_ada = (const float*)args.in[3]; F.b_ada = (const float*)args.in[4];
    F.g_mix = (const float*)args.in[5]; F.w_in = (const float*)args.in[6]; F.g_q = (const float*)args.in[7]; F.g_k = (const float*)args.in[8]; F.lam = (const float*)args.in[9];
    F.g_sub = (const float*)args.in[10]; F.w_out = (const float*)args.in[11]; F.g_ffn = (const float*)args.in[12]; F.w_router = (const float*)args.in[13]; F.e_bias = (const float*)args.in[14];
    F.w_sh_gu = (const float*)args.in[15]; F.w_sh_down = (const float*)args.in[16]; F.w_gu = (const float*)args.in[17]; F.w_down = (const float*)args.in[18];
    F.out = args.out;
    F.MOD = (float*)(ws + WS_MOD); F.RCOS = (float*)(ws + WS_COS); F.RSIN = (float*)(ws + WS_SIN); F.DLT = (bf16*)(ws + WS_R); F.LW = (float*)(ws + WS_LW);
    F.WIN = (bf16*)(ws + WS_WIN); F.WOUT = (bf16*)(ws + WS_WOUT); F.WR = (bf16*)(ws + WS_WR); F.XN = (bf16*)(ws + WS_XN); F.PROJ = (bf16*)(ws + WS_PROJ); F.SVT = (bf16*)(ws + WS_SVT);
    F.ORAW = (bf16*)(ws + WS_ORAW); F.MIXED = (bf16*)(ws + WS_MIXED); F.H2 = (bf16*)(ws + WS_H2); F.Y = (bf16*)(ws + WS_Y); F.ACT = (bf16*)(ws + WS_ACT); F.LTOK = (unsigned*)(ws + WS_LTOK);
    for (int u = F.tid; u < (LDS_BYTES - LDSCTL_OFF) / 4; u += NWAVES * 64) ((LAS unsigned*)(F.lds + LDSCTL_OFF))[u] = 0u;
    __syncthreads();
    XcdBarrier bar = xcd_barrier_post(F.ctl + CW_BAR, F.MISC + 8);
#define GRID_BAR() xcd_barrier(bar)
#define PHASE_BEGIN() do { int t_ = threadIdx.x; asm volatile("" : "+v"(t_)); F.tid = t_; F.lane = t_ & 63; } while (0)

    PHASE_BEGIN(); p0_prologue(F);
    GRID_BAR();
    PHASE_BEGIN(); rows_adaln(F, F.x, F.g_mix, F.MOD + 0 * 1024, F.MOD + 1 * 1024, F.XN);
    GRID_BAR();
    {   pg8::Gemm g{F.XN, F.WIN, T, NPROJ, D}; pg8::StaticOrder S; S.init(T, NPROJ, F.G, (int)blockIdx.x);
        pg8::EpiProj E{F.PROJ, F.SVT, F.RCOS, F.RSIN, F.g_q, F.g_k};
        pg8::gemm_phase<pg8::EpiProj, pg8::StaticOrder, PG8_ALIGN, PG8_SP2>(F.lds + RING_OFF, g, S, E); }
    GRID_BAR();
    {   const attn_body::StaticOrder S((int)F.G, (int)blockIdx.x);
        attn_body::attn_phase<attn_body::StaticOrder>((char*)lds + RING_OFF, (const attn_body::bf16*)F.PROJ, (attn_body::bf16*)F.ORAW, S); }
    PHASE_BEGIN(); sb_phase(F);
    GRID_BAR();
    PHASE_BEGIN(); combine_phase(F);
    GRID_BAR();
    {   pg8::Gemm g{F.MIXED, F.WOUT, T, D, D}; pg8::StaticOrder S; S.init(T, D, F.G, (int)blockIdx.x);
        pg8::EpiGateBf16 E{F.MOD + 2 * 1024, F.DLT};
        pg8::gemm_phase<pg8::EpiGateBf16, pg8::StaticOrder, PG8_ALIGN, PG8_SP2>(F.lds + RING_OFF, g, S, E); }
    GRID_BAR();
    PHASE_BEGIN(); route_phase(F);
    GRID_BAR();
    PHASE_BEGIN(); expert_phase(F);
    GRID_BAR();
    PHASE_BEGIN(); final_phase(F);
}

extern "C" void kernel_launch(void* const* d_in, const int* in_sizes, int n_in, void* d_out, int out_size, void* d_ws, size_t ws_size, hipStream_t stream) {
    static int grid = 0;
    if (grid == 0) {
        if (n_in != 19 || out_size != T * D || ws_size < WS_END) { fprintf(stderr, "kernel_launch: unexpected problem shape (n_in %d, out %d, ws %zu); nothing launched\n", n_in, out_size, ws_size); grid = -1; return; }
        int dev = 0, cus = 0, per_cu = 0;
        if (hipGetDevice(&dev) != hipSuccess || hipDeviceGetAttribute(&cus, hipDeviceAttributeMultiprocessorCount, dev) != hipSuccess) { grid = -1; return; }
        if (hipFuncSetAttribute((const void*)hybrid_fwd, hipFuncAttributeMaxDynamicSharedMemorySize, LDS_BYTES) != hipSuccess) { fprintf(stderr, "kernel_launch: hipFuncSetAttribute failed\n"); grid = -1; return; }
        if (hipOccupancyMaxActiveBlocksPerMultiprocessor(&per_cu, (const void*)hybrid_fwd, NWAVES * 64, LDS_BYTES) != hipSuccess || per_cu < 1)
            fprintf(stderr, "kernel_launch: note: the occupancy query reports %d workgroups per CU\n", per_cu);
        (void)hipGetLastError();
        grid = cus;
        if (grid != 256) fprintf(stderr, "kernel_launch: %d CUs (expected 256)\n", grid);
    }
    if (grid < 0) return;
    if (hipMemsetAsync((char*)d_ws + WS_CTL, 0, CTL_ZERO_BYTES, stream) != hipSuccess) { fprintf(stderr, "kernel_launch: hipMemsetAsync failed\n"); return; }
    Args a{};
    for (int i = 0; i < 19; ++i) a.in[i] = d_in[i];
    a.out = (float*)d_out; a.ws = (unsigned char*)d_ws;
    hipLaunchKernelGGL(hybrid_fwd, dim3(grid), dim3(NWAVES * 64), LDS_BYTES, stream, a);
    const hipError_t le = hipPeekAtLastError();
    if (le != hipSuccess) fprintf(stderr, "kernel_launch: launch failed: %s\n", hipGetErrorName(le));
}
```

```cpp
#include <hip/hip_runtime.h>
#include <hip/hip_bf16.h>
#include <cstdio>
#include <cstdint>
#include <cmath>
namespace pg8 {
#define PG8_LAS __attribute__((address_space(3)))
typedef unsigned short bf16_t;
typedef short bf16x8 __attribute__((ext_vector_type(8)));
typedef float f32x4 __attribute__((ext_vector_type(4)));
typedef unsigned u32x4 __attribute__((ext_vector_type(4)));
constexpr int BM = 256, BK = 64, HALF = 128, HTB = HALF * BK * 2  , STAGE_BYTES = 8 * HTB, NXCD = 8, WGM = 8;

__host__ __device__ __forceinline__ int lds_byte(int r, int c) { const int st = (r >> 4) * 2 + (c >> 5), rr = r & 15, cc = c & 31, ob = rr * 64 + cc * 2; return st * 1024 + (ob ^ (((ob >> 9) & 1) << 5)); }
__host__ __device__ __forceinline__ void stage_rc(int b, int& R, int& C) { const int st = b / 1024, sb = b % 1024, swz = sb ^ (((sb >> 9) & 1) << 5); R = (st >> 1) * 16 + swz / 64; C = (st & 1) * 32 + (swz % 64) / 2; }
__host__ __device__ __forceinline__ int perm32(int rho) { const int n = rho >> 4, i = rho & 15; return 8 * (i >> 2) + 4 * n + (i & 3); }

struct Unit { int pm, pn; };
struct Gemm { const bf16_t* A; const bf16_t* Bt; int M, N, K; };

struct StaticOrder {
    int nM, nN, nwg, G, c;
    __host__ __device__ void init(int M, int N, int G_, int c_) { nM = M / BM; nN = N / BM; nwg = nM * nN; G = G_; c = c_; }
    __host__ __device__ bool next(int i, Unit& u) const {
        const long L = (long)i * G + c; if (L >= nwg) return false;
        int wgid = (int)L; { const int q = nwg / NXCD, r = nwg % NXCD, xcd = wgid % NXCD, off = wgid / NXCD; wgid = (xcd < r ? xcd * (q + 1) : r * (q + 1) + (xcd - r) * q) + off; }
        const int nig = WGM * nN, gid = wgid / nig, fm = gid * WGM, gsz = (nM - fm) < WGM ? (nM - fm) : WGM;
        u.pm = fm + ((wgid % nig) % gsz); u.pn = (wgid % nig) / gsz; return true;
    }
    __device__ __forceinline__ void a_ready(const Unit&) const {}
    __device__ __forceinline__ void done(const Unit&) const {}
};

__device__ __forceinline__ unsigned cvt_pk_bf16(float lo, float hi) { typedef float f2_t __attribute__((ext_vector_type(2))); typedef __bf16 b2_t __attribute__((ext_vector_type(2)));
    f2_t v = {lo, hi}; b2_t b = __builtin_convertvector(v, b2_t); return __builtin_bit_cast(unsigned, b); }
typedef unsigned u32x2 __attribute__((ext_vector_type(2)));
constexpr float QK_C2 = 0.125f * 1.4426950408889634f;

struct EpiGateBf16 {
    static constexpr bool PERM = false, AFTER_DRAIN = false;
    const float* gate; bf16_t* DLT;
    __device__ __forceinline__ void operator()(const f32x4 (&acc)[2][2][4][2], const Unit& u, int wr, int wc, int fr, int fq) const {
        const int row0 = u.pm * BM + wr * 64 + fr, col0 = u.pn * BM + wc * 32 + 4 * fq;
        const float* gb = gate + (size_t)(u.pm >> 4) * 6144 + col0;
        f32x4 gv[2][2];
#pragma unroll
        for (int bj = 0; bj < 2; ++bj)
#pragma unroll
            for (int n = 0; n < 2; ++n) gv[bj][n] = *(const f32x4*)(gb + bj * HALF + n * 16);
#pragma unroll
        for (int ai = 0; ai < 2; ++ai)
#pragma unroll
            for (int m = 0; m < 4; ++m) { bf16_t* rowp = DLT + (size_t)(row0 + ai * HALF + m * 16) * 1024 + col0;
#pragma unroll
                for (int bj = 0; bj < 2; ++bj)
#pragma unroll
                    for (int n = 0; n < 2; ++n) { const f32x4 v = gv[bj][n] * acc[ai][bj][m][n]; u32x2 w; w.x = cvt_pk_bf16(v[0], v[1]); w.y = cvt_pk_bf16(v[2], v[3]); *(u32x2*)(rowp + bj * HALF + n * 16) = w; } }
    }
};
struct EpiProj {
    static constexpr bool PERM = false, AFTER_DRAIN = false;
    bf16_t* P; bf16_t* SVT; const float* rcos; const float* rsin; const float* gq; const float* gk;
    __device__ __forceinline__ void operator()(const f32x4 (&acc)[2][2][4][2], const Unit& u, int wr, int wc, int fr, int fq) const {
        const int row0 = u.pm * BM + wr * 64 + fr, pn = u.pn;
        const int cbase = pn * BM + 64 * wc + 4 * fq;
        if (pn < 4) {
            const float* g = pn < 2 ? gq : gk; const float osc = pn < 2 ? QK_C2 : 1.0f;
            f32x4 gv[2][2];
#pragma unroll
            for (int bj = 0; bj < 2; ++bj)
#pragma unroll
                for (int n = 0; n < 2; ++n) gv[bj][n] = *(const f32x4*)(g + 32 * bj + 16 * n + 4 * fq);
#pragma unroll
            for (int ai = 0; ai < 2; ++ai)
#pragma unroll
                for (int m = 0; m < 4; ++m) { const int row = row0 + ai * HALF + m * 16; float ss = 0.f;
#pragma unroll
                    for (int bj = 0; bj < 2; ++bj)
#pragma unroll
                        for (int n = 0; n < 2; ++n) { const f32x4 v = acc[ai][bj][m][n]; ss += (v[0] * v[0] + v[1] * v[1]) + (v[2] * v[2] + v[3] * v[3]); }
                    ss += __shfl_xor(ss, 16); ss += __shfl_xor(ss, 32);
                    const float rstd = 1.0f / sqrtf(ss * (1.0f / 64.0f) + 1e-6f);
                    bf16_t* prow = P + (size_t)row * 3072 + cbase;
#pragma unroll
                    for (int n = 0; n < 2; ++n) { const f32x4 cs = *(const f32x4*)(rcos + (size_t)row * 32 + 16 * n + 4 * fq), sn = *(const f32x4*)(rsin + (size_t)row * 32 + 16 * n + 4 * fq);
                        const f32x4 lo = acc[ai][0][m][n] * rstd * gv[0][n], hi = acc[ai][1][m][n] * rstd * gv[1][n];
                        const f32x4 olo = (lo * cs - hi * sn) * osc, ohi = (hi * cs + lo * sn) * osc;
                        u32x2 w0, w1; w0.x = cvt_pk_bf16(olo[0], olo[1]); w0.y = cvt_pk_bf16(olo[2], olo[3]); w1.x = cvt_pk_bf16(ohi[0], ohi[1]); w1.y = cvt_pk_bf16(ohi[2], ohi[3]);
                        *(u32x2*)(prow + 16 * n) = w0; *(u32x2*)(prow + 32 + 16 * n) = w1; } }
        } else if (pn < 10) {
            const float osc = (pn == 6 || pn == 7) ? QK_C2 : 1.0f;
#pragma unroll
            for (int ai = 0; ai < 2; ++ai)
#pragma unroll
                for (int m = 0; m < 4; ++m) { bf16_t* prow = P + (size_t)(row0 + ai * HALF + m * 16) * 3072 + cbase;
#pragma unroll
                    for (int bj = 0; bj < 2; ++bj)
#pragma unroll
                        for (int n = 0; n < 2; ++n) { const f32x4 v = acc[ai][bj][m][n] * osc; u32x2 w; w.x = cvt_pk_bf16(v[0], v[1]); w.y = cvt_pk_bf16(v[2], v[3]); *(u32x2*)(prow + 32 * bj + 16 * n) = w; } }
        } else {
            const int hd = 4 * (pn - 10) + wc;
#pragma unroll
            for (int ai = 0; ai < 2; ++ai)
#pragma unroll
                for (int m = 0; m < 4; ++m) { const int row = row0 + ai * HALF + m * 16, b = row >> 12, t = row & 4095;
                    bf16_t* vb = SVT + ((size_t)(b * 8 + hd) * 64 + 4 * fq) * 4096 + t;
#pragma unroll
                    for (int bj = 0; bj < 2; ++bj)
#pragma unroll
                        for (int n = 0; n < 2; ++n) { const f32x4 v = acc[ai][bj][m][n]; const unsigned p0 = cvt_pk_bf16(v[0], v[1]), p1 = cvt_pk_bf16(v[2], v[3]);
                            bf16_t* d = vb + (size_t)(32 * bj + 16 * n) * 4096;
                            d[0] = (bf16_t)(p0 & 0xffffu); d[4096] = (bf16_t)(p0 >> 16); d[2 * 4096] = (bf16_t)(p1 & 0xffffu); d[3 * 4096] = (bf16_t)(p1 >> 16); } }
        }
    }
};

template <class Epi, class Sched, bool ALIGN_EPI = false, bool SP2 = false>
__device__ __forceinline__ void gemm_phase(PG8_LAS unsigned char* lds, const Gemm g, const Sched& S, const Epi& E) {
    int tid_ = threadIdx.x; asm volatile("" : "+v"(tid_));
    const int tid = tid_, wid = __builtin_amdgcn_readfirstlane(tid >> 6), lane = tid & 63, wr = wid >> 2, wc = wid & 3, fr = lane & 15, fq = lane >> 4;
    const int K = g.K, nt = K / BK;
    unsigned voffA[2], voffB[2];
#pragma unroll
    for (int i = 0; i < 2; ++i) { int R, C; stage_rc(tid * 16 + i * 8192, R, C); const int Rb = Epi::PERM ? ((R & ~31) + perm32(R & 31)) : R;
        voffA[i] = (unsigned)(R * K + C) * 2u; voffB[i] = (unsigned)(Rb * K + C) * 2u; }
    const size_t kstep = (size_t)(BK * 2);
    const size_t hstep = (size_t)HALF * K * 2;
    const size_t tstep = 2 * hstep;
    const unsigned ldsw = (unsigned)wid * 1024u;
    const int aoff = lds_byte(wr * 64 + fr, fq * 8), boff = lds_byte(wc * 32 + fr, fq * 8);
#define PG8_SA(b, h) (((b) * 2 + (h)) * HTB)
#define PG8_SB(b, h) ((4 + (b) * 2 + (h)) * HTB)
#define PG8_STAGE(bufoff, gbase, voff) do { _Pragma("unroll") for (int _i = 0; _i < 2; ++_i) \
        __builtin_amdgcn_global_load_lds((const unsigned*)((const char*)(gbase) + (voff)[_i]), (PG8_LAS unsigned*)(lds + (bufoff) + ldsw + _i * 8192), 16, 0, 0); } while (0)
#define PG8_LDA(dst, b, h) do { _Pragma("unroll") for (int m = 0; m < 4; ++m) _Pragma("unroll") for (int k = 0; k < 2; ++k) dst[m][k] = *(const PG8_LAS bf16x8*)(lds + PG8_SA(b, h) + aoff + m * 2048 + k * 1024); } while (0)
#define PG8_LDB(dst, b, h) do { _Pragma("unroll") for (int n = 0; n < 2; ++n) _Pragma("unroll") for (int k = 0; k < 2; ++k) dst[n][k] = *(const PG8_LAS bf16x8*)(lds + PG8_SB(b, h) + boff + n * 2048 + k * 1024); } while (0)
#define PG8_MMA(ai, bj, At, Bt) do { __builtin_amdgcn_s_setprio(1); _Pragma("unroll") for (int m = 0; m < 4; ++m) _Pragma("unroll") for (int n = 0; n < 2; ++n) _Pragma("unroll") for (int k = 0; k < 2; ++k) \
        acc[ai][bj][m][n] = __builtin_amdgcn_mfma_f32_16x16x32_bf16(Bt[n][k], At[m][k], acc[ai][bj][m][n], 0, 0, 0); __builtin_amdgcn_s_setprio(0); } while (0)
#define PG8_WAIT_V(n) asm volatile("s_waitcnt vmcnt(" #n ")" ::: "memory")
#define PG8_WAIT_L(n) asm volatile("s_waitcnt lgkmcnt(" #n ")" ::: "memory")
#define PG8_BAR __builtin_amdgcn_s_barrier()
#define PG8_SCHED __builtin_amdgcn_sched_barrier(0)
    Unit cur, nxt; int ui = 0;
    if (!S.next(0, cur)) return;
    f32x4 acc[2][2][4][2];
#pragma unroll
    for (int a = 0; a < 2; ++a)
#pragma unroll
        for (int b = 0; b < 2; ++b)
#pragma unroll
            for (int m = 0; m < 4; ++m)
#pragma unroll
                for (int n = 0; n < 2; ++n) acc[a][b][m][n] = (f32x4){0.f, 0.f, 0.f, 0.f};
    bf16x8 At[4][2], B0[2][2], B1[2][2];
    const char* cA = (const char*)g.A + (size_t)cur.pm * tstep; const char* cB = (const char*)g.Bt + (size_t)cur.pn * tstep;
    S.a_ready(cur);
    if constexpr (SP2) {
        PG8_STAGE(PG8_SB(0, 0), cB, voffB); PG8_STAGE(PG8_SB(0, 1), cB + hstep, voffB); PG8_STAGE(PG8_SA(0, 0), cA, voffA); PG8_STAGE(PG8_SA(0, 1), cA + hstep, voffA);
        if (wr == 1) PG8_BAR;
        PG8_WAIT_V(2); PG8_BAR;
        PG8_STAGE(PG8_SB(1, 0), cB + kstep, voffB); PG8_STAGE(PG8_SA(1, 0), cA + kstep, voffA); PG8_STAGE(PG8_SB(1, 1), cB + hstep + kstep, voffB);
        PG8_WAIT_V(6); PG8_BAR;
    } else {
        PG8_STAGE(PG8_SB(0, 0), cB, voffB); PG8_STAGE(PG8_SA(0, 0), cA, voffA); PG8_STAGE(PG8_SB(0, 1), cB + hstep, voffB); PG8_STAGE(PG8_SA(0, 1), cA + hstep, voffA);
        if (wr == 1) PG8_BAR;
        PG8_WAIT_V(4); PG8_BAR;
        PG8_STAGE(PG8_SB(1, 0), cB + kstep, voffB); PG8_STAGE(PG8_SA(1, 0), cA + kstep, voffA); PG8_STAGE(PG8_SB(1, 1), cB + hstep + kstep, voffB);
        PG8_WAIT_V(6); PG8_BAR;
    }
    for (;;) {
        const bool has_next = S.next(ui + 1, nxt);
        const char* nA = has_next ? (const char*)g.A + (size_t)nxt.pm * tstep : cA; const char* nB = has_next ? (const char*)g.Bt + (size_t)nxt.pn * tstep : cB;
        for (int t = 0; t < nt; t += 2) {
            const bool last = (t == nt - 2);
            const char* a1 = cA + (size_t)(t + 1) * kstep;
            const char* a2 = last ? nA : cA + (size_t)(t + 2) * kstep; const char* b2 = last ? nB : cB + (size_t)(t + 2) * kstep;
            const char* a3 = a2 + kstep; const char* b3 = b2 + kstep;
            if (last && has_next) S.a_ready(nxt);
            if constexpr (SP2) {
            PG8_LDB(B0, 0, 0); PG8_LDB(B1, 0, 1); PG8_SCHED; PG8_LDA(At, 0, 0); PG8_STAGE(PG8_SA(1, 1), a1 + hstep, voffA);
            PG8_WAIT_V(8); PG8_WAIT_L(0); PG8_BAR; PG8_MMA(0, 0, At, B0); PG8_MMA(0, 1, At, B1); PG8_BAR; PG8_SCHED;
            PG8_LDA(At, 0, 1); PG8_STAGE(PG8_SB(0, 0), b2, voffB); PG8_STAGE(PG8_SB(0, 1), b2 + hstep, voffB); PG8_STAGE(PG8_SA(0, 0), a2, voffA);
            PG8_WAIT_V(8); PG8_WAIT_L(0); PG8_BAR; PG8_MMA(1, 0, At, B0); PG8_MMA(1, 1, At, B1); PG8_BAR; PG8_SCHED;
            PG8_LDB(B0, 1, 0); PG8_LDB(B1, 1, 1); PG8_SCHED; PG8_LDA(At, 1, 0); PG8_STAGE(PG8_SA(0, 1), a2 + hstep, voffA);
            PG8_WAIT_V(8); PG8_WAIT_L(0); PG8_BAR; PG8_MMA(0, 0, At, B0); PG8_MMA(0, 1, At, B1); PG8_BAR; PG8_SCHED;
            PG8_LDA(At, 1, 1); PG8_STAGE(PG8_SB(1, 0), b3, voffB); PG8_STAGE(PG8_SB(1, 1), b3 + hstep, voffB); PG8_STAGE(PG8_SA(1, 0), a3, voffA);
            PG8_WAIT_V(8); PG8_WAIT_L(0); PG8_BAR; PG8_MMA(1, 0, At, B0); PG8_MMA(1, 1, At, B1); PG8_BAR; PG8_SCHED;
            } else {
            PG8_LDB(B0, 0, 0); PG8_SCHED; PG8_LDA(At, 0, 0); PG8_STAGE(PG8_SA(1, 1), a1 + hstep, voffA);
            PG8_WAIT_L(8); PG8_BAR; PG8_WAIT_L(0); PG8_MMA(0, 0, At, B0); PG8_BAR; PG8_SCHED;
            PG8_LDB(B1, 0, 1); PG8_STAGE(PG8_SB(0, 0), b2, voffB);
            PG8_BAR; PG8_WAIT_L(0); PG8_MMA(0, 1, At, B1); PG8_BAR;
            PG8_LDA(At, 0, 1); PG8_STAGE(PG8_SA(0, 0), a2, voffA);
            PG8_BAR; PG8_WAIT_L(0); PG8_MMA(1, 0, At, B0); PG8_BAR; PG8_SCHED;
            PG8_STAGE(PG8_SB(0, 1), b2 + hstep, voffB);
            PG8_WAIT_V(6); PG8_BAR; PG8_MMA(1, 1, At, B1); PG8_BAR;
            PG8_LDB(B0, 1, 0); PG8_SCHED; PG8_LDA(At, 1, 0); PG8_STAGE(PG8_SA(0, 1), a2 + hstep, voffA);
            PG8_WAIT_L(8); PG8_BAR; PG8_WAIT_L(0); PG8_MMA(0, 0, At, B0); PG8_BAR; PG8_SCHED;
            PG8_LDB(B1, 1, 1); PG8_STAGE(PG8_SB(1, 0), b3, voffB);
            PG8_BAR; PG8_WAIT_L(0); PG8_MMA(0, 1, At, B1); PG8_BAR;
            PG8_LDA(At, 1, 1); PG8_STAGE(PG8_SA(1, 0), a3, voffA);
            PG8_BAR; PG8_WAIT_L(0); PG8_MMA(1, 0, At, B0); PG8_BAR; PG8_SCHED;
            PG8_STAGE(PG8_SB(1, 1), b3 + hstep, voffB);
            PG8_WAIT_V(6); PG8_BAR; PG8_MMA(1, 1, At, B1); PG8_BAR;
            }
        }
        if constexpr (ALIGN_EPI) { if (wr == 0) PG8_BAR; }
        if constexpr (!Epi::AFTER_DRAIN) { E(acc, cur, wr, wc, fr, fq); S.done(cur); }
        if (!has_next) break;
#pragma unroll
        for (int a = 0; a < 2; ++a)
#pragma unroll
            for (int b = 0; b < 2; ++b)
#pragma unroll
                for (int m = 0; m < 4; ++m)
#pragma unroll
                    for (int n = 0; n < 2; ++n) acc[a][b][m][n] = (f32x4){0.f, 0.f, 0.f, 0.f};
        cur = nxt; cA = nA; cB = nB; ++ui;
        if constexpr (ALIGN_EPI) { if (wr == 1) PG8_BAR; }
    }
    PG8_WAIT_V(0);
    if constexpr (!ALIGN_EPI) { if (wr == 0) PG8_BAR; }
    PG8_BAR;
    if constexpr (Epi::AFTER_DRAIN) { E.fused(acc, cur, wr, wc, fr, fq, lds, wid, lane); S.done(cur); }
#undef PG8_SA
#undef PG8_SB
#undef PG8_STAGE
#undef PG8_LDA
#undef PG8_LDB
#undef PG8_MMA
#undef PG8_WAIT_V
#undef PG8_WAIT_L
#undef PG8_BAR
#undef PG8_SCHED
}
}

#ifndef PG8_SP2
#define PG8_SP2 true
#endif
#ifndef PG8_ALIGN
#define PG8_ALIGN true
#endif
namespace attn_body {
using bf16=__hip_bfloat16;
using bf16x8=__attribute__((ext_vector_type(8)))short;
using s16x4=__attribute__((ext_vector_type(4)))short;
using f32x16=__attribute__((ext_vector_type(16)))float;
using u32x4=__attribute__((ext_vector_type(4)))unsigned;
constexpr int BATCH=4,NHEAD=8,SEQ=4096,D=64,DV=128,PIN=3072,POUT=1024;
constexpr int NW=8,QBLK=32,QB=QBLK*NW,KVBLK=64,NQB=SEQ/QB;
constexpr int ATTN_UNIT_ROWS=QB;
__device__ __forceinline__ int crow(int r,int hi){return (r&3)+8*(r>>2)+4*hi;}
#define SBAR() __builtin_amdgcn_sched_barrier(0)
__device__ __forceinline__ void cmask(f32x16&p0,f32x16&p1,int jb,int qrel,int hi){
  const float NEG=-INFINITY; int kb=64*jb+4*hi;
  #pragma unroll
  for(int r=0;r<16;++r){int kv=kb+(r&3)+8*(r>>2); if(kv>qrel)p0[r]=NEG; if(kv+32>qrel)p1[r]=NEG;}
}

constexpr int NSLOT=3, SLOTB=8192;
constexpr int LDS_K=0, LDS_V=NSLOT*SLOTB, LDS_WS=3*NSLOT*SLOTB, LDS_OST=LDS_WS+NW*64*4, LDS_BYTES=LDS_OST+NW*8192;
constexpr float C2=0.125f*1.4426950408889634f;
__device__ __forceinline__ void glds16(const void*gsrc,unsigned lds_dst){unsigned keep;
  asm volatile("s_mov_b32 %0, m0\n\ts_mov_b32 m0, %2\n\ts_nop 0\n\tglobal_load_lds_dwordx4 %1, off\n\ts_mov_b32 m0, %0":"=&s"(keep):"v"(gsrc),"s"(lds_dst):"memory");}
__device__ __forceinline__ float max3f(float a,float b,float c){float r;asm("v_max3_f32 %0, %1, %2, %3":"=v"(r):"v"(a),"v"(b),"v"(c));return r;}
__device__ __forceinline__ float max2f(float a,float b){float r;asm("v_max_f32_e32 %0, %1, %2":"=v"(r):"v"(a),"v"(b));return r;}
__device__ __forceinline__ float fadd_s(float a,float b){float r;asm("v_add_f32_e32 %0, %1, %2":"=v"(r):"v"(a),"v"(b));return r;}
__device__ __forceinline__ float fsub_s(float a,float b){float r;asm("v_sub_f32_e32 %0, %1, %2":"=v"(r):"v"(a),"v"(b));return r;}
typedef float f32x2_t __attribute__((ext_vector_type(2))); typedef __bf16 bf16x2_t __attribute__((ext_vector_type(2)));
__device__ __forceinline__ unsigned cvtpk_s(float lo,float hi){f32x2_t v={lo,hi};bf16x2_t b=__builtin_convertvector(v,bf16x2_t);return __builtin_bit_cast(unsigned,b);}
#define WAIT_BAR(N) asm volatile("s_waitcnt vmcnt(" #N ") lgkmcnt(0)\n\ts_barrier":::"memory")

__device__ __forceinline__ void qkt(f32x16&p0,f32x16&p1,const char*Kslot,const bf16x8*qr,const f32x16&negm,int r32,int hi){
  const char*kb=Kslot+hi*1024+r32*16;
  #pragma unroll
  for(int d0=0;d0<4;++d0){
    const bf16x8 b0=*reinterpret_cast<const bf16x8*>(kb+d0*2048);
    const bf16x8 b1=*reinterpret_cast<const bf16x8*>(kb+d0*2048+512);
    if(d0==0){p0=__builtin_amdgcn_mfma_f32_32x32x16_bf16(b0,qr[0],negm,0,0,0);p1=__builtin_amdgcn_mfma_f32_32x32x16_bf16(b1,qr[0],negm,0,0,0);}
    else{p0=__builtin_amdgcn_mfma_f32_32x32x16_bf16(b0,qr[d0],p0,0,0,0);p1=__builtin_amdgcn_mfma_f32_32x32x16_bf16(b1,qr[d0],p1,0,0,0);}}
}
typedef __attribute__((address_space(3))) const char* lds_cptr;
typedef short v4i16_t __attribute__((ext_vector_type(4)));
__device__ __forceinline__ void kload8(bf16x8*kf,lds_cptr kp){
  kf[0]=*(const __attribute__((address_space(3))) bf16x8*)(kp);      kf[1]=*(const __attribute__((address_space(3))) bf16x8*)(kp+512);
  kf[2]=*(const __attribute__((address_space(3))) bf16x8*)(kp+2048); kf[3]=*(const __attribute__((address_space(3))) bf16x8*)(kp+2560);
  kf[4]=*(const __attribute__((address_space(3))) bf16x8*)(kp+4096); kf[5]=*(const __attribute__((address_space(3))) bf16x8*)(kp+4608);
  kf[6]=*(const __attribute__((address_space(3))) bf16x8*)(kp+6144); kf[7]=*(const __attribute__((address_space(3))) bf16x8*)(kp+6656);
}
__device__ __forceinline__ void kload2(bf16x8*kf,lds_cptr kp,int j){ kf[2*j]=*(const __attribute__((address_space(3))) bf16x8*)(kp+j*2048); kf[2*j+1]=*(const __attribute__((address_space(3))) bf16x8*)(kp+j*2048+512); }
__device__ __forceinline__ s16x4 vtr(lds_cptr p){ return __builtin_bit_cast(s16x4,__builtin_amdgcn_ds_read_tr16_b64_v4i16((__attribute__((address_space(3))) v4i16_t*)p)); }
__device__ __forceinline__ float rowmax(const f32x16&p0,const f32x16&p1){
  float a=max3f(p0[0],p0[1],p1[0]),b=max3f(p0[2],p0[3],p1[1]);a=max3f(a,p1[2],p1[3]);
  #pragma unroll
  for(int r=4;r<16;r+=4){a=max3f(a,p0[r],p0[r+1]);b=max3f(b,p0[r+2],p0[r+3]);a=max3f(a,p1[r],p1[r+1]);b=max3f(b,p1[r+2],p1[r+3]);}
  const float m=max2f(a,b);
  auto rr=__builtin_amdgcn_permlane32_swap(__float_as_uint(m),__float_as_uint(m),false,false);
  return max2f(__uint_as_float(rr[0]),__uint_as_float(rr[1]));
}
__device__ __forceinline__ void pv(f32x16*o,int vb,bf16x8 pa0,bf16x8 pa1,bf16x8 pa2,bf16x8 pa3){
  #pragma unroll
  for(int d0=0;d0<4;++d0){s16x4 lo[4],hi[4];
    #pragma unroll
    for(int ks=0;ks<4;++ks){
      asm volatile("ds_read_b64_tr_b16 %0,%1 offset:%c2":"=&v"(lo[ks]):"v"(vb),"i"(d0*4096+ks*1024):"memory");
      asm volatile("ds_read_b64_tr_b16 %0,%1 offset:%c2":"=&v"(hi[ks]):"v"(vb),"i"(d0*4096+ks*1024+512):"memory");}
    asm volatile("s_waitcnt lgkmcnt(0)":::"memory");SBAR();
    #define PK(k) (bf16x8){lo[k][0],lo[k][1],lo[k][2],lo[k][3],hi[k][0],hi[k][1],hi[k][2],hi[k][3]}
    o[d0]=__builtin_amdgcn_mfma_f32_32x32x16_bf16(pa0,PK(0),o[d0],0,0,0);
    o[d0]=__builtin_amdgcn_mfma_f32_32x32x16_bf16(pa1,PK(1),o[d0],0,0,0);
    o[d0]=__builtin_amdgcn_mfma_f32_32x32x16_bf16(pa2,PK(2),o[d0],0,0,0);
    o[d0]=__builtin_amdgcn_mfma_f32_32x32x16_bf16(pa3,PK(3),o[d0],0,0,0);
    #undef PK
  }
}

#ifndef ATTN_STORE16
#define ATTN_STORE16(p,v) (*(u32x4*)(p)=(v))
#endif
template<int THRL> __device__ __forceinline__ void attn_unit(int b,int vh,int qb,const bf16*P,bf16*O,char*shm){
  int tid_=threadIdx.x; asm volatile("":"+v"(tid_)); const int tid=tid_,lane=tid&63,r32=lane&31,hi=lane>>5; const int wid=__builtin_amdgcn_readfirstlane(tid>>6);
  const long rowbase=(long)b*SEQ; const int q0=qb*QB;
  const bf16*Qw=P+(rowbase+q0+wid*QBLK)*PIN+vh*D;
  const bf16*Kh=P+rowbase*PIN+512+vh*D,*Vh=P+rowbase*PIN+1024+(vh>>1)*DV;
  const unsigned lds0=(unsigned)(uintptr_t)shm;
  float*wsf=(float*)(shm+LDS_WS)+wid*64;
  const bf16*ksrc=Kh+(long)lane*PIN+wid*8;
  const bf16*vsrc=Vh+(long)(16*(wid&3)+(lane>>2))*PIN+(wid>>2)*32+(lane&3)*8;
  const unsigned kdst=lds0+LDS_K+wid*1024, vdst=lds0+LDS_V+wid*1024;
  #define DMA_K(t,slot) glds16(ksrc+(long)(t)*KVBLK*PIN,(unsigned)__builtin_amdgcn_readfirstlane(kdst+(slot)))
  #define DMA_V(t,slot) do{ glds16(vsrc+(long)(t)*KVBLK*PIN,(unsigned)__builtin_amdgcn_readfirstlane(vdst+2*(slot))); glds16(vsrc+(long)(t)*KVBLK*PIN+64,(unsigned)__builtin_amdgcn_readfirstlane(vdst+2*(slot)+8192)); }while(0)
  const int vb0=(int)(lds0+LDS_V)+((lane>>4)&1)*32+(lane&3)*8+(4*hi+((lane&15)>>2))*64;
  const char*Kbase=shm+LDS_K; bf16x8 kf[8];
  const lds_cptr shm3=(lds_cptr)shm; const lds_cptr kp0=shm3+LDS_K+hi*1024+r32*16; const lds_cptr vp0=shm3+LDS_V+((lane>>4)&1)*32+(lane&3)*8+(4*hi+((lane&15)>>2))*64;
  const int NT=(q0+QB)/KVBLK;
  DMA_K(0,0);DMA_V(0,0);DMA_K(1,SLOTB);
  bf16x8 qr[4];
  #pragma unroll
  for(int d0=0;d0<4;++d0)qr[d0]=*reinterpret_cast<const bf16x8*>(&Qw[(long)r32*PIN+d0*16+hi*8]);
  float mhat=0.f,l_reg=0.f;f32x16 o[4];o[0]=f32x16{};o[1]=f32x16{};o[2]=f32x16{};o[3]=f32x16{};f32x16 negm;{float nz_=0.f;asm volatile("":"+v"(nz_));_Pragma("unroll") for(int r=0;r<16;++r)negm[r]=nz_;}asm volatile("":"+v"(negm));
  const int qrel=wid*QBLK+r32;
  #define CMASK(P0,P1,t) do{int jb_=(t)-(NT-4); if(jb_>=0)cmask(P0,P1,jb_,qrel,hi);}while(0)
  bool resc=false;
  #define START(P0,P1) do{ const float rm=rowmax(P0,P1); resc=false; \
    { const float dl=rm; mhat=fadd_s(mhat,dl); \
      _Pragma("unroll") for(int r=0;r<16;++r){P0[r]=fsub_s(P0[r],dl);P1[r]=fsub_s(P1[r],dl);} \
      _Pragma("unroll") for(int r=0;r<16;++r)negm[r]=-mhat; asm volatile("":"+v"(negm)); } \
    _Pragma("unroll") for(int r=0;r<16;++r)P0[r]=__builtin_amdgcn_exp2f(P0[r]); }while(0)
  #define RESC() do{ if(resc){ asm volatile("s_waitcnt lgkmcnt(0)":::"memory"); \
      _Pragma("unroll") for(int d_=0;d_<4;++d_) _Pragma("unroll") for(int r=0;r<16;++r)o[d_][r]*=wsf[crow(r,hi)]; } }while(0)
  f32x16 pA0,pA1,pB0,pB1;
  int sl_prev=0,sl_cur=0,sl_next=SLOTB;
  #define ROT() do{sl_prev=sl_cur;sl_cur=sl_next;sl_next=(sl_next==(NSLOT-1)*SLOTB)?0:sl_next+SLOTB;}while(0)
  DMA_K(2,2*SLOTB);
  WAIT_BAR(3);
  qkt(pA0,pA1,Kbase,qr,negm,r32,hi);asm volatile("s_nop 15\n\ts_nop 7":"+v"(pA0),"+v"(pA1));CMASK(pA0,pA1,0);
  START(pA0,pA1);
  _Pragma("unroll") for(int r=0;r<16;++r)pA1[r]=__builtin_amdgcn_exp2f(pA1[r]);
  WAIT_BAR(0);
  DMA_K(3,0);DMA_V(1,SLOTB);
  ROT();
  kload8(kf,kp0+sl_cur);
  WAIT_BAR(3);
  s16x4 vlo[4],vhi[4]; u32x4 pw0,pw1,pw2,pw3;
  #define PKW(P,B) cvtpk_s(P[B],P[B+1])
  #define PAF(k) __builtin_bit_cast(bf16x8,pw##k)
  #define VFR(i) (bf16x8){vlo[i][0],vlo[i][1],vlo[i][2],vlo[i][3],vhi[i][0],vhi[i][1],vhi[i][2],vhi[i][3]}
  #define PIN(x) asm volatile("":"+v"(x))
  #define MX3(a,b,c) __builtin_fmaxf(__builtin_fmaxf((a),(b)),(c))
  #define GAPA(MF,A0,A1,A2,A3,W0,W1,PW) do{ MF; sacc+=A0; sacc+=A1; sacc+=A2; sacc+=A3; PIN(sacc); W0; W1; PIN(PW); SBAR(); }while(0)
  #define EX(v) __builtin_amdgcn_exp2f(v)
  #define VRD(dq,ks) do{ vlo[dq]=vtr(vp_+((dq)*4096+(ks)*1024)); vhi[dq]=vtr(vp_+((dq)*4096+(ks)*1024+512)); }while(0)
  #define GAPB(DQ,KS,X,B) do{ o[DQ]=__builtin_amdgcn_mfma_f32_32x32x16_bf16(PAF(KS),VFR(DQ),o[DQ],0,0,0); if((KS)<3){ VRD(DQ,(KS)+1); } X[B]=EX(X[B]); X[B+1]=EX(X[B+1]); PIN(X); SBAR(); }while(0)
  #define KRD(G,j) do{ if(G){ kload2(kf,kp0+sl_next,j); SBAR(); } }while(0)
  #define STEP(C0,C1,P0,P1,t,GK,GV,GL) do{ SBAR(); \
    const lds_cptr vp_=vp0+2*sl_prev; \
    float sacc=(P0[0]+P0[1]); \
    GAPA(C0=__builtin_amdgcn_mfma_f32_32x32x16_bf16(kf[0],qr[0],negm,0,0,0), P0[2],P0[3],P0[4],P0[5],     pw0[0]=PKW(P0,0), pw0[1]=PKW(P0,2), pw0); \
    GAPA(C1=__builtin_amdgcn_mfma_f32_32x32x16_bf16(kf[1],qr[0],negm,0,0,0), P0[6],P0[7],P0[8],P0[9],     pw0[2]=PKW(P0,4), pw0[3]=PKW(P0,6), pw0); \
    GAPA(C0=__builtin_amdgcn_mfma_f32_32x32x16_bf16(kf[2],qr[1],C0,0,0,0),   P0[10],P0[11],P0[12],P0[13], pw1[0]=PKW(P0,8), pw1[1]=PKW(P0,10), pw1); \
    GAPA(C1=__builtin_amdgcn_mfma_f32_32x32x16_bf16(kf[3],qr[1],C1,0,0,0),   P0[14],P0[15],P1[0],P1[1],   pw1[2]=PKW(P0,12),pw1[3]=PKW(P0,14), pw1); \
    VRD(0,0); SBAR(); GAPA(C0=__builtin_amdgcn_mfma_f32_32x32x16_bf16(kf[4],qr[2],C0,0,0,0),   P1[2],P1[3],P1[4],P1[5],     pw2[0]=PKW(P1,0), pw2[1]=PKW(P1,2), pw2); \
    VRD(1,0); SBAR(); GAPA(C1=__builtin_amdgcn_mfma_f32_32x32x16_bf16(kf[5],qr[2],C1,0,0,0),   P1[6],P1[7],P1[8],P1[9],     pw2[2]=PKW(P1,4), pw2[3]=PKW(P1,6), pw2); \
    VRD(2,0); SBAR(); GAPA(C0=__builtin_amdgcn_mfma_f32_32x32x16_bf16(kf[6],qr[3],C0,0,0,0),   P1[10],P1[11],P1[12],P1[13], pw3[0]=PKW(P1,8), pw3[1]=PKW(P1,10), pw3); \
    VRD(3,0); SBAR(); GAPA(C1=__builtin_amdgcn_mfma_f32_32x32x16_bf16(kf[7],qr[3],C1,0,0,0),   P1[14],P1[15],0.f,0.f,       pw3[2]=PKW(P1,12),pw3[3]=PKW(P1,14), pw3); \
    l_reg+=sacc; \
    if(GK){DMA_K((t)+3,sl_cur);} if(GV){DMA_V((t)+1,sl_next);} \
    CMASK(C0,C1,t); \
    { float a=MX3(C0[0],C0[1],C1[0]),b=MX3(C0[2],C0[3],C1[1]); a=MX3(a,C1[2],C1[3]); \
      _Pragma("unroll") for(int r=4;r<16;r+=4){a=MX3(a,C0[r],C0[r+1]);b=MX3(b,C0[r+2],C0[r+3]);a=MX3(a,C1[r],C1[r+1]);b=MX3(b,C1[r+2],C1[r+3]);} \
      float rm=__builtin_fmaxf(a,b); { auto rr=__builtin_amdgcn_permlane32_swap(__float_as_uint(rm),__float_as_uint(rm),false,false); rm=__builtin_fmaxf(__uint_as_float(rr[0]),__uint_as_float(rr[1])); } \
      resc=false; \
      if(__builtin_expect(__any(rm>(float)THRL),0)){ const float dl=__builtin_fmaxf(rm,0.f); mhat+=dl; \
        _Pragma("unroll") for(int r=0;r<16;++r){C0[r]-=dl;C1[r]-=dl;} \
        _Pragma("unroll") for(int r=0;r<16;++r)negm[r]=-mhat; asm volatile("":"+v"(negm)); \
        const float f=__builtin_amdgcn_exp2f(-dl); l_reg*=f; if(hi==0)wsf[r32]=f; resc=true; } } \
    SBAR(); \
    GAPB(0,0,C0,0);  GAPB(1,0,C0,2);  GAPB(2,0,C0,4);  GAPB(3,0,C0,6); \
    KRD(GL,0); GAPB(0,1,C0,8);  GAPB(1,1,C0,10); KRD(GL,1); GAPB(2,1,C0,12); GAPB(3,1,C0,14); \
    KRD(GL,2); GAPB(0,2,C1,0);  GAPB(1,2,C1,2);  KRD(GL,3); GAPB(2,2,C1,4);  GAPB(3,2,C1,6); \
    GAPB(0,3,C1,8);  GAPB(1,3,C1,10); GAPB(2,3,C1,12); GAPB(3,3,C1,14); \
    }while(0)
  int t=1;
  #undef CMASK
  #define CMASK(P0,P1,t) do{}while(0)
  for(;t+5<NT;t+=2){
    STEP(pB0,pB1,pA0,pA1,t,true,true,true);     WAIT_BAR(3); RESC(); ROT();
    STEP(pA0,pA1,pB0,pB1,t+1,true,true,true);   WAIT_BAR(3); RESC(); ROT();
  }
  #undef CMASK
  #define CMASK(P0,P1,t) do{int jb_=(t)-(NT-4); if(jb_>=0)cmask(P0,P1,jb_,qrel,hi);}while(0)
  #define ENDW(tt) do{ if((tt)+3<NT){WAIT_BAR(3);} else if((tt)+2<NT){WAIT_BAR(2);} else {WAIT_BAR(0);} }while(0)
  for(;t+1<NT;t+=2){
    STEP(pB0,pB1,pA0,pA1,t,(t+3<NT),(t+1<NT),(t+1<NT));       ENDW(t);   RESC(); ROT();
    STEP(pA0,pA1,pB0,pB1,t+1,(t+4<NT),(t+2<NT),(t+2<NT));     ENDW(t+1); RESC(); ROT();
  }
  STEP(pB0,pB1,pA0,pA1,NT-1,false,false,false); RESC();
  { float sacc=pB0[0]+pB0[1]; _Pragma("unroll") for(int r=2;r<16;++r)sacc+=pB0[r]; _Pragma("unroll") for(int r=0;r<16;++r)sacc+=pB1[r]; l_reg+=sacc;
    pw0=(u32x4){PKW(pB0,0),PKW(pB0,2),PKW(pB0,4),PKW(pB0,6)};pw1=(u32x4){PKW(pB0,8),PKW(pB0,10),PKW(pB0,12),PKW(pB0,14)};pw2=(u32x4){PKW(pB1,0),PKW(pB1,2),PKW(pB1,4),PKW(pB1,6)};pw3=(u32x4){PKW(pB1,8),PKW(pB1,10),PKW(pB1,12),PKW(pB1,14)};
    SBAR(); pv(o,vb0+2*sl_cur,PAF(0),PAF(1),PAF(2),PAF(3)); }
  #undef PKW
  #undef PAF
  #undef VFR
  #undef PIN
  #undef MX3
  #undef GAPA
  #undef GAPB
  #undef EX
  #undef VRD
  #undef KRD
  #undef STEP
  #undef ENDW
  {auto rr=__builtin_amdgcn_permlane32_swap(__float_as_uint(l_reg),__float_as_uint(l_reg),false,false);l_reg=__uint_as_float(rr[0])+__uint_as_float(rr[1]);}
  if(hi==0)wsf[32+r32]=l_reg;asm volatile("s_waitcnt lgkmcnt(0)":::"memory");
  float rli[16];
  #pragma unroll
  for(int r=0;r<16;++r)rli[r]=__builtin_amdgcn_rcpf(wsf[32+crow(r,hi)]);
  bf16*Ow=O+(rowbase+q0+wid*QBLK)*POUT+vh*DV;
  { bf16*stg=(bf16*)(shm+LDS_OST)+wid*4096;
    #pragma unroll
    for(int r=0;r<16;++r){const int orow=crow(r,hi);
      #pragma unroll
      for(int d0=0;d0<4;++d0)stg[orow*128+d0*32+r32]=__float2bfloat16(o[d0][r]*rli[r]);}
    asm volatile("s_waitcnt lgkmcnt(0)":::"memory");
    #pragma unroll
    for(int i=0;i<8;++i){const int row=i*4+(lane>>4),ch=lane&15; const u32x4 v=*(const u32x4*)(stg+row*128+ch*8); ATTN_STORE16(Ow+(long)row*POUT+ch*8,v);} }
  asm volatile("s_waitcnt lgkmcnt(0)\n\ts_barrier":::"memory");
  #undef DMA_K
  #undef DMA_V
  #undef CMASK
  #undef START
  #undef RESC
  #undef ROT
}
constexpr int ATTN_LDS_BYTES=LDS_BYTES;
struct AttnUnit { int bh; int qb; };
struct StaticOrder {
  int vcu;
  __device__ __forceinline__ explicit StaticOrder(int grid,int block):vcu((block%8)*(grid/8)+block/8){}
  __device__ __forceinline__ bool next(int i,AttnUnit&u)const{ if(i>=2)return false; const int s=vcu&7; u.bh=vcu>>3; u.qb=(i==0)?15-s:s; return true; }
};
template<class Sched,int THRL=8> __device__ __forceinline__ void attn_phase(char*lds,const bf16*P,bf16*O,const Sched&S){
  AttnUnit u;
  for(int i=0;S.next(i,u);++i){ attn_unit<THRL>(u.bh/NHEAD,u.bh%NHEAD,u.qb,P,O,lds); }
}
#undef SBAR
#undef WAIT_BAR
}
constexpr int NWAVES = 8;
constexpr int NB = 4, SEQ = 4096, D = 1024, T = NB * SEQ, NPROJ = 3072, NE = 256, FF = 256, KSEL = 8, NSLOT9 = 9;
constexpr float NORM_EPS = 1e-6f;
constexpr size_t MiB = 1u << 20;
constexpr size_t WS_CTL = 0, CTL_ZERO_BYTES = 65536;
constexpr size_t WS_MOD = 1 * MiB;
constexpr size_t WS_COS = 2 * MiB, WS_SIN = 4 * MiB;
constexpr size_t WS_WIN = 6 * MiB, WS_WOUT = 12 * MiB, WS_WR = 14 * MiB;
constexpr size_t WS_XN = 16 * MiB;
constexpr size_t WS_PROJ = 48 * MiB;
constexpr size_t WS_SVT = 144 * MiB;
constexpr size_t WS_ORAW = 160 * MiB;
constexpr size_t WS_MIXED = 192 * MiB;
constexpr size_t WS_R = 224 * MiB;
constexpr size_t WS_LTOK = 304 * MiB, WS_LW = 321 * MiB;
constexpr size_t WS_H2 = 338 * MiB;
constexpr size_t WS_ACT = 372 * MiB;
constexpr size_t WS_Y = 416 * MiB;
constexpr size_t WS_END = WS_Y + (size_t)T * NSLOT9 * D * 2;
constexpr int CW_QUEUE = 8192;
constexpr int CW_COUNT = 1024;
constexpr int CW_BAR = 4096;
constexpr int RING_OFF = 0, RING_BYTES = 151552;
constexpr int LDSCTL_OFF = RING_BYTES, MISC_OFF = LDSCTL_OFF + 320;
constexpr int LDS_BYTES = 152576;
static_assert(MISC_OFF + 128 <= LDS_BYTES, "LDS map");

#define GAS __attribute__((address_space(1)))
#define LAS __attribute__((address_space(3)))
typedef unsigned short bf16;
typedef unsigned v4u __attribute__((ext_vector_type(4)));
typedef unsigned v2u __attribute__((ext_vector_type(2)));
typedef float f32x4 __attribute__((ext_vector_type(4)));
typedef float f32x16 __attribute__((ext_vector_type(16)));
typedef short bf16x8 __attribute__((ext_vector_type(8)));
typedef GAS unsigned gu32;
#define RLX_AGENT __ATOMIC_RELAXED, __HIP_MEMORY_SCOPE_AGENT
#define LDS_WAIT() asm volatile("s_waitcnt lgkmcnt(0)" ::: "memory")
#define VM_WAIT() asm volatile("s_waitcnt vmcnt(0)" ::: "memory")
__device__ __forceinline__ unsigned pk2(float lo, float hi) { return pg8::cvt_pk_bf16(lo, hi); }
__device__ __forceinline__ float bflo(unsigned w) { return __uint_as_float(w << 16); }
__device__ __forceinline__ float bfhi(unsigned w) { return __uint_as_float(w & 0xffff0000u); }

#define XB_TMO      128
#define XB_XCNT(j)  (256  + 64 * (j))
#define XB_XSUB(j)  (1280 + 64 * (j))
#define XB_XGEN(j)  (2304 + 64 * (j))
#define XB_TOP      3328
#define XB_TOPGEN   3392
#define XCD_BAR_WORDS 3456
#define XB_SPIN_CAP (1u << 18)

__device__ __forceinline__ unsigned xb_ld(unsigned* p)              { return __hip_atomic_load(p, __ATOMIC_RELAXED, __HIP_MEMORY_SCOPE_AGENT); }
__device__ __forceinline__ unsigned xb_add(unsigned* p, unsigned v) { return __hip_atomic_fetch_add(p, v, __ATOMIC_RELAXED, __HIP_MEMORY_SCOPE_AGENT); }
__device__ __forceinline__ unsigned xb_xcc_id() { return (unsigned)__builtin_amdgcn_s_getreg((3 << 11) | 20) & 0xFu; }
#define XB_SPIN(cond, bar) do { unsigned _sp = 0; while (cond) { __builtin_amdgcn_s_sleep(1); \
    if ((++_sp & 255u) == 0u) { if (xb_ld(&(bar)[XB_TMO])) break; if (_sp > XB_SPIN_CAP) { atomicAdd(&(bar)[XB_TMO], 1u); break; } } } } while (0)

struct XcdBarrier {
    unsigned* bar; unsigned x;
    volatile LAS unsigned* st;
};

__device__ __forceinline__ XcdBarrier xcd_barrier_post(unsigned* bar, volatile LAS unsigned* st) {
    XcdBarrier b; b.bar = bar; b.x = xb_xcc_id(); b.st = st;
    if (threadIdx.x == 0) (void)xb_add(&bar[XB_XCNT(b.x)], 1u);
    return b;
}
__device__ __forceinline__ void xcd_barrier_complete(unsigned* bar, unsigned x, unsigned& nloc, unsigned& nx) {
    const unsigned G = gridDim.x * gridDim.y * gridDim.z;
    unsigned sum, cnt, mine, sp = 0u;
    for (;;) {
        sum = 0u; cnt = 0u; mine = 0u;
#pragma unroll
        for (unsigned j = 0; j < 16; ++j) { const unsigned c = xb_ld(&bar[XB_XCNT(j)]); sum += c; cnt += (c > 0u) ? 1u : 0u; mine = (j == x) ? c : mine; }
        if (sum == G) break;
        __builtin_amdgcn_s_sleep(1);
        if ((++sp & 255u) == 0u) { if (xb_ld(&bar[XB_TMO])) break; if (sp > XB_SPIN_CAP) { atomicAdd(&bar[XB_TMO], 1u); break; } }
    }
    nloc = mine > 0u ? mine : 1u; nx = cnt > 0u ? cnt : 1u;
}

__device__ __forceinline__ void xcd_barrier(const XcdBarrier& b) {
    asm volatile("s_waitcnt vmcnt(0)" ::: "memory");
    __syncthreads();
    if (threadIdx.x == 0) {
        unsigned* bar = b.bar;
        __builtin_amdgcn_s_waitcnt(0);
        unsigned nloc = b.st[0], nx = b.st[1];
        if (nloc == 0u) { xcd_barrier_complete(bar, b.x, nloc, nx); b.st[0] = nloc; b.st[1] = nx; }
        const unsigned old = xb_add(&bar[XB_XSUB(b.x)], 1u);
        const unsigned gen = old / nloc;
        if (old + 1u == (gen + 1u) * nloc) {
            __builtin_amdgcn_fence(__ATOMIC_RELEASE, "agent");
            asm volatile("s_waitcnt vmcnt(0)" ::: "memory");
            const unsigned og = xb_add(&bar[XB_TOP], 1u);
            const unsigned tg = og / nx;
            if (og + 1u == (tg + 1u) * nx) xb_add(&bar[XB_TOPGEN], 1u);
            else XB_SPIN(xb_ld(&bar[XB_TOPGEN]) == tg, bar);
            __builtin_amdgcn_fence(__ATOMIC_ACQUIRE, "agent");
            xb_add(&bar[XB_XGEN(b.x)], 1u);
            asm volatile("s_waitcnt vmcnt(0)" ::: "memory");
        } else {
            XB_SPIN(xb_ld(&bar[XB_XGEN(b.x)]) == gen, bar);
            __builtin_amdgcn_fence(__ATOMIC_ACQUIRE, "agent");
            asm volatile("s_waitcnt vmcnt(0)" ::: "memory");
        }
    }
    __syncthreads();
}


struct Frame {
    LAS unsigned char* lds;
    volatile LAS unsigned* MISC;
    unsigned* ctl;
    int tid, lane, wave;
    int vcu, G;
    const float *x, *c, *w_ada, *b_ada, *g_mix, *w_in, *g_q, *g_k, *lam, *g_sub, *w_out, *g_ffn, *w_router, *e_bias, *w_sh_gu, *w_sh_down, *w_gu, *w_down;
    const int* positions;
    float* out;
    float *MOD, *RCOS, *RSIN, *LW;
    bf16 *WIN, *WOUT, *WR, *XN, *PROJ, *SVT, *ORAW, *MIXED, *H2, *Y, *ACT, *DLT;
    unsigned* LTOK;
};
__device__ __forceinline__ float wave_sum(float v) {
#pragma unroll
    for (int o = 1; o < 64; o <<= 1) v += __shfl_xor(v, o);
    return v;
}
__device__ __forceinline__ float wave_max(float v) {
#pragma unroll
    for (int o = 1; o < 64; o <<= 1) v = fmaxf(v, __shfl_xor(v, o));
    return v;
}
__device__ __forceinline__ void p0_transpose_item(const float* W, int K, int N, bf16* WT, int k0, int n0, int dst_row0, LAS float* scr, int lane) {
#pragma unroll 8
    for (int i = 0; i < 32; ++i) { const int kk = 2 * i + (lane >> 5); scr[kk * 33 + (lane & 31)] = W[(size_t)(k0 + kk) * N + n0 + (lane & 31)]; }
    LDS_WAIT(); asm volatile("" ::: "memory");
    const int c = lane & 7;
#pragma unroll
    for (int j = 0; j < 4; ++j) { const int n = (lane >> 3) + 8 * j; const LAS float* s = scr + (8 * c) * 33 + n;
        v4u o; o.x = pk2(s[0 * 33], s[1 * 33]); o.y = pk2(s[2 * 33], s[3 * 33]); o.z = pk2(s[4 * 33], s[5 * 33]); o.w = pk2(s[6 * 33], s[7 * 33]);
        *(GAS v4u*)(WT + (size_t)(dst_row0 + n) * K + k0 + 8 * c) = o; }
    LDS_WAIT(); asm volatile("" ::: "memory");
}
__device__ __forceinline__ void p0_prologue(Frame& F) {
    LAS float* sc = (LAS float*)(F.lds + RING_OFF);
    LAS float* red = (LAS float*)(F.lds + RING_OFF + 16384);
    if (F.vcu < 192) {
        for (int i = F.tid; i < NB * D; i += NWAVES * 64) { const float v = F.c[i]; sc[i] = v / (1.0f + __expf(-v)); }
        __syncthreads();
        const int kr = F.lane >> 3, ch = F.lane & 7, n0 = 32 * F.vcu + 4 * ch;
        float a[4][4];
#pragma unroll
        for (int b = 0; b < 4; ++b)
#pragma unroll
            for (int j = 0; j < 4; ++j) a[b][j] = 0.f;
#pragma unroll 4
        for (int it = 0; it < 16; ++it) { const int k = 128 * F.wave + 8 * it + kr; const f32x4 wv = *(const f32x4*)(F.w_ada + (size_t)k * 6144 + n0);
#pragma unroll
            for (int b = 0; b < 4; ++b) { const float s = sc[b * D + k];
#pragma unroll
                for (int j = 0; j < 4; ++j) a[b][j] += s * wv[j]; } }
#pragma unroll
        for (int b = 0; b < 4; ++b)
#pragma unroll
            for (int j = 0; j < 4; ++j) { float v = a[b][j]; v += __shfl_xor(v, 8); v += __shfl_xor(v, 16); v += __shfl_xor(v, 32); a[b][j] = v; }
        if (kr == 0) {
#pragma unroll
            for (int b = 0; b < 4; ++b)
#pragma unroll
                for (int j = 0; j < 4; ++j) red[(F.wave * 4 + b) * 32 + 4 * ch + j] = a[b][j]; }
        __syncthreads();
        if (F.tid < 128) { const int b = F.tid >> 5, col = F.tid & 31; float s = F.b_ada[32 * F.vcu + col];
#pragma unroll
            for (int w = 0; w < 8; ++w) s += red[(w * 4 + b) * 32 + col];
            F.MOD[b * 6144 + 32 * F.vcu + col] = s; }
        __syncthreads();
    }
    LAS float* scr = (LAS float*)(F.lds + RING_OFF + 32768 + F.wave * 9216);
    const int gw = F.vcu * NWAVES + F.wave, NGW = F.G * NWAVES;
    constexpr int I_IN = (D / 64) * (NPROJ / 32), I_OUT = (D / 64) * (D / 32), I_R = (D / 64) * (NE / 32);
    for (int it = gw; it < I_IN + I_OUT + I_R; it += NGW) {
        int r = it;
        if (r < I_IN) { const int nblk = NPROJ / 32, kb = r / nblk, nb = r % nblk, n0 = 32 * nb;
            const int cl = n0 & 255, dst = (n0 & ~255) + 128 * ((cl >> 5) & 1) + 32 * (cl >> 6);
            p0_transpose_item(F.w_in, D, NPROJ, F.WIN, 64 * kb, n0, dst, scr, F.lane); continue; }
        r -= I_IN;
        if (r < I_OUT) { const int nblk = D / 32, kb = r / nblk, nb = r % nblk; p0_transpose_item(F.w_out, D, D, F.WOUT, 64 * kb, 32 * nb, 32 * nb, scr, F.lane); continue; }
        r -= I_OUT;
        { const int nblk = NE / 32, kb = r / nblk, nb = r % nblk; p0_transpose_item(F.w_router, D, NE, F.WR, 64 * kb, 32 * nb, 32 * nb, scr, F.lane); }
    }
    for (int idx = (int)blockIdx.x * (NWAVES * 64) + F.tid; idx < T * 32; idx += F.G * NWAVES * 64) {
        const int t = idx >> 5, i = idx & 31;
        const float inv = exp2f(-(float)i * (13.287712379549449f / 32.0f));
        const float ang = (float)F.positions[t] * inv;
        F.RCOS[idx] = cosf(ang); F.RSIN[idx] = sinf(ang);
    }
}
__device__ __forceinline__ void rows_adaln(Frame& F, const float* src, const float* g, const float* shift, const float* scale, bf16* dst) {
    const int gw = F.vcu * NWAVES + F.wave, NGW = F.G * NWAVES;
    for (int m = gw; m < T; m += NGW) {
        const int b = m >> 12;
        const GAS f32x4* xr = (const GAS f32x4*)(src + (size_t)m * D) + F.lane;
        f32x4 v[4]; float s2 = 0.f;
#pragma unroll
        for (int j = 0; j < 4; ++j) { v[j] = xr[64 * j]; s2 += (v[j].x * v[j].x + v[j].y * v[j].y) + (v[j].z * v[j].z + v[j].w * v[j].w); }
        const float rstd = 1.f / sqrtf(wave_sum(s2) * (1.f / D) + NORM_EPS);
        GAS v2u* o8 = (GAS v2u*)(dst + (size_t)m * D) + F.lane;
#pragma unroll
        for (int j = 0; j < 4; ++j) { const int c = 4 * F.lane + 256 * j;
            const f32x4 gv = *(const f32x4*)(g + c), sh = *(const f32x4*)(shift + b * 6144 + c), sc = *(const f32x4*)(scale + b * 6144 + c);
            const f32x4 y = v[j] * rstd * gv * (sc + 1.0f) + sh;
            v2u w; w.x = pk2(y.x, y.y); w.y = pk2(y.z, y.w); o8[64 * j] = w; }
    }
}
constexpr float SB_EXIT_LOG2 = 48.0f;
__device__ __forceinline__ int crow16(int r, int h) { return (r & 3) + 8 * (r >> 2) + 4 * h; }
__device__ __forceinline__ void sb_wave_tile(const bf16* PROJ, const bf16* SVT, bf16* MIXED, int b, int hd, int qt, int lane) {
    const int r32 = lane & 31, hi = lane >> 5;
    const bf16* Qp = PROJ + (size_t)(b * SEQ + 32 * qt + r32) * NPROJ + 1536 + hd * 64 + 8 * hi;
    bf16x8 qf[4];
#pragma unroll
    for (int s = 0; s < 4; ++s) qf[s] = *(const bf16x8*)(Qp + 16 * s);
    bf16x8 tf[2];
#pragma unroll
    for (int s = 0; s < 2; ++s)
#pragma unroll
        for (int j = 0; j < 8; ++j) tf[s][j] = (16 * s + 8 * (j >> 2) + 4 * hi + (j & 3)) >= r32 ? (short)0x3F80 : (short)0;
    f32x16 oT[2];
#pragma unroll
    for (int i = 0; i < 16; ++i) { oT[0][i] = 0.f; oT[1][i] = 0.f; }
    float R = 0.f;
    const bf16* Kb = PROJ + (size_t)(b * SEQ + r32) * NPROJ + 2048 + hd * 64 + 8 * hi;
    const bf16* Vb = SVT + ((size_t)(b * 8 + hd) * 64 + r32) * SEQ + 4 * hi;
    for (int kt = qt; kt >= 0; --kt) {
        const bf16* Kp = Kb + (size_t)(32 * kt) * NPROJ;
        bf16x8 kf[4];
#pragma unroll
        for (int s = 0; s < 4; ++s) kf[s] = *(const bf16x8*)(Kp + 16 * s);
        v2u vlo[2][2], vhi[2][2];
#pragma unroll
        for (int dt = 0; dt < 2; ++dt)
#pragma unroll
            for (int s = 0; s < 2; ++s) { const bf16* vp = Vb + (size_t)(32 * dt) * SEQ + 32 * kt + 16 * s; vlo[dt][s] = *(const v2u*)vp; vhi[dt][s] = *(const v2u*)(vp + 8); }
        f32x16 z;
#pragma unroll
        for (int i = 0; i < 16; ++i) z[i] = 0.f;
#pragma unroll
        for (int s = 0; s < 4; ++s) z = __builtin_amdgcn_mfma_f32_32x32x16_bf16(kf[s], qf[s], z, 0, 0, 0);
        const bool diag = (kt == qt);
        float sp[16];
#pragma unroll
        for (int i = 0; i < 16; ++i) { const float zz = z[i]; float v = fmaxf(zz, 0.f) + __builtin_amdgcn_logf(1.0f + __builtin_amdgcn_exp2f(-fabsf(zz)));
            if (diag && crow16(i, hi) >= r32) v = 0.f; sp[i] = v; }
        v4u p0, p1; p0.x = pk2(sp[0], sp[1]); p0.y = pk2(sp[2], sp[3]); p0.z = pk2(sp[4], sp[5]); p0.w = pk2(sp[6], sp[7]);
        p1.x = pk2(sp[8], sp[9]); p1.y = pk2(sp[10], sp[11]); p1.z = pk2(sp[12], sp[13]); p1.w = pk2(sp[14], sp[15]);
        f32x16 cs;
#pragma unroll
        for (int i = 0; i < 16; ++i) cs[i] = R;
        cs = __builtin_amdgcn_mfma_f32_32x32x16_bf16(tf[0], __builtin_bit_cast(bf16x8, p0), cs, 0, 0, 0);
        cs = __builtin_amdgcn_mfma_f32_32x32x16_bf16(tf[1], __builtin_bit_cast(bf16x8, p1), cs, 0, 0, 0);
        float w[16];
#pragma unroll
        for (int i = 0; i < 16; ++i) { float v = __builtin_amdgcn_exp2f(z[i] - cs[i]); if (diag && crow16(i, hi) >= r32) v = 0.f; w[i] = v; }
        R = __shfl(cs[0], r32);
        const bool done_ = __all(R > SB_EXIT_LOG2) != 0;
        v4u w0, w1; w0.x = pk2(w[0], w[1]); w0.y = pk2(w[2], w[3]); w0.z = pk2(w[4], w[5]); w0.w = pk2(w[6], w[7]);
        w1.x = pk2(w[8], w[9]); w1.y = pk2(w[10], w[11]); w1.z = pk2(w[12], w[13]); w1.w = pk2(w[14], w[15]);
#pragma unroll
        for (int dt = 0; dt < 2; ++dt) {
            v4u a0; a0.x = vlo[dt][0].x; a0.y = vlo[dt][0].y; a0.z = vhi[dt][0].x; a0.w = vhi[dt][0].y;
            v4u a1; a1.x = vlo[dt][1].x; a1.y = vlo[dt][1].y; a1.z = vhi[dt][1].x; a1.w = vhi[dt][1].y;
            oT[dt] = __builtin_amdgcn_mfma_f32_32x32x16_bf16(__builtin_bit_cast(bf16x8, a0), __builtin_bit_cast(bf16x8, w0), oT[dt], 0, 0, 0);
            oT[dt] = __builtin_amdgcn_mfma_f32_32x32x16_bf16(__builtin_bit_cast(bf16x8, a1), __builtin_bit_cast(bf16x8, w1), oT[dt], 0, 0, 0);
        }
        if (done_) break;
    }
    bf16* Op = MIXED + (size_t)(b * SEQ + 32 * qt + r32) * D + 512 + hd * 64 + 4 * hi;
#pragma unroll
    for (int dt = 0; dt < 2; ++dt)
#pragma unroll
        for (int g = 0; g < 4; ++g) { v2u o; o.x = pk2(oT[dt][4 * g], oT[dt][4 * g + 1]); o.y = pk2(oT[dt][4 * g + 2], oT[dt][4 * g + 3]); *(v2u*)(Op + 32 * dt + 8 * g) = o; }
}
__device__ __forceinline__ void sb_phase(Frame& F) {
    const int bh = F.vcu >> 3, s = F.vcu & 7;
    if (bh >= NB * 8) return;
#pragma unroll 1
    for (int i = 0; i < 2; ++i) { const int qb = i == 0 ? 15 - s : s; sb_wave_tile(F.PROJ, F.SVT, F.MIXED, bh >> 3, bh & 7, 8 * qb + F.wave, F.lane); }
}
__device__ __forceinline__ void combine_phase(Frame& F) {
    const int gw = F.vcu * NWAVES + F.wave, NGW = F.G * NWAVES;
    const float l01 = wave_sum(F.lam[F.lane] * F.lam[64 + F.lane]), l23 = wave_sum(F.lam[128 + F.lane] * F.lam[192 + F.lane]);
    const float lmbda = expf(l01) - expf(l23) + 0.2f;
    const float g0 = F.g_sub[2 * F.lane] * 0.8f, g1 = F.g_sub[2 * F.lane + 1] * 0.8f;
    for (int m = gw; m < T; m += NGW) {
        const unsigned* orow = (const unsigned*)(F.ORAW + (size_t)m * D);
        unsigned* mrow = (unsigned*)(F.MIXED + (size_t)m * D);
#pragma unroll
        for (int h = 0; h < 4; ++h) {
            const unsigned a = orow[h * 128 + F.lane], c = orow[h * 128 + 64 + F.lane];
            const float o0 = bflo(a) - lmbda * bflo(c), o1 = bfhi(a) - lmbda * bfhi(c);
            const float rstd = 1.f / sqrtf(wave_sum(o0 * o0 + o1 * o1) * (1.f / 128.f) + NORM_EPS);
            mrow[h * 64 + F.lane] = pk2(o0 * rstd * g0, o1 * rstd * g1);
        }
    }
}
__device__ __forceinline__ unsigned ex_pk8(float a, float b, float c, float d) { return (unsigned)__builtin_amdgcn_cvt_pk_fp8_f32(c, d, __builtin_amdgcn_cvt_pk_fp8_f32(a, b, 0, false), true); }
constexpr int RT_ROWS = 64, RT_HP = 2064, RT_LP = 1040;
static_assert(RT_ROWS * RT_HP <= RING_BYTES && T / RT_ROWS == 256, "router phase LDS map / one tile per workgroup");
__device__ __forceinline__ void route_phase(Frame& F) {
    LAS unsigned char* lds = F.lds + RING_OFF;
    const int tid = F.tid, lane = F.lane, wid = F.wave;
    const float NEG = -INFINITY;
    for (int tile = F.vcu; tile < T / RT_ROWS; tile += F.G) {
        const int row0 = tile * RT_ROWS, b = row0 >> 12;
        __syncthreads();
        const float* shift = F.MOD + b * 6144 + 3 * 1024; const float* scale = F.MOD + b * 6144 + 4 * 1024;
#pragma unroll 1
        for (int r0 = 0; r0 < 8; r0 += 4) {
            f32x4 v[4][4]; v2u dd[4][4];
#pragma unroll
            for (int r = 0; r < 4; ++r) { const int m = row0 + 8 * wid + r0 + r;
                const GAS f32x4* xr = (const GAS f32x4*)(F.x + (size_t)m * D) + lane; const GAS v2u* dr = (const GAS v2u*)(F.DLT + (size_t)m * D) + lane;
#pragma unroll
                for (int j = 0; j < 4; ++j) { v[r][j] = xr[64 * j]; dd[r][j] = dr[64 * j]; } }
#pragma unroll
            for (int r = 0; r < 4; ++r) { const int lr = 8 * wid + r0 + r, m = row0 + lr; float s2 = 0.f;
#pragma unroll
                for (int j = 0; j < 4; ++j) { const v2u d = dd[r][j]; v[r][j].x += bflo(d.x); v[r][j].y += bfhi(d.x); v[r][j].z += bflo(d.y); v[r][j].w += bfhi(d.y);
                    s2 += (v[r][j].x * v[r][j].x + v[r][j].y * v[r][j].y) + (v[r][j].z * v[r][j].z + v[r][j].w * v[r][j].w); }
                const float rstd = 1.f / sqrtf(wave_sum(s2) * (1.f / D) + NORM_EPS);
                GAS unsigned* o8 = (GAS unsigned*)((GAS unsigned char*)F.H2 + (size_t)m * D) + lane;
#pragma unroll
                for (int j = 0; j < 4; ++j) { const int c = 4 * lane + 256 * j;
                    const f32x4 gv = *(const f32x4*)(F.g_ffn + c), sh = *(const f32x4*)(shift + c), sc = *(const f32x4*)(scale + c);
                    const f32x4 y = v[r][j] * rstd * gv * (sc + 1.0f) + sh;
                    v2u w; w.x = pk2(y.x, y.y); w.y = pk2(y.z, y.w); o8[64 * j] = ex_pk8(y.x, y.y, y.z, y.w); *(LAS v2u*)(lds + lr * RT_HP + c * 2) = w; } }
        }
        __syncthreads();
        const int fr = lane & 15, fq = lane >> 4;
        f32x4 acc[4][2];
#pragma unroll
        for (int mt = 0; mt < 4; ++mt)
#pragma unroll
            for (int nt = 0; nt < 2; ++nt) acc[mt][nt] = (f32x4){0.f, 0.f, 0.f, 0.f};
        const bf16* wr0 = F.WR + (size_t)(32 * wid + fr) * D + 8 * fq;
#pragma unroll 8
        for (int ks = 0; ks < D / 32; ++ks) {
            const bf16x8 b0 = *(const bf16x8*)(wr0 + 32 * ks), b1 = *(const bf16x8*)(wr0 + (size_t)16 * D + 32 * ks);
#pragma unroll
            for (int mt = 0; mt < 4; ++mt) { const bf16x8 a = *(const LAS bf16x8*)(lds + (16 * mt + fr) * RT_HP + (32 * ks + 8 * fq) * 2);
                acc[mt][0] = __builtin_amdgcn_mfma_f32_16x16x32_bf16(a, b0, acc[mt][0], 0, 0, 0); acc[mt][1] = __builtin_amdgcn_mfma_f32_16x16x32_bf16(a, b1, acc[mt][1], 0, 0, 0); }
        }
        __syncthreads();
#pragma unroll
        for (int mt = 0; mt < 4; ++mt)
#pragma unroll
            for (int nt = 0; nt < 2; ++nt)
#pragma unroll
                for (int j = 0; j < 4; ++j) *(LAS float*)(lds + (16 * mt + 4 * fq + j) * RT_LP + (32 * wid + 16 * nt + fr) * 4) = acc[mt][nt][j];
        __syncthreads();
        const int tl = lane >> 3, g = lane & 7, t = row0 + 8 * wid + tl;
        float s[32], bz[32];
#pragma unroll
        for (int i4 = 0; i4 < 8; ++i4) { const f32x4 lg = *(const LAS f32x4*)(lds + (8 * wid + tl) * RT_LP + (32 * g + 4 * i4) * 4); const f32x4 eb = *(const f32x4*)(F.e_bias + 32 * g + 4 * i4);
#pragma unroll
            for (int j = 0; j < 4; ++j) { const float sg = __builtin_amdgcn_rcpf(1.0f + __expf(-lg[j])); s[4 * i4 + j] = sg; bz[4 * i4 + j] = sg + eb[j]; } }
        float m1 = NEG, m2 = NEG;
#pragma unroll
        for (int i = 0; i < 32; ++i) { const float v = bz[i]; m2 = fmaxf(m2, fminf(m1, v)); m1 = fmaxf(m1, v); }
        const float gs = m1 + m2; int rank = 0;
#pragma unroll
        for (int gp = 0; gp < 8; ++gp) { const float og = __shfl(gs, (lane & ~7) + gp); rank += (og > gs || (og == gs && gp < g)) ? 1 : 0; }
        unsigned taken = rank < 4 ? 0u : 0xffffffffu;
        int my_e = 0; float my_s = 0.f, ssum = 0.f;
#pragma unroll 1
        for (int k = 0; k < KSEL; ++k) {
            float lm = NEG, ls = 0.f; int li = 0;
#pragma unroll
            for (int i = 0; i < 32; ++i) { const float v = ((taken >> i) & 1u) ? NEG : bz[i]; const bool up = v > lm; lm = up ? v : lm; li = up ? i : li; ls = up ? s[i] : ls; }
            float wm = lm, ws = ls; int we = 32 * g + li;
#pragma unroll
            for (int off = 1; off < 8; off <<= 1) { const float ov = __shfl_xor(wm, off), os = __shfl_xor(ws, off); const int oe = __shfl_xor(we, off);
                const bool take = ov > wm || (ov == wm && oe < we); wm = take ? ov : wm; ws = take ? os : ws; we = take ? oe : we; }
            if ((we >> 5) == g) taken |= 1u << (we & 31);
            if (g == k) { my_e = we; my_s = ws; }
            ssum += ws;
        }
        { unsigned* cnt = F.ctl + CW_COUNT; const unsigned rk = atomicAdd(cnt + my_e, 1u); const size_t p = (size_t)my_e * T + rk; F.LTOK[p] = (unsigned)t | ((unsigned)g << 16); F.LW[p] = my_s / ssum * 2.5f; }
        if (g == 0) { const size_t p = (size_t)NE * T + t; F.LTOK[p] = (unsigned)t | (8u << 16); F.LW[p] = 1.0f; }
    }
}
constexpr int EX_TOK = 0, EX_WGT = 1024, EX_PFX = 2048, EX_QW = 3584, EX_A0 = 4096, EX_ASL = 8192, EX_NAS = 6, EX_W0 = EX_A0 + EX_NAS * EX_ASL, EX_WST = 32768, EX_NST = 3;
static_assert(EX_W0 + EX_NST * EX_WST <= RING_BYTES, "expert LDS map");
constexpr int EX_ROWS = 256, EX_XQ = 34;
__device__ __forceinline__ v4u ex_gld16v(const char* sbase, unsigned voff) { v4u v; asm volatile("global_load_dwordx4 %0, %1, %2" : "=v"(v) : "v"(voff), "s"(sbase) : "memory"); return v; }
template <int AUX> __device__ __forceinline__ void ex_dma(const void* g, LAS unsigned char* l) { __builtin_amdgcn_global_load_lds((const unsigned*)g, (LAS unsigned*)l, 16, 0, AUX); }
template <int MODE>
__device__ __forceinline__ void ex_tile(Frame& F, LAS unsigned char* lds, int tid_, const float* W, int j, int nrows, unsigned char* ACT) {
    int tid = tid_; asm volatile("" : "+v"(tid));
    LAS unsigned* tokL = (LAS unsigned*)(lds + EX_TOK); LAS float* wgtL = (LAS float*)(lds + EX_WGT);
    const int lane = tid & 63, wid = __builtin_amdgcn_readfirstlane(tid >> 6), wr = wid >> 2, wc = wid & 3, fr = lane & 15, fq = lane >> 4;
    constexpr int K = MODE == 0 ? D : FF, ldw = MODE == 0 ? 512 : D, NK = K / 32, NB = K / 128, APITCH = MODE == 0 ? D : FF;
    const int wcol = MODE == 0 ? (((lane & 3) >> 1) * 256 + 128 * j + 32 * (lane >> 4) + 8 * ((lane >> 2) & 3) + 4 * (lane & 1)) : (256 * j + 4 * lane);
    const char* wsrc = (const char*)(W + (size_t)(4 * wid) * ldw);
    const unsigned wvoff = 4u * (unsigned)wcol;
    const char* abase = MODE == 0 ? (const char*)F.H2 : (const char*)ACT;
    const int arow0 = 32 * wid + (lane >> 3), ac = lane & 7;
    const int awoff = EX_A0 + arow0 * 32 + (ac & 1) * 16;
#define EX_ISSUE_W(ks, st) do { LAS unsigned char* sb_ = lds + EX_W0 + (st) * EX_WST; \
        _Pragma("unroll") for (int i_ = 0; i_ < 4; ++i_) ex_dma<0>(wsrc + (size_t)(32 * (ks) + i_) * (ldw * 4) + wvoff, sb_ + (4 * wid + i_) * 1024); } while (0)
#define EX_LOAD_A(b) do { _Pragma("unroll") for (int i_ = 0; i_ < 4; ++i_) { const int r_ = arow0 + 8 * i_; \
        const unsigned o_ = (MODE == 0 ? (tokL[r_] & 0xffffu) : (unsigned)r_) * (unsigned)APITCH + 16u * (unsigned)ac + 128u * (unsigned)(b); ar[i_] = ex_gld16v(abase, o_); } } while (0)
#define EX_WRITE_A(sb0, WAITSTR) do {   \
          \
        int sl_ = (sb0) + (ac >> 1); sl_ = sl_ >= EX_NAS ? sl_ - EX_NAS : sl_; \
        const unsigned ae_ = (unsigned)(uintptr_t)(lds + awoff + sl_ * EX_ASL), ao_ = (unsigned)(uintptr_t)(lds + (awoff ^ 16) + sl_ * EX_ASL); \
        asm volatile(WAITSTR "\n\tds_write_b128 %4, %0\n\tds_write_b128 %5, %1 offset:256\n\tds_write_b128 %4, %2 offset:512\n\tds_write_b128 %5, %3 offset:768" \
                     :: "v"(ar[0]), "v"(ar[1]), "v"(ar[2]), "v"(ar[3]), "v"(ae_), "v"(ao_) : "memory"); } while (0)
    v4u ar[4];
    f32x4 acc[8][4];
#pragma unroll
    for (int m = 0; m < 8; ++m)
#pragma unroll
        for (int q = 0; q < 4; ++q) acc[m][q] = (f32x4){0.f, 0.f, 0.f, 0.f};
    const bool active = 128 * wr < nrows;
    const int boff = EX_W0 + fq * 8192 + wc * 256 + fr * 16;
    const int aoff_r = EX_A0 + (128 * wr + fr) * 32 + ((fq ^ (((fr >> 3) & 1) << 1)) * 8);
    EX_LOAD_A(0); EX_ISSUE_W(0, 0); EX_ISSUE_W(1, 1);
    EX_WRITE_A(0, "s_waitcnt vmcnt(8)");
    int st = 0, as = 0;
#pragma unroll 4
    for (int ks = 0; ks < NK; ++ks) {
        { const int after = (ks + 1 < NK ? 4 : 0) + ((((ks & 3) == 1 || (ks & 3) == 2) && (ks >> 2) + 1 < NB) ? 4 : 0);
          if (after >= 8) asm volatile("s_waitcnt vmcnt(8)" ::: "memory"); else if (after >= 4) asm volatile("s_waitcnt vmcnt(4)" ::: "memory"); else asm volatile("s_waitcnt vmcnt(0)" ::: "memory"); }
        asm volatile("s_waitcnt lgkmcnt(0)" ::: "memory");
        __builtin_amdgcn_s_barrier();
        asm volatile("" ::: "memory");
        f32x4 xw[8]; long af[8];
        if (active) {
            const LAS unsigned char* bp = lds + boff + st * EX_WST;
#pragma unroll
            for (int jj = 0; jj < 8; ++jj) xw[jj] = *(const LAS f32x4*)(bp + jj * 1024);
            const LAS unsigned char* ap = lds + aoff_r + as * EX_ASL;
#pragma unroll
            for (int m = 0; m < 8; ++m) af[m] = *(const LAS long*)(ap + m * 512);
        }
        const int s2 = st + 2 >= EX_NST ? st + 2 - EX_NST : st + 2;
        if (ks + 2 < NK) EX_ISSUE_W(ks + 2, s2);
        if (active) {
            long bw[4];
#pragma unroll
            for (int q = 0; q < 4; ++q) { const unsigned lo = ex_pk8(xw[0][q], xw[1][q], xw[2][q], xw[3][q]), hi = ex_pk8(xw[4][q], xw[5][q], xw[6][q], xw[7][q]);
                bw[q] = (long)(((unsigned long long)hi << 32) | (unsigned long long)lo); }
            __builtin_amdgcn_s_setprio(1);
#pragma unroll
            for (int m = 0; m < 8; ++m)
#pragma unroll
                for (int q = 0; q < 4; ++q) acc[m][q] = __builtin_amdgcn_mfma_f32_16x16x32_fp8_fp8(bw[q], af[m], acc[m][q], 0, 0, 0);
            __builtin_amdgcn_s_setprio(0);
        }
        if ((ks & 3) == 0 && (ks >> 2) + 1 < NB) EX_LOAD_A((ks >> 2) + 1);
        if ((ks & 3) == 3 && ks + 1 < NK) {
            const int sb0 = as + 1 >= EX_NAS ? 0 : as + 1;
            EX_WRITE_A(sb0, "s_waitcnt vmcnt(12)");
        }
        st = st + 1 >= EX_NST ? 0 : st + 1; as = as + 1 >= EX_NAS ? 0 : as + 1;
    }
#undef EX_ISSUE_W
#undef EX_LOAD_A
#undef EX_WRITE_A
    if (active) {
        if (MODE == 0) {
#pragma unroll
            for (int m = 0; m < 8; ++m) { float o[8];
#pragma unroll
                for (int rg = 0; rg < 2; ++rg)
#pragma unroll
                    for (int q = 0; q < 4; ++q) { const float g = acc[m][q][rg], u = acc[m][q][rg + 2]; o[4 * rg + q] = g * __builtin_amdgcn_rcpf(1.0f + __expf(-g)) * u; }
                v2u w; w.x = ex_pk8(o[0], o[1], o[2], o[3]); w.y = ex_pk8(o[4], o[5], o[6], o[7]);
                *(v2u*)(ACT + (size_t)(128 * wr + 16 * m + fr) * FF + 128 * j + 32 * wc + 8 * fq) = w; }
        } else {
#pragma unroll
            for (int m = 0; m < 8; ++m) { const int row = 128 * wr + 16 * m + fr;
                if (row < nrows) { const unsigned ti = tokL[row]; const float wv = wgtL[row];
                    unsigned char* yp = (unsigned char*)F.Y + ((size_t)(ti & 0xffffu) * NSLOT9 + (ti >> 16)) * D + 256 * j + 64 * wc + 16 * fq;
                    v4u w;
#pragma unroll
                    for (int rg = 0; rg < 4; ++rg) { unsigned p = __builtin_amdgcn_cvt_pk_fp8_f32(acc[m][0][rg] * wv, acc[m][1][rg] * wv, 0, false);
                        w[rg] = __builtin_amdgcn_cvt_pk_fp8_f32(acc[m][2][rg] * wv, acc[m][3][rg] * wv, p, true); }
                    *(v4u*)yp = w; } }
        }
    }
    __builtin_amdgcn_s_barrier();
    asm volatile("" ::: "memory");
}
__device__ __forceinline__ void expert_unit(Frame& F, int e, int chunk, int nrows) {
    LAS unsigned char* lds = F.lds + RING_OFF;
    LAS unsigned* tokL = (LAS unsigned*)(lds + EX_TOK); LAS float* wgtL = (LAS float*)(lds + EX_WGT);
    const int tid = F.tid;
    if (tid < EX_ROWS) { const bool ok = tid < nrows; const size_t p = (size_t)e * T + (size_t)chunk * EX_ROWS + tid; tokL[tid] = ok ? F.LTOK[p] : 0u; wgtL[tid] = ok ? F.LW[p] : 0.f; }
    __syncthreads();
    const float* Wgu = e < NE ? F.w_gu + (size_t)e * D * 512 : F.w_sh_gu;
    const float* Wdn = e < NE ? F.w_down + (size_t)e * FF * D : F.w_sh_down;
    unsigned char* ACT = (unsigned char*)F.ACT + (size_t)F.vcu * EX_ROWS * FF;
#pragma unroll 1
    for (int j = 0; j < 2; ++j) ex_tile<0>(F, lds, tid, Wgu, j, nrows, ACT);
    VM_WAIT(); __syncthreads();
#pragma unroll 1
    for (int j = 0; j < 4; ++j) ex_tile<1>(F, lds, tid, Wdn, j, nrows, ACT);
}
__device__ __forceinline__ void expert_phase(Frame& F) {
    LAS unsigned char* lds = F.lds + RING_OFF;
    LAS unsigned* pfx = (LAS unsigned*)(lds + EX_PFX);
    LAS unsigned* qw = (LAS unsigned*)(lds + EX_QW);
    __syncthreads();
    LAS unsigned* cntL = (LAS unsigned*)(lds + EX_A0);
    if (F.tid < NE) cntL[F.tid] = __hip_atomic_load(F.ctl + CW_COUNT + F.tid, RLX_AGENT);
    __syncthreads();
    if (F.tid < 8) { const int x = F.tid; unsigned run = 0;
        for (int i = 0; i < 32; ++i) { pfx[x * EX_XQ + i] = run; run += (cntL[8 * i + x] + EX_ROWS - 1) / EX_ROWS; }
        pfx[x * EX_XQ + 32] = run; run += (T / EX_ROWS) / 8; pfx[x * EX_XQ + 33] = run; }
    __syncthreads();
    const int myx = (int)(xb_xcc_id() & 7u);
    int hop = 0;
#pragma unroll 1
    for (;;) {
        __syncthreads();
        if (F.tid == 0) { unsigned u = 0xffffffffu; int h = hop;
            for (; h < 8; ++h) { const int x = (myx + h) & 7; u = __hip_atomic_fetch_add(F.ctl + CW_QUEUE + 64 * x, 1u, RLX_AGENT); if (u < pfx[x * EX_XQ + 33]) break; }
            qw[0] = u; qw[1] = (unsigned)h; }
        __syncthreads();
        const int u = (int)qw[0]; hop = (int)qw[1];
        if (hop >= 8) break;
        const int x = (myx + hop) & 7;
        const LAS unsigned* px = pfx + x * EX_XQ;
        int lo = 0, hi = 32;
        while (lo < hi) { const int mid = (lo + hi + 1) >> 1; if ((int)px[mid] <= u) lo = mid; else hi = mid - 1; }
        int e, chunk, cnt;
        if (lo < 32) { e = 8 * lo + x; chunk = u - (int)px[lo]; cnt = (int)__hip_atomic_load(F.ctl + CW_COUNT + e, RLX_AGENT); }
        else { e = NE; chunk = 8 * x + (u - (int)px[32]); cnt = T; }
        const int nrows = min(EX_ROWS, cnt - EX_ROWS * chunk);
        expert_unit(F, e, chunk, nrows);
    }
}
__device__ __forceinline__ void final_phase(Frame& F) {
    typedef float f32x2 __attribute__((ext_vector_type(2)));
    const int gw = F.vcu * NWAVES + F.wave, NGW = F.G * NWAVES;
    for (int m = gw; m < T; m += NGW) {
        const float* gm = F.MOD + (size_t)(m >> 12) * 6144 + 5 * 1024;
        const unsigned* yrow = (const unsigned*)((const unsigned char*)F.Y + (size_t)m * NSLOT9 * D) + F.lane;
#pragma unroll
        for (int i = 0; i < 4; ++i) { const int c = 4 * F.lane + 256 * i; float a0 = 0.f, a1 = 0.f, a2 = 0.f, a3 = 0.f;
#pragma unroll
            for (int k = 0; k < NSLOT9; ++k) { const unsigned y = __builtin_nontemporal_load(yrow + k * (D / 4) + 64 * i);
                const f32x2 lo = __builtin_amdgcn_cvt_pk_f32_fp8(y, false), hi = __builtin_amdgcn_cvt_pk_f32_fp8(y, true); a0 += lo[0]; a1 += lo[1]; a2 += hi[0]; a3 += hi[1]; }
            f32x4 r = __builtin_nontemporal_load((const f32x4*)(F.x + (size_t)m * D + c));
            { const v2u d = __builtin_nontemporal_load((const v2u*)(F.DLT + (size_t)m * D + c)); r.x += bflo(d.x); r.y += bfhi(d.x); r.z += bflo(d.y); r.w += bfhi(d.y); }
            const f32x4 g = *(const f32x4*)(gm + c);
            f32x4 o; o.x = r.x + g.x * a0; o.y = r.y + g.y * a1; o.z = r.z + g.z * a2; o.w = r.w + g.w * a3;
            __builtin_nontemporal_store(o, (f32x4*)(F.out + (size_t)m * D + c)); }
    }
}
struct Args { const void* in[19]; float* out; unsigned char* ws; };
static_assert(sizeof(Args) == 21 * 8, "Args has no padding bytes");
__global__ void __launch_bounds__(NWAVES * 64, 2) hybrid_fwd(Args args) {
    extern __shared__ __attribute__((aligned(16))) unsigned char lds[];
    Frame F;
    F.lds = (LAS unsigned char*)lds;
    F.MISC = (volatile LAS unsigned*)(F.lds + MISC_OFF);
    F.tid = threadIdx.x; F.lane = F.tid & 63; F.wave = __builtin_amdgcn_readfirstlane(F.tid >> 6);
    F.G = gridDim.x; { const int bx = blockIdx.x; F.vcu = (F.G % 8 == 0) ? (bx % 8) * (F.G / 8) + bx / 8 : bx; }
    unsigned char* ws = args.ws;
    F.ctl = (unsigned*)(ws + WS_CTL);
    F.x = (const float*)args.in[0]; F.c = (const float*)args.in[1]; F.positions = (const int*)args.in[2]; F.w_ada = (const float*)args.in[3]; F.b_ada = (const float*)args.in[4];
    F.g_mix = (const float*)args.in[5]; F.w_in = (const float*)args.in[6]; F.g_q = (const float*)args.in[7]; F.g_k = (const float*)args.in[8]; F.lam = (const float*)args.in[9];
    F.g_sub = (const float*)args.in[10]; F.w_out = (const float*)args.in[11]; F.g_ffn = (const float*)args.in[12]; F.w_router = (const float*)args.in[13]; F.e_bias = (const float*)args.in[14];
    F.w_sh_gu = (const float*)args.in[15]; F.w_sh_down = (const float*)args.in[16]; F.w_gu = (const float*)args.in[17]; F.w_down = (const float*)args.in[18];
    F.out = args.out;
    F.MOD = (float*)(ws + WS_MOD); F.RCOS = (float*)(ws + WS_COS); F.RSIN = (float*)(ws + WS_SIN); F.DLT = (bf16*)(ws + WS_R); F.LW = (float*)(ws + WS_LW);
    F.WIN = (bf16*)(ws + WS_WIN); F.WOUT = (bf16*)(ws + WS_WOUT); F.WR = (bf16*)(ws + WS_WR); F.XN = (bf16*)(ws + WS_XN); F.PROJ = (bf16*)(ws + WS_PROJ); F.SVT = (bf16*)(ws + WS_SVT);
    F.ORAW = (bf16*)(ws + WS_ORAW); F.MIXED = (bf16*)(ws + WS_MIXED); F.H2 = (bf16*)(ws + WS_H2); F.Y = (bf16*)(ws + WS_Y); F.ACT = (bf16*)(ws + WS_ACT); F.LTOK = (unsigned*)(ws + WS_LTOK);
    for (int u = F.tid; u < (LDS_BYTES - LDSCTL_OFF) / 4; u += NWAVES * 64) ((LAS unsigned*)(F.lds + LDSCTL_OFF))[u] = 0u;
    __syncthreads();
    XcdBarrier bar = xcd_barrier_post(F.ctl + CW_BAR, F.MISC + 8);
#define GRID_BAR() xcd_barrier(bar)
#define PHASE_BEGIN() do { int t_ = threadIdx.x; asm volatile("" : "+v"(t_)); F.tid = t_; F.lane = t_ & 63; } while (0)

    PHASE_BEGIN(); p0_prologue(F);
    GRID_BAR();
    PHASE_BEGIN(); rows_adaln(F, F.x, F.g_mix, F.MOD + 0 * 1024, F.MOD + 1 * 1024, F.XN);
    GRID_BAR();
    {   pg8::Gemm g{F.XN, F.WIN, T, NPROJ, D}; pg8::StaticOrder S; S.init(T, NPROJ, F.G, (int)blockIdx.x);
        pg8::EpiProj E{F.PROJ, F.SVT, F.RCOS, F.RSIN, F.g_q, F.g_k};
        pg8::gemm_phase<pg8::EpiProj, pg8::StaticOrder, PG8_ALIGN, PG8_SP2>(F.lds + RING_OFF, g, S, E); }
    GRID_BAR();
    {   const attn_body::StaticOrder S((int)F.G, (int)blockIdx.x);
        attn_body::attn_phase<attn_body::StaticOrder>((char*)lds + RING_OFF, (const attn_body::bf16*)F.PROJ, (attn_body::bf16*)F.ORAW, S); }
    PHASE_BEGIN(); sb_phase(F);
    GRID_BAR();
    PHASE_BEGIN(); combine_phase(F);
    GRID_BAR();
    {   pg8::Gemm g{F.MIXED, F.WOUT, T, D, D}; pg8::StaticOrder S; S.init(T, D, F.G, (int)blockIdx.x);
        pg8::EpiGateBf16 E{F.MOD + 2 * 1024, F.DLT};
        pg8::gemm_phase<pg8::EpiGateBf16, pg8::StaticOrder, PG8_ALIGN, PG8_SP2>(F.lds + RING_OFF, g, S, E); }
    GRID_BAR();
    PHASE_BEGIN(); route_phase(F);
    GRID_BAR();
    PHASE_BEGIN(); expert_phase(F);
    GRID_BAR();
    PHASE_BEGIN(); final_phase(F);
}

extern "C" void kernel_launch(void* const* d_in, const int* in_sizes, int n_in, void* d_out, int out_size, void* d_ws, size_t ws_size, hipStream_t stream) {
    static int grid = 0;
    if (grid == 0) {
        if (n_in != 19 || out_size != T * D || ws_size < WS_END) { fprintf(stderr, "kernel_launch: unexpected problem shape (n_in %d, out %d, ws %zu); nothing launched\n", n_in, out_size, ws_size); grid = -1; return; }
        int dev = 0, cus = 0, per_cu = 0;
        if (hipGetDevice(&dev) != hipSuccess || hipDeviceGetAttribute(&cus, hipDeviceAttributeMultiprocessorCount, dev) != hipSuccess) { grid = -1; return; }
        if (hipFuncSetAttribute((const void*)hybrid_fwd, hipFuncAttributeMaxDynamicSharedMemorySize, LDS_BYTES) != hipSuccess) { fprintf(stderr, "kernel_launch: hipFuncSetAttribute failed\n"); grid = -1; return; }
        if (hipOccupancyMaxActiveBlocksPerMultiprocessor(&per_cu, (const void*)hybrid_fwd, NWAVES * 64, LDS_BYTES) != hipSuccess || per_cu < 1)
            fprintf(stderr, "kernel_launch: note: the occupancy query reports %d workgroups per CU\n", per_cu);
        (void)hipGetLastError();
        grid = cus;
        if (grid != 256) fprintf(stderr, "kernel_launch: %d CUs (expected 256)\n", grid);
    }
    if (grid < 0) return;
    if (hipMemsetAsync((char*)d_ws + WS_CTL, 0, CTL_ZERO_BYTES, stream) != hipSuccess) { fprintf(stderr, "kernel_launch: hipMemsetAsync failed\n"); return; }
    Args a{};
    for (int i = 0; i < 19; ++i) a.in[i] = d_in[i];
    a.out = (float*)d_out; a.ws = (unsigned char*)d_ws;
    hipLaunchKernelGGL(hybrid_fwd, dim3(grid), dim3(NWAVES * 64), LDS_BYTES, stream, a);
    const hipError_t le = hipPeekAtLastError();
    if (le != hipSuccess) fprintf(stderr, "kernel_launch: launch failed: %s\n", hipGetErrorName(le));
}
```

```cpp
#include <hip/hip_runtime.h>
#include <hip/hip_bf16.h>
#include <cstdio>
#include <cstdint>
#include <cmath>
namespace pg8 {
#define PG8_LAS __attribute__((address_space(3)))
typedef unsigned short bf16_t;
typedef short bf16x8 __attribute__((ext_vector_type(8)));
typedef float f32x4 __attribute__((ext_vector_type(4)));
typedef unsigned u32x4 __attribute__((ext_vector_type(4)));
constexpr int BM = 256, BK = 64, HALF = 128, HTB = HALF * BK * 2  , STAGE_BYTES = 8 * HTB, NXCD = 8, WGM = 8;

__host__ __device__ __forceinline__ int lds_byte(int r, int c) { const int st = (r >> 4) * 2 + (c >> 5), rr = r & 15, cc = c & 31, ob = rr * 64 + cc * 2; return st * 1024 + (ob ^ (((ob >> 9) & 1) << 5)); }
__host__ __device__ __forceinline__ void stage_rc(int b, int& R, int& C) { const int st = b / 1024, sb = b % 1024, swz = sb ^ (((sb >> 9) & 1) << 5); R = (st >> 1) * 16 + swz / 64; C = (st & 1) * 32 + (swz % 64) / 2; }
__host__ __device__ __forceinline__ int perm32(int rho) { const int n = rho >> 4, i = rho & 15; return 8 * (i >> 2) + 4 * n + (i & 3); }

struct Unit { int pm, pn; };
struct Gemm { const bf16_t* A; const bf16_t* Bt; int M, N, K; };

struct StaticOrder {
    int nM, nN, nwg, G, c;
    __host__ __device__ void init(int M, int N, int G_, int c_) { nM = M / BM; nN = N / BM; nwg = nM * nN; G = G_; c = c_; }
    __host__ __device__ bool next(int i, Unit& u) const {
        const long L = (long)i * G + c; if (L >= nwg) return false;
        int wgid = (int)L; { const int q = nwg / NXCD, r = nwg % NXCD, xcd = wgid % NXCD, off = wgid / NXCD; wgid = (xcd < r ? xcd * (q + 1) : r * (q + 1) + (xcd - r) * q) + off; }
        const int nig = WGM * nN, gid = wgid / nig, fm = gid * WGM, gsz = (nM - fm) < WGM ? (nM - fm) : WGM;
        u.pm = fm + ((wgid % nig) % gsz); u.pn = (wgid % nig) / gsz; return true;
    }
    __device__ __forceinline__ void a_ready(const Unit&) const {}
    __device__ __forceinline__ void done(const Unit&) const {}
};

__device__ __forceinline__ unsigned cvt_pk_bf16(float lo, float hi) { typedef float f2_t __attribute__((ext_vector_type(2))); typedef __bf16 b2_t __attribute__((ext_vector_type(2)));
    f2_t v = {lo, hi}; b2_t b = __builtin_convertvector(v, b2_t); return __builtin_bit_cast(unsigned, b); }
typedef unsigned u32x2 __attribute__((ext_vector_type(2)));
constexpr float QK_C2 = 0.125f * 1.4426950408889634f;

struct EpiGateBf16 {
    static constexpr bool PERM = false, AFTER_DRAIN = false;
    const float* gate; bf16_t* DLT;
    __device__ __forceinline__ void operator()(const f32x4 (&acc)[2][2][4][2], const Unit& u, int wr, int wc, int fr, int fq) const {
        const int row0 = u.pm * BM + wr * 64 + fr, col0 = u.pn * BM + wc * 32 + 4 * fq;
        const float* gb = gate + (size_t)(u.pm >> 4) * 6144 + col0;
        f32x4 gv[2][2];
#pragma unroll
        for (int bj = 0; bj < 2; ++bj)
#pragma unroll
            for (int n = 0; n < 2; ++n) gv[bj][n] = *(const f32x4*)(gb + bj * HALF + n * 16);
#pragma unroll
        for (int ai = 0; ai < 2; ++ai)
#pragma unroll
            for (int m = 0; m < 4; ++m) { bf16_t* rowp = DLT + (size_t)(row0 + ai * HALF + m * 16) * 1024 + col0;
#pragma unroll
                for (int bj = 0; bj < 2; ++bj)
#pragma unroll
                    for (int n = 0; n < 2; ++n) { const f32x4 v = gv[bj][n] * acc[ai][bj][m][n]; u32x2 w; w.x = cvt_pk_bf16(v[0], v[1]); w.y = cvt_pk_bf16(v[2], v[3]); *(u32x2*)(rowp + bj * HALF + n * 16) = w; } }
    }
};
struct EpiProj {
    static constexpr bool PERM = false, AFTER_DRAIN = false;
    bf16_t* P; bf16_t* SVT; const float* rcos; const float* rsin; const float* gq; const float* gk;
    __device__ __forceinline__ void operator()(const f32x4 (&acc)[2][2][4][2], const Unit& u, int wr, int wc, int fr, int fq) const {
        const int row0 = u.pm * BM + wr * 64 + fr, pn = u.pn;
        const int cbase = pn * BM + 64 * wc + 4 * fq;
        if (pn < 4) {
            const float* g = pn < 2 ? gq : gk; const float osc = pn < 2 ? QK_C2 : 1.0f;
            f32x4 gv[2][2];
#pragma unroll
            for (int bj = 0; bj < 2; ++bj)
#pragma unroll
                for (int n = 0; n < 2; ++n) gv[bj][n] = *(const f32x4*)(g + 32 * bj + 16 * n + 4 * fq);
#pragma unroll
            for (int ai = 0; ai < 2; ++ai)
#pragma unroll
                for (int m = 0; m < 4; ++m) { const int row = row0 + ai * HALF + m * 16; float ss = 0.f;
#pragma unroll
                    for (int bj = 0; bj < 2; ++bj)
#pragma unroll
                        for (int n = 0; n < 2; ++n) { const f32x4 v = acc[ai][bj][m][n]; ss += (v[0] * v[0] + v[1] * v[1]) + (v[2] * v[2] + v[3] * v[3]); }
                    ss += __shfl_xor(ss, 16); ss += __shfl_xor(ss, 32);
                    const float rstd = 1.0f / sqrtf(ss * (1.0f / 64.0f) + 1e-6f);
                    bf16_t* prow = P + (size_t)row * 3072 + cbase;
#pragma unroll
                    for (int n = 0; n < 2; ++n) { const f32x4 cs = *(const f32x4*)(rcos + (size_t)row * 32 + 16 * n + 4 * fq), sn = *(const f32x4*)(rsin + (size_t)row * 32 + 16 * n + 4 * fq);
                        const f32x4 lo = acc[ai][0][m][n] * rstd * gv[0][n], hi = acc[ai][1][m][n] * rstd * gv[1][n];
                        const f32x4 olo = (lo * cs - hi * sn) * osc, ohi = (hi * cs + lo * sn) * osc;
                        u32x2 w0, w1; w0.x = cvt_pk_bf16(olo[0], olo[1]); w0.y = cvt_pk_bf16(olo[2], olo[3]); w1.x = cvt_pk_bf16(ohi[0], ohi[1]); w1.y = cvt_pk_bf16(ohi[2], ohi[3]);
                        *(u32x2*)(prow + 16 * n) = w0; *(u32x2*)(prow + 32 + 16 * n) = w1; } }
        } else if (pn < 10) {
            const float osc = (pn == 6 || pn == 7) ? QK_C2 : 1.0f;
#pragma unroll
            for (int ai = 0; ai < 2; ++ai)
#pragma unroll
                for (int m = 0; m < 4; ++m) { bf16_t* prow = P + (size_t)(row0 + ai * HALF + m * 16) * 3072 + cbase;
#pragma unroll
                    for (int bj = 0; bj < 2; ++bj)
#pragma unroll
                        for (int n = 0; n < 2; ++n) { const f32x4 v = acc[ai][bj][m][n] * osc; u32x2 w; w.x = cvt_pk_bf16(v[0], v[1]); w.y = cvt_pk_bf16(v[2], v[3]); *(u32x2*)(prow + 32 * bj + 16 * n) = w; } }
        } else {
            const int hd = 4 * (pn - 10) + wc;
#pragma unroll
            for (int ai = 0; ai < 2; ++ai)
#pragma unroll
                for (int m = 0; m < 4; ++m) { const int row = row0 + ai * HALF + m * 16, b = row >> 12, t = row & 4095;
                    bf16_t* vb = SVT + ((size_t)(b * 8 + hd) * 64 + 4 * fq) * 4096 + t;
#pragma unroll
                    for (int bj = 0; bj < 2; ++bj)
#pragma unroll
                        for (int n = 0; n < 2; ++n) { const f32x4 v = acc[ai][bj][m][n]; const unsigned p0 = cvt_pk_bf16(v[0], v[1]), p1 = cvt_pk_bf16(v[2], v[3]);
                            bf16_t* d = vb + (size_t)(32 * bj + 16 * n) * 4096;
                            d[0] = (bf16_t)(p0 & 0xffffu); d[4096] = (bf16_t)(p0 >> 16); d[2 * 4096] = (bf16_t)(p1 & 0xffffu); d[3 * 4096] = (bf16_t)(p1 >> 16); } }
        }
    }
};

template <class Epi, class Sched, bool ALIGN_EPI = false, bool SP2 = false>
__device__ __forceinline__ void gemm_phase(PG8_LAS unsigned char* lds, const Gemm g, const Sched& S, const Epi& E) {
    int tid_ = threadIdx.x; asm volatile("" : "+v"(tid_));
    const int tid = tid_, wid = __builtin_amdgcn_readfirstlane(tid >> 6), lane = tid & 63, wr = wid >> 2, wc = wid & 3, fr = lane & 15, fq = lane >> 4;
    const int K = g.K, nt = K / BK;
    unsigned voffA[2], voffB[2];
#pragma unroll
    for (int i = 0; i < 2; ++i) { int R, C; stage_rc(tid * 16 + i * 8192, R, C); const int Rb = Epi::PERM ? ((R & ~31) + perm32(R & 31)) : R;
        voffA[i] = (unsigned)(R * K + C) * 2u; voffB[i] = (unsigned)(Rb * K + C) * 2u; }
    const size_t kstep = (size_t)(BK * 2);
    const size_t hstep = (size_t)HALF * K * 2;
    const size_t tstep = 2 * hstep;
    const unsigned ldsw = (unsigned)wid * 1024u;
    const int aoff = lds_byte(wr * 64 + fr, fq * 8), boff = lds_byte(wc * 32 + fr, fq * 8);
#define PG8_SA(b, h) (((b) * 2 + (h)) * HTB)
#define PG8_SB(b, h) ((4 + (b) * 2 + (h)) * HTB)
#define PG8_STAGE(bufoff, gbase, voff) do { _Pragma("unroll") for (int _i = 0; _i < 2; ++_i) \
        __builtin_amdgcn_global_load_lds((const unsigned*)((const char*)(gbase) + (voff)[_i]), (PG8_LAS unsigned*)(lds + (bufoff) + ldsw + _i * 8192), 16, 0, 0); } while (0)
#define PG8_LDA(dst, b, h) do { _Pragma("unroll") for (int m = 0; m < 4; ++m) _Pragma("unroll") for (int k = 0; k < 2; ++k) dst[m][k] = *(const PG8_LAS bf16x8*)(lds + PG8_SA(b, h) + aoff + m * 2048 + k * 1024); } while (0)
#define PG8_LDB(dst, b, h) do { _Pragma("unroll") for (int n = 0; n < 2; ++n) _Pragma("unroll") for (int k = 0; k < 2; ++k) dst[n][k] = *(const PG8_LAS bf16x8*)(lds + PG8_SB(b, h) + boff + n * 2048 + k * 1024); } while (0)
#define PG8_MMA(ai, bj, At, Bt) do { __builtin_amdgcn_s_setprio(1); _Pragma("unroll") for (int m = 0; m < 4; ++m) _Pragma("unroll") for (int n = 0; n < 2; ++n) _Pragma("unroll") for (int k = 0; k < 2; ++k) \
        acc[ai][bj][m][n] = __builtin_amdgcn_mfma_f32_16x16x32_bf16(Bt[n][k], At[m][k], acc[ai][bj][m][n], 0, 0, 0); __builtin_amdgcn_s_setprio(0); } while (0)
#define PG8_WAIT_V(n) asm volatile("s_waitcnt vmcnt(" #n ")" ::: "memory")
#define PG8_WAIT_L(n) asm volatile("s_waitcnt lgkmcnt(" #n ")" ::: "memory")
#define PG8_BAR __builtin_amdgcn_s_barrier()
#define PG8_SCHED __builtin_amdgcn_sched_barrier(0)
    Unit cur, nxt; int ui = 0;
    if (!S.next(0, cur)) return;
    f32x4 acc[2][2][4][2];
#pragma unroll
    for (int a = 0; a < 2; ++a)
#pragma unroll
        for (int b = 0; b < 2; ++b)
#pragma unroll
            for (int m = 0; m < 4; ++m)
#pragma unroll
                for (int n = 0; n < 2; ++n) acc[a][b][m][n] = (f32x4){0.f, 0.f, 0.f, 0.f};
    bf16x8 At[4][2], B0[2][2], B1[2][2];
    const char* cA = (const char*)g.A + (size_t)cur.pm * tstep; const char* cB = (const char*)g.Bt + (size_t)cur.pn * tstep;
    S.a_ready(cur);
    if constexpr (SP2) {
        PG8_STAGE(PG8_SB(0, 0), cB, voffB); PG8_STAGE(PG8_SB(0, 1), cB + hstep, voffB); PG8_STAGE(PG8_SA(0, 0), cA, voffA); PG8_STAGE(PG8_SA(0, 1), cA + hstep, voffA);
        if (wr == 1) PG8_BAR;
        PG8_WAIT_V(2); PG8_BAR;
        PG8_STAGE(PG8_SB(1, 0), cB + kstep, voffB); PG8_STAGE(PG8_SA(1, 0), cA + kstep, voffA); PG8_STAGE(PG8_SB(1, 1), cB + hstep + kstep, voffB);
        PG8_WAIT_V(6); PG8_BAR;
    } else {
        PG8_STAGE(PG8_SB(0, 0), cB, voffB); PG8_STAGE(PG8_SA(0, 0), cA, voffA); PG8_STAGE(PG8_SB(0, 1), cB + hstep, voffB); PG8_STAGE(PG8_SA(0, 1), cA + hstep, voffA);
        if (wr == 1) PG8_BAR;
        PG8_WAIT_V(4); PG8_BAR;
        PG8_STAGE(PG8_SB(1, 0), cB + kstep, voffB); PG8_STAGE(PG8_SA(1, 0), cA + kstep, voffA); PG8_STAGE(PG8_SB(1, 1), cB + hstep + kstep, voffB);
        PG8_WAIT_V(6); PG8_BAR;
    }
    for (;;) {
        const bool has_next = S.next(ui + 1, nxt);
        const char* nA = has_next ? (const char*)g.A + (size_t)nxt.pm * tstep : cA; const char* nB = has_next ? (const char*)g.Bt + (size_t)nxt.pn * tstep : cB;
        for (int t = 0; t < nt; t += 2) {
            const bool last = (t == nt - 2);
            const char* a1 = cA + (size_t)(t + 1) * kstep;
            const char* a2 = last ? nA : cA + (size_t)(t + 2) * kstep; const char* b2 = last ? nB : cB + (size_t)(t + 2) * kstep;
            const char* a3 = a2 + kstep; const char* b3 = b2 + kstep;
            if (last && has_next) S.a_ready(nxt);
            if constexpr (SP2) {
            PG8_LDB(B0, 0, 0); PG8_LDB(B1, 0, 1); PG8_SCHED; PG8_LDA(At, 0, 0); PG8_STAGE(PG8_SA(1, 1), a1 + hstep, voffA);
            PG8_WAIT_V(8); PG8_WAIT_L(0); PG8_BAR; PG8_MMA(0, 0, At, B0); PG8_MMA(0, 1, At, B1); PG8_BAR; PG8_SCHED;
            PG8_LDA(At, 0, 1); PG8_STAGE(PG8_SB(0, 0), b2, voffB); PG8_STAGE(PG8_SB(0, 1), b2 + hstep, voffB); PG8_STAGE(PG8_SA(0, 0), a2, voffA);
            PG8_WAIT_V(8); PG8_WAIT_L(0); PG8_BAR; PG8_MMA(1, 0, At, B0); PG8_MMA(1, 1, At, B1); PG8_BAR; PG8_SCHED;
            PG8_LDB(B0, 1, 0); PG8_LDB(B1, 1, 1); PG8_SCHED; PG8_LDA(At, 1, 0); PG8_STAGE(PG8_SA(0, 1), a2 + hstep, voffA);
            PG8_WAIT_V(8); PG8_WAIT_L(0); PG8_BAR; PG8_MMA(0, 0, At, B0); PG8_MMA(0, 1, At, B1); PG8_BAR; PG8_SCHED;
            PG8_LDA(At, 1, 1); PG8_STAGE(PG8_SB(1, 0), b3, voffB); PG8_STAGE(PG8_SB(1, 1), b3 + hstep, voffB); PG8_STAGE(PG8_SA(1, 0), a3, voffA);
            PG8_WAIT_V(8); PG8_WAIT_L(0); PG8_BAR; PG8_MMA(1, 0, At, B0); PG8_MMA(1, 1, At, B1); PG8_BAR; PG8_SCHED;
            } else {
            PG8_LDB(B0, 0, 0); PG8_SCHED; PG8_LDA(At, 0, 0); PG8_STAGE(PG8_SA(1, 1), a1 + hstep, voffA);
            PG8_WAIT_L(8); PG8_BAR; PG8_WAIT_L(0); PG8_MMA(0, 0, At, B0); PG8_BAR; PG8_SCHED;
            PG8_LDB(B1, 0, 1); PG8_STAGE(PG8_SB(0, 0), b2, voffB);
            PG8_BAR; PG8_WAIT_L(0); PG8_MMA(0, 1, At, B1); PG8_BAR;
            PG8_LDA(At, 0, 1); PG8_STAGE(PG8_SA(0, 0), a2, voffA);
            PG8_BAR; PG8_WAIT_L(0); PG8_MMA(1, 0, At, B0); PG8_BAR; PG8_SCHED;
            PG8_STAGE(PG8_SB(0, 1), b2 + hstep, voffB);
            PG8_WAIT_V(6); PG8_BAR; PG8_MMA(1, 1, At, B1); PG8_BAR;
            PG8_LDB(B0, 1, 0); PG8_SCHED; PG8_LDA(At, 1, 0); PG8_STAGE(PG8_SA(0, 1), a2 + hstep, voffA);
            PG8_WAIT_L(8); PG8_BAR; PG8_WAIT_L(0); PG8_MMA(0, 0, At, B0); PG8_BAR; PG8_SCHED;
            PG8_LDB(B1, 1, 1); PG8_STAGE(PG8_SB(1, 0), b3, voffB);
            PG8_BAR; PG8_WAIT_L(0); PG8_MMA(0, 1, At, B1); PG8_BAR;
            PG8_LDA(At, 1, 1); PG8_STAGE(PG8_SA(1, 0), a3, voffA);
            PG8_BAR; PG8_WAIT_L(0); PG8_MMA(1, 0, At, B0); PG8_BAR; PG8_SCHED;
            PG8_STAGE(PG8_SB(1, 1), b3 + hstep, voffB);
            PG8_WAIT_V(6); PG8_BAR; PG8_MMA(1, 1, At, B1); PG8_BAR;
            }
        }
        if constexpr (ALIGN_EPI) { if (wr == 0) PG8_BAR; }
        if constexpr (!Epi::AFTER_DRAIN) { E(acc, cur, wr, wc, fr, fq); S.done(cur); }
        if (!has_next) break;
#pragma unroll
        for (int a = 0; a < 2; ++a)
#pragma unroll
            for (int b = 0; b < 2; ++b)
#pragma unroll
                for (int m = 0; m < 4; ++m)
#pragma unroll
                    for (int n = 0; n < 2; ++n) acc[a][b][m][n] = (f32x4){0.f, 0.f, 0.f, 0.f};
        cur = nxt; cA = nA; cB = nB; ++ui;
        if constexpr (ALIGN_EPI) { if (wr == 1) PG8_BAR; }
    }
    PG8_WAIT_V(0);
    if constexpr (!ALIGN_EPI) { if (wr == 0) PG8_BAR; }
    PG8_BAR;
    if constexpr (Epi::AFTER_DRAIN) { E.fused(acc, cur, wr, wc, fr, fq, lds, wid, lane); S.done(cur); }
#undef PG8_SA
#undef PG8_SB
#undef PG8_STAGE
#undef PG8_LDA
#undef PG8_LDB
#undef PG8_MMA
#undef PG8_WAIT_V
#undef PG8_WAIT_L
#undef PG8_BAR
#undef PG8_SCHED
}
}

#ifndef PG8_SP2
#define PG8_SP2 true
#endif
#ifndef PG8_ALIGN
#define PG8_ALIGN true
#endif
namespace attn_body {
using bf16=__hip_bfloat16;
using bf16x8=__attribute__((ext_vector_type(8)))short;
using s16x4=__attribute__((ext_vector_type(4)))short;
using f32x16=__attribute__((ext_vector_type(16)))float;
using u32x4=__attribute__((ext_vector_type(4)))unsigned;
constexpr int BATCH=4,NHEAD=8,SEQ=4096,D=64,DV=128,PIN=3072,POUT=1024;
constexpr int NW=8,QBLK=32,QB=QBLK*NW,KVBLK=64,NQB=SEQ/QB;
constexpr int ATTN_UNIT_ROWS=QB;
__device__ __forceinline__ int crow(int r,int hi){return (r&3)+8*(r>>2)+4*hi;}
#define SBAR() __builtin_amdgcn_sched_barrier(0)
__device__ __forceinline__ void cmask(f32x16&p0,f32x16&p1,int jb,int qrel,int hi){
  const float NEG=-INFINITY; int kb=64*jb+4*hi;
  #pragma unroll
  for(int r=0;r<16;++r){int kv=kb+(r&3)+8*(r>>2); if(kv>qrel)p0[r]=NEG; if(kv+32>qrel)p1[r]=NEG;}
}

constexpr int NSLOT=3, SLOTB=8192;
constexpr int LDS_K=0, LDS_V=NSLOT*SLOTB, LDS_WS=3*NSLOT*SLOTB, LDS_OST=LDS_WS+NW*64*4, LDS_BYTES=LDS_OST+NW*8192;
constexpr float C2=0.125f*1.4426950408889634f;
__device__ __forceinline__ void glds16(const void*gsrc,unsigned lds_dst){unsigned keep;
  asm volatile("s_mov_b32 %0, m0\n\ts_mov_b32 m0, %2\n\ts_nop 0\n\tglobal_load_lds_dwordx4 %1, off\n\ts_mov_b32 m0, %0":"=&s"(keep):"v"(gsrc),"s"(lds_dst):"memory");}
__device__ __forceinline__ float max3f(float a,float b,float c){float r;asm("v_max3_f32 %0, %1, %2, %3":"=v"(r):"v"(a),"v"(b),"v"(c));return r;}
__device__ __forceinline__ float max2f(float a,float b){float r;asm("v_max_f32_e32 %0, %1, %2":"=v"(r):"v"(a),"v"(b));return r;}
__device__ __forceinline__ float fadd_s(float a,float b){float r;asm("v_add_f32_e32 %0, %1, %2":"=v"(r):"v"(a),"v"(b));return r;}
__device__ __forceinline__ float fsub_s(float a,float b){float r;asm("v_sub_f32_e32 %0, %1, %2":"=v"(r):"v"(a),"v"(b));return r;}
typedef float f32x2_t __attribute__((ext_vector_type(2))); typedef __bf16 bf16x2_t __attribute__((ext_vector_type(2)));
__device__ __forceinline__ unsigned cvtpk_s(float lo,float hi){f32x2_t v={lo,hi};bf16x2_t b=__builtin_convertvector(v,bf16x2_t);return __builtin_bit_cast(unsigned,b);}
#define WAIT_BAR(N) asm volatile("s_waitcnt vmcnt(" #N ") lgkmcnt(0)\n\ts_barrier":::"memory")

__device__ __forceinline__ void qkt(f32x16&p0,f32x16&p1,const char*Kslot,const bf16x8*qr,const f32x16&negm,int r32,int hi){
  const char*kb=Kslot+hi*1024+r32*16;
  #pragma unroll
  for(int d0=0;d0<4;++d0){
    const bf16x8 b0=*reinterpret_cast<const bf16x8*>(kb+d0*2048);
    const bf16x8 b1=*reinterpret_cast<const bf16x8*>(kb+d0*2048+512);
    if(d0==0){p0=__builtin_amdgcn_mfma_f32_32x32x16_bf16(b0,qr[0],negm,0,0,0);p1=__builtin_amdgcn_mfma_f32_32x32x16_bf16(b1,qr[0],negm,0,0,0);}
    else{p0=__builtin_amdgcn_mfma_f32_32x32x16_bf16(b0,qr[d0],p0,0,0,0);p1=__builtin_amdgcn_mfma_f32_32x32x16_bf16(b1,qr[d0],p1,0,0,0);}}
}
typedef __attribute__((address_space(3))) const char* lds_cptr;
typedef short v4i16_t __attribute__((ext_vector_type(4)));
__device__ __forceinline__ void kload8(bf16x8*kf,lds_cptr kp){
  kf[0]=*(const __attribute__((address_space(3))) bf16x8*)(kp);      kf[1]=*(const __attribute__((address_space(3))) bf16x8*)(kp+512);
  kf[2]=*(const __attribute__((address_space(3))) bf16x8*)(kp+2048); kf[3]=*(const __attribute__((address_space(3))) bf16x8*)(kp+2560);
  kf[4]=*(const __attribute__((address_space(3))) bf16x8*)(kp+4096); kf[5]=*(const __attribute__((address_space(3))) bf16x8*)(kp+4608);
  kf[6]=*(const __attribute__((address_space(3))) bf16x8*)(kp+6144); kf[7]=*(const __attribute__((address_space(3))) bf16x8*)(kp+6656);
}
__device__ __forceinline__ void kload2(bf16x8*kf,lds_cptr kp,int j){ kf[2*j]=*(const __attribute__((address_space(3))) bf16x8*)(kp+j*2048); kf[2*j+1]=*(const __attribute__((address_space(3))) bf16x8*)(kp+j*2048+512); }
__device__ __forceinline__ s16x4 vtr(lds_cptr p){ return __builtin_bit_cast(s16x4,__builtin_amdgcn_ds_read_tr16_b64_v4i16((__attribute__((address_space(3))) v4i16_t*)p)); }
__device__ __forceinline__ float rowmax(const f32x16&p0,const f32x16&p1){
  float a=max3f(p0[0],p0[1],p1[0]),b=max3f(p0[2],p0[3],p1[1]);a=max3f(a,p1[2],p1[3]);
  #pragma unroll
  for(int r=4;r<16;r+=4){a=max3f(a,p0[r],p0[r+1]);b=max3f(b,p0[r+2],p0[r+3]);a=max3f(a,p1[r],p1[r+1]);b=max3f(b,p1[r+2],p1[r+3]);}
  const float m=max2f(a,b);
  auto rr=__builtin_amdgcn_permlane32_swap(__float_as_uint(m),__float_as_uint(m),false,false);
  return max2f(__uint_as_float(rr[0]),__uint_as_float(rr[1]));
}
__device__ __forceinline__ void pv(f32x16*o,int vb,bf16x8 pa0,bf16x8 pa1,bf16x8 pa2,bf16x8 pa3){
  #pragma unroll
  for(int d0=0;d0<4;++d0){s16x4 lo[4],hi[4];
    #pragma unroll
    for(int ks=0;ks<4;++ks){
      asm volatile("ds_read_b64_tr_b16 %0,%1 offset:%c2":"=&v"(lo[ks]):"v"(vb),"i"(d0*4096+ks*1024):"memory");
      asm volatile("ds_read_b64_tr_b16 %0,%1 offset:%c2":"=&v"(hi[ks]):"v"(vb),"i"(d0*4096+ks*1024+512):"memory");}
    asm volatile("s_waitcnt lgkmcnt(0)":::"memory");SBAR();
    #define PK(k) (bf16x8){lo[k][0],lo[k][1],lo[k][2],lo[k][3],hi[k][0],hi[k][1],hi[k][2],hi[k][3]}
    o[d0]=__builtin_amdgcn_mfma_f32_32x32x16_bf16(pa0,PK(0),o[d0],0,0,0);
    o[d0]=__builtin_amdgcn_mfma_f32_32x32x16_bf16(pa1,PK(1),o[d0],0,0,0);
    o[d0]=__builtin_amdgcn_mfma_f32_32x32x16_bf16(pa2,PK(2),o[d0],0,0,0);
    o[d0]=__builtin_amdgcn_mfma_f32_32x32x16_bf16(pa3,PK(3),o[d0],0,0,0);
    #undef PK
  }
}

#ifndef ATTN_STORE16
#define ATTN_STORE16(p,v) (*(u32x4*)(p)=(v))
#endif
template<int THRL> __device__ __forceinline__ void attn_unit(int b,int vh,int qb,const bf16*P,bf16*O,char*shm){
  int tid_=threadIdx.x; asm volatile("":"+v"(tid_)); const int tid=tid_,lane=tid&63,r32=lane&31,hi=lane>>5; const int wid=__builtin_amdgcn_readfirstlane(tid>>6);
  const long rowbase=(long)b*SEQ; const int q0=qb*QB;
  const bf16*Qw=P+(rowbase+q0+wid*QBLK)*PIN+vh*D;
  const bf16*Kh=P+rowbase*PIN+512+vh*D,*Vh=P+rowbase*PIN+1024+(vh>>1)*DV;
  const unsigned lds0=(unsigned)(uintptr_t)shm;
  float*wsf=(float*)(shm+LDS_WS)+wid*64;
  const bf16*ksrc=Kh+(long)lane*PIN+wid*8;
  const bf16*vsrc=Vh+(long)(16*(wid&3)+(lane>>2))*PIN+(wid>>2)*32+(lane&3)*8;
  const unsigned kdst=lds0+LDS_K+wid*1024, vdst=lds0+LDS_V+wid*1024;
  #define DMA_K(t,slot) glds16(ksrc+(long)(t)*KVBLK*PIN,(unsigned)__builtin_amdgcn_readfirstlane(kdst+(slot)))
  #define DMA_V(t,slot) do{ glds16(vsrc+(long)(t)*KVBLK*PIN,(unsigned)__builtin_amdgcn_readfirstlane(vdst+2*(slot))); glds16(vsrc+(long)(t)*KVBLK*PIN+64,(unsigned)__builtin_amdgcn_readfirstlane(vdst+2*(slot)+8192)); }while(0)
  const int vb0=(int)(lds0+LDS_V)+((lane>>4)&1)*32+(lane&3)*8+(4*hi+((lane&15)>>2))*64;
  const char*Kbase=shm+LDS_K; bf16x8 kf[8];
  const lds_cptr shm3=(lds_cptr)shm; const lds_cptr kp0=shm3+LDS_K+hi*1024+r32*16; const lds_cptr vp0=shm3+LDS_V+((lane>>4)&1)*32+(lane&3)*8+(4*hi+((lane&15)>>2))*64;
  const int NT=(q0+QB)/KVBLK;
  DMA_K(0,0);DMA_V(0,0);DMA_K(1,SLOTB);
  bf16x8 qr[4];
  #pragma unroll
  for(int d0=0;d0<4;++d0)qr[d0]=*reinterpret_cast<const bf16x8*>(&Qw[(long)r32*PIN+d0*16+hi*8]);
  float mhat=0.f,l_reg=0.f;f32x16 o[4];o[0]=f32x16{};o[1]=f32x16{};o[2]=f32x16{};o[3]=f32x16{};f32x16 negm;{float nz_=0.f;asm volatile("":"+v"(nz_));_Pragma("unroll") for(int r=0;r<16;++r)negm[r]=nz_;}asm volatile("":"+v"(negm));
  const int qrel=wid*QBLK+r32;
  #define CMASK(P0,P1,t) do{int jb_=(t)-(NT-4); if(jb_>=0)cmask(P0,P1,jb_,qrel,hi);}while(0)
  bool resc=false;
  #define START(P0,P1) do{ const float rm=rowmax(P0,P1); resc=false; \
    { const float dl=rm; mhat=fadd_s(mhat,dl); \
      _Pragma("unroll") for(int r=0;r<16;++r){P0[r]=fsub_s(P0[r],dl);P1[r]=fsub_s(P1[r],dl);} \
      _Pragma("unroll") for(int r=0;r<16;++r)negm[r]=-mhat; asm volatile("":"+v"(negm)); } \
    _Pragma("unroll") for(int r=0;r<16;++r)P0[r]=__builtin_amdgcn_exp2f(P0[r]); }while(0)
  #define RESC() do{ if(resc){ asm volatile("s_waitcnt lgkmcnt(0)":::"memory"); \
      _Pragma("unroll") for(int d_=0;d_<4;++d_) _Pragma("unroll") for(int r=0;r<16;++r)o[d_][r]*=wsf[crow(r,hi)]; } }while(0)
  f32x16 pA0,pA1,pB0,pB1;
  int sl_prev=0,sl_cur=0,sl_next=SLOTB;
  #define ROT() do{sl_prev=sl_cur;sl_cur=sl_next;sl_next=(sl_next==(NSLOT-1)*SLOTB)?0:sl_next+SLOTB;}while(0)
  DMA_K(2,2*SLOTB);
  WAIT_BAR(3);
  qkt(pA0,pA1,Kbase,qr,negm,r32,hi);asm volatile("s_nop 15\n\ts_nop 7":"+v"(pA0),"+v"(pA1));CMASK(pA0,pA1,0);
  START(pA0,pA1);
  _Pragma("unroll") for(int r=0;r<16;++r)pA1[r]=__builtin_amdgcn_exp2f(pA1[r]);
  WAIT_BAR(0);
  DMA_K(3,0);DMA_V(1,SLOTB);
  ROT();
  kload8(kf,kp0+sl_cur);
  WAIT_BAR(3);
  s16x4 vlo[4],vhi[4]; u32x4 pw0,pw1,pw2,pw3;
  #define PKW(P,B) cvtpk_s(P[B],P[B+1])
  #define PAF(k) __builtin_bit_cast(bf16x8,pw##k)
  #define VFR(i) (bf16x8){vlo[i][0],vlo[i][1],vlo[i][2],vlo[i][3],vhi[i][0],vhi[i][1],vhi[i][2],vhi[i][3]}
  #define PIN(x) asm volatile("":"+v"(x))
  #define MX3(a,b,c) __builtin_fmaxf(__builtin_fmaxf((a),(b)),(c))
  #define GAPA(MF,A0,A1,A2,A3,W0,W1,PW) do{ MF; sacc+=A0; sacc+=A1; sacc+=A2; sacc+=A3; PIN(sacc); W0; W1; PIN(PW); SBAR(); }while(0)
  #define EX(v) __builtin_amdgcn_exp2f(v)
  #define VRD(dq,ks) do{ vlo[dq]=vtr(vp_+((dq)*4096+(ks)*1024)); vhi[dq]=vtr(vp_+((dq)*4096+(ks)*1024+512)); }while(0)
  #define GAPB(DQ,KS,X,B) do{ o[DQ]=__builtin_amdgcn_mfma_f32_32x32x16_bf16(PAF(KS),VFR(DQ),o[DQ],0,0,0); if((KS)<3){ VRD(DQ,(KS)+1); } X[B]=EX(X[B]); X[B+1]=EX(X[B+1]); PIN(X); SBAR(); }while(0)
  #define KRD(G,j) do{ if(G){ kload2(kf,kp0+sl_next,j); SBAR(); } }while(0)
  #define STEP(C0,C1,P0,P1,t,GK,GV,GL) do{ SBAR(); \
    const lds_cptr vp_=vp0+2*sl_prev; \
    float sacc=(P0[0]+P0[1]); \
    GAPA(C0=__builtin_amdgcn_mfma_f32_32x32x16_bf16(kf[0],qr[0],negm,0,0,0), P0[2],P0[3],P0[4],P0[5],     pw0[0]=PKW(P0,0), pw0[1]=PKW(P0,2), pw0); \
    GAPA(C1=__builtin_amdgcn_mfma_f32_32x32x16_bf16(kf[1],qr[0],negm,0,0,0), P0[6],P0[7],P0[8],P0[9],     pw0[2]=PKW(P0,4), pw0[3]=PKW(P0,6), pw0); \
    GAPA(C0=__builtin_amdgcn_mfma_f32_32x32x16_bf16(kf[2],qr[1],C0,0,0,0),   P0[10],P0[11],P0[12],P0[13], pw1[0]=PKW(P0,8), pw1[1]=PKW(P0,10), pw1); \
    GAPA(C1=__builtin_amdgcn_mfma_f32_32x32x16_bf16(kf[3],qr[1],C1,0,0,0),   P0[14],P0[15],P1[0],P1[1],   pw1[2]=PKW(P0,12),pw1[3]=PKW(P0,14), pw1); \
    VRD(0,0); SBAR(); GAPA(C0=__builtin_amdgcn_mfma_f32_32x32x16_bf16(kf[4],qr[2],C0,0,0,0),   P1[2],P1[3],P1[4],P1[5],     pw2[0]=PKW(P1,0), pw2[1]=PKW(P1,2), pw2); \
    VRD(1,0); SBAR(); GAPA(C1=__builtin_amdgcn_mfma_f32_32x32x16_bf16(kf[5],qr[2],C1,0,0,0),   P1[6],P1[7],P1[8],P1[9],     pw2[2]=PKW(P1,4), pw2[3]=PKW(P1,6), pw2); \
    VRD(2,0); SBAR(); GAPA(C0=__builtin_amdgcn_mfma_f32_32x32x16_bf16(kf[6],qr[3],C0,0,0,0),   P1[10],P1[11],P1[12],P1[13], pw3[0]=PKW(P1,8), pw3[1]=PKW(P1,10), pw3); \
    VRD(3,0); SBAR(); GAPA(C1=__builtin_amdgcn_mfma_f32_32x32x16_bf16(kf[7],qr[3],C1,0,0,0),   P1[14],P1[15],0.f,0.f,       pw3[2]=PKW(P1,12),pw3[3]=PKW(P1,14), pw3); \
    l_reg+=sacc; \
    if(GK){DMA_K((t)+3,sl_cur);} if(GV){DMA_V((t)+1,sl_next);} \
    CMASK(C0,C1,t); \
    { float a=MX3(C0[0],C0[1],C1[0]),b=MX3(C0[2],C0[3],C1[1]); a=MX3(a,C1[2],C1[3]); \
      _Pragma("unroll") for(int r=4;r<16;r+=4){a=MX3(a,C0[r],C0[r+1]);b=MX3(b,C0[r+2],C0[r+3]);a=MX3(a,C1[r],C1[r+1]);b=MX3(b,C1[r+2],C1[r+3]);} \
      float rm=__builtin_fmaxf(a,b); { auto rr=__builtin_amdgcn_permlane32_swap(__float_as_uint(rm),__float_as_uint(rm),false,false); rm=__builtin_fmaxf(__uint_as_float(rr[0]),__uint_as_float(rr[1])); } \
      resc=false; \
      if(__builtin_expect(__any(rm>(float)THRL),0)){ const float dl=__builtin_fmaxf(rm,0.f); mhat+=dl; \
        _Pragma("unroll") for(int r=0;r<16;++r){C0[r]-=dl;C1[r]-=dl;} \
        _Pragma("unroll") for(int r=0;r<16;++r)negm[r]=-mhat; asm volatile("":"+v"(negm)); \
        const float f=__builtin_amdgcn_exp2f(-dl); l_reg*=f; if(hi==0)wsf[r32]=f; resc=true; } } \
    SBAR(); \
    GAPB(0,0,C0,0);  GAPB(1,0,C0,2);  GAPB(2,0,C0,4);  GAPB(3,0,C0,6); \
    KRD(GL,0); GAPB(0,1,C0,8);  GAPB(1,1,C0,10); KRD(GL,1); GAPB(2,1,C0,12); GAPB(3,1,C0,14); \
    KRD(GL,2); GAPB(0,2,C1,0);  GAPB(1,2,C1,2);  KRD(GL,3); GAPB(2,2,C1,4);  GAPB(3,2,C1,6); \
    GAPB(0,3,C1,8);  GAPB(1,3,C1,10); GAPB(2,3,C1,12); GAPB(3,3,C1,14); \
    }while(0)
  int t=1;
  #undef CMASK
  #define CMASK(P0,P1,t) do{}while(0)
  for(;t+5<NT;t+=2){
    STEP(pB0,pB1,pA0,pA1,t,true,true,true);     WAIT_BAR(3); RESC(); ROT();
    STEP(pA0,pA1,pB0,pB1,t+1,true,true,true);   WAIT_BAR(3); RESC(); ROT();
  }
  #undef CMASK
  #define CMASK(P0,P1,t) do{int jb_=(t)-(NT-4); if(jb_>=0)cmask(P0,P1,jb_,qrel,hi);}while(0)
  #define ENDW(tt) do{ if((tt)+3<NT){WAIT_BAR(3);} else if((tt)+2<NT){WAIT_BAR(2);} else {WAIT_BAR(0);} }while(0)
  for(;t+1<NT;t+=2){
    STEP(pB0,pB1,pA0,pA1,t,(t+3<NT),(t+1<NT),(t+1<NT));       ENDW(t);   RESC(); ROT();
    STEP(pA0,pA1,pB0,pB1,t+1,(t+4<NT),(t+2<NT),(t+2<NT));     ENDW(t+1); RESC(); ROT();
  }
  STEP(pB0,pB1,pA0,pA1,NT-1,false,false,false); RESC();
  { float sacc=pB0[0]+pB0[1]; _Pragma("unroll") for(int r=2;r<16;++r)sacc+=pB0[r]; _Pragma("unroll") for(int r=0;r<16;++r)sacc+=pB1[r]; l_reg+=sacc;
    pw0=(u32x4){PKW(pB0,0),PKW(pB0,2),PKW(pB0,4),PKW(pB0,6)};pw1=(u32x4){PKW(pB0,8),PKW(pB0,10),PKW(pB0,12),PKW(pB0,14)};pw2=(u32x4){PKW(pB1,0),PKW(pB1,2),PKW(pB1,4),PKW(pB1,6)};pw3=(u32x4){PKW(pB1,8),PKW(pB1,10),PKW(pB1,12),PKW(pB1,14)};
    SBAR(); pv(o,vb0+2*sl_cur,PAF(0),PAF(1),PAF(2),PAF(3)); }
  #undef PKW
  #undef PAF
  #undef VFR
  #undef PIN
  #undef MX3
  #undef GAPA
  #undef GAPB
  #undef EX
  #undef VRD
  #undef KRD
  #undef STEP
  #undef ENDW
  {auto rr=__builtin_amdgcn_permlane32_swap(__float_as_uint(l_reg),__float_as_uint(l_reg),false,false);l_reg=__uint_as_float(rr[0])+__uint_as_float(rr[1]);}
  if(hi==0)wsf[32+r32]=l_reg;asm volatile("s_waitcnt lgkmcnt(0)":::"memory");
  float rli[16];
  #pragma unroll
  for(int r=0;r<16;++r)rli[r]=__builtin_amdgcn_rcpf(wsf[32+crow(r,hi)]);
  bf16*Ow=O+(rowbase+q0+wid*QBLK)*POUT+vh*DV;
  { bf16*stg=(bf16*)(shm+LDS_OST)+wid*4096;
    #pragma unroll
    for(int r=0;r<16;++r){const int orow=crow(r,hi);
      #pragma unroll
      for(int d0=0;d0<4;++d0)stg[orow*128+d0*32+r32]=__float2bfloat16(o[d0][r]*rli[r]);}
    asm volatile("s_waitcnt lgkmcnt(0)":::"memory");
    #pragma unroll
    for(int i=0;i<8;++i){const int row=i*4+(lane>>4),ch=lane&15; const u32x4 v=*(const u32x4*)(stg+row*128+ch*8); ATTN_STORE16(Ow+(long)row*POUT+ch*8,v);} }
  asm volatile("s_waitcnt lgkmcnt(0)\n\ts_barrier":::"memory");
  #undef DMA_K
  #undef DMA_V
  #undef CMASK
  #undef START
  #undef RESC
  #undef ROT
}
constexpr int ATTN_LDS_BYTES=LDS_BYTES;
struct AttnUnit { int bh; int qb; };
struct StaticOrder {
  int vcu;
  __device__ __forceinline__ explicit StaticOrder(int grid,int block):vcu((block%8)*(grid/8)+block/8){}
  __device__ __forceinline__ bool next(int i,AttnUnit&u)const{ if(i>=2)return false; const int s=vcu&7; u.bh=vcu>>3; u.qb=(i==0)?15-s:s; return true; }
};
template<class Sched,int THRL=8> __device__ __forceinline__ void attn_phase(char*lds,const bf16*P,bf16*O,const Sched&S){
  AttnUnit u;
  for(int i=0;S.next(i,u);++i){ attn_unit<THRL>(u.bh/NHEAD,u.bh%NHEAD,u.qb,P,O,lds); }
}
#undef SBAR
#undef WAIT_BAR
}
constexpr int NWAVES = 8;
constexpr int NB = 4, SEQ = 4096, D = 1024, T = NB * SEQ, NPROJ = 3072, NE = 256, FF = 256, KSEL = 8, NSLOT9 = 9;
constexpr float NORM_EPS = 1e-6f;
constexpr size_t MiB = 1u << 20;
constexpr size_t WS_CTL = 0, CTL_ZERO_BYTES = 65536;
constexpr size_t WS_MOD = 1 * MiB;
constexpr size_t WS_COS = 2 * MiB, WS_SIN = 4 * MiB;
constexpr size_t WS_WIN = 6 * MiB, WS_WOUT = 12 * MiB, WS_WR = 14 * MiB;
constexpr size_t WS_XN = 16 * MiB;
constexpr size_t WS_PROJ = 48 * MiB;
constexpr size_t WS_SVT = 144 * MiB;
constexpr size_t WS_ORAW = 160 * MiB;
constexpr size_t WS_MIXED = 192 * MiB;
constexpr size_t WS_R = 224 * MiB;
constexpr size_t WS_LTOK = 304 * MiB, WS_LW = 321 * MiB;
constexpr size_t WS_H2 = 338 * MiB;
constexpr size_t WS_ACT = 372 * MiB;
constexpr size_t WS_Y = 416 * MiB;
constexpr size_t WS_END = WS_Y + (size_t)T * NSLOT9 * D * 2;
constexpr int CW_QUEUE = 8192;
constexpr int CW_COUNT = 1024;
constexpr int CW_BAR = 4096;
constexpr int RING_OFF = 0, RING_BYTES = 151552;
constexpr int LDSCTL_OFF = RING_BYTES, MISC_OFF = LDSCTL_OFF + 320;
constexpr int LDS_BYTES = 152576;
static_assert(MISC_OFF + 128 <= LDS_BYTES, "LDS map");

#define GAS __attribute__((address_space(1)))
#define LAS __attribute__((address_space(3)))
typedef unsigned short bf16;
typedef unsigned v4u __attribute__((ext_vector_type(4)));
typedef unsigned v2u __attribute__((ext_vector_type(2)));
typedef float f32x4 __attribute__((ext_vector_type(4)));
typedef float f32x16 __attribute__((ext_vector_type(16)));
typedef short bf16x8 __attribute__((ext_vector_type(8)));
typedef GAS unsigned gu32;
#define RLX_AGENT __ATOMIC_RELAXED, __HIP_MEMORY_SCOPE_AGENT
#define LDS_WAIT() asm volatile("s_waitcnt lgkmcnt(0)" ::: "memory")
#define VM_WAIT() asm volatile("s_waitcnt vmcnt(0)" ::: "memory")
__device__ __forceinline__ unsigned pk2(float lo, float hi) { return pg8::cvt_pk_bf16(lo, hi); }
__device__ __forceinline__ float bflo(unsigned w) { return __uint_as_float(w << 16); }
__device__ __forceinline__ float bfhi(unsigned w) { return __uint_as_float(w & 0xffff0000u); }

#define XB_TMO      128
#define XB_XCNT(j)  (256  + 64 * (j))
#define XB_XSUB(j)  (1280 + 64 * (j))
#define XB_XGEN(j)  (2304 + 64 * (j))
#define XB_TOP      3328
#define XB_TOPGEN   3392
#define XCD_BAR_WORDS 3456
#define XB_SPIN_CAP (1u << 18)

__device__ __forceinline__ unsigned xb_ld(unsigned* p)              { return __hip_atomic_load(p, __ATOMIC_RELAXED, __HIP_MEMORY_SCOPE_AGENT); }
__device__ __forceinline__ unsigned xb_add(unsigned* p, unsigned v) { return __hip_atomic_fetch_add(p, v, __ATOMIC_RELAXED, __HIP_MEMORY_SCOPE_AGENT); }
__device__ __forceinline__ unsigned xb_xcc_id() { return (unsigned)__builtin_amdgcn_s_getreg((3 << 11) | 20) & 0xFu; }
#define XB_SPIN(cond, bar) do { unsigned _sp = 0; while (cond) { __builtin_amdgcn_s_sleep(1); \
    if ((++_sp & 255u) == 0u) { if (xb_ld(&(bar)[XB_TMO])) break; if (_sp > XB_SPIN_CAP) { atomicAdd(&(bar)[XB_TMO], 1u); break; } } } } while (0)

struct XcdBarrier {
    unsigned* bar; unsigned x;
    volatile LAS unsigned* st;
};

__device__ __forceinline__ XcdBarrier xcd_barrier_post(unsigned* bar, volatile LAS unsigned* st) {
    XcdBarrier b; b.bar = bar; b.x = xb_xcc_id(); b.st = st;
    if (threadIdx.x == 0) (void)xb_add(&bar[XB_XCNT(b.x)], 1u);
    return b;
}
__device__ __forceinline__ void xcd_barrier_complete(unsigned* bar, unsigned x, unsigned& nloc, unsigned& nx) {
    const unsigned G = gridDim.x * gridDim.y * gridDim.z;
    unsigned sum, cnt, mine, sp = 0u;
    for (;;) {
        sum = 0u; cnt = 0u; mine = 0u;
#pragma unroll
        for (unsigned j = 0; j < 16; ++j) { const unsigned c = xb_ld(&bar[XB_XCNT(j)]); sum += c; cnt += (c > 0u) ? 1u : 0u; mine = (j == x) ? c : mine; }
        if (sum == G) break;
        __builtin_amdgcn_s_sleep(1);
        if ((++sp & 255u) == 0u) { if (xb_ld(&bar[XB_TMO])) break; if (sp > XB_SPIN_CAP) { atomicAdd(&bar[XB_TMO], 1u); break; } }
    }
    nloc = mine > 0u ? mine : 1u; nx = cnt > 0u ? cnt : 1u;
}

__device__ __forceinline__ void xcd_barrier(const XcdBarrier& b) {
    asm volatile("s_waitcnt vmcnt(0)" ::: "memory");
    __syncthreads();
    if (threadIdx.x == 0) {
        unsigned* bar = b.bar;
        __builtin_amdgcn_s_waitcnt(0);
        unsigned nloc = b.st[0], nx = b.st[1];
        if (nloc == 0u) { xcd_barrier_complete(bar, b.x, nloc, nx); b.st[0] = nloc; b.st[1] = nx; }
        const unsigned old = xb_add(&bar[XB_XSUB(b.x)], 1u);
        const unsigned gen = old / nloc;
        if (old + 1u == (gen + 1u) * nloc) {
            __builtin_amdgcn_fence(__ATOMIC_RELEASE, "agent");
            asm volatile("s_waitcnt vmcnt(0)" ::: "memory");
            const unsigned og = xb_add(&bar[XB_TOP], 1u);
            const unsigned tg = og / nx;
            if (og + 1u == (tg + 1u) * nx) xb_add(&bar[XB_TOPGEN], 1u);
            else XB_SPIN(xb_ld(&bar[XB_TOPGEN]) == tg, bar);
            __builtin_amdgcn_fence(__ATOMIC_ACQUIRE, "agent");
            xb_add(&bar[XB_XGEN(b.x)], 1u);
            asm volatile("s_waitcnt vmcnt(0)" ::: "memory");
        } else {
            XB_SPIN(xb_ld(&bar[XB_XGEN(b.x)]) == gen, bar);
            __builtin_amdgcn_fence(__ATOMIC_ACQUIRE, "agent");
            asm volatile("s_waitcnt vmcnt(0)" ::: "memory");
        }
    }
    __syncthreads();
}


struct Frame {
    LAS unsigned char* lds;
    volatile LAS unsigned* MISC;
    unsigned* ctl;
    int tid, lane, wave;
    int vcu, G;
    const float *x, *c, *w_ada, *b_ada, *g_mix, *w_in, *g_q, *g_k, *lam, *g_sub, *w_out, *g_ffn, *w_router, *e_bias, *w_sh_gu, *w_sh_down, *w_gu, *w_down;
    const int* positions;
    float* out;
    float *MOD, *RCOS, *RSIN, *LW;
    bf16 *WIN, *WOUT, *WR, *XN, *PROJ, *SVT, *ORAW, *MIXED, *H2, *Y, *ACT, *DLT;
    unsigned* LTOK;
};
__device__ __forceinline__ float wave_sum(float v) {
#pragma unroll
    for (int o = 1; o < 64; o <<= 1) v += __shfl_xor(v, o);
    return v;
}
__device__ __forceinline__ float wave_max(float v) {
#pragma unroll
    for (int o = 1; o < 64; o <<= 1) v = fmaxf(v, __shfl_xor(v, o));
    return v;
}
__device__ __forceinline__ void p0_transpose_item(const float* W, int K, int N, bf16* WT, int k0, int n0, int dst_row0, LAS float* scr, int lane) {
#pragma unroll 8
    for (int i = 0; i < 32; ++i) { const int kk = 2 * i + (lane >> 5); scr[kk * 33 + (lane & 31)] = W[(size_t)(k0 + kk) * N + n0 + (lane & 31)]; }
    LDS_WAIT(); asm volatile("" ::: "memory");
    const int c = lane & 7;
#pragma unroll
    for (int j = 0; j < 4; ++j) { const int n = (lane >> 3) + 8 * j; const LAS float* s = scr + (8 * c) * 33 + n;
        v4u o; o.x = pk2(s[0 * 33], s[1 * 33]); o.y = pk2(s[2 * 33], s[3 * 33]); o.z = pk2(s[4 * 33], s[5 * 33]); o.w = pk2(s[6 * 33], s[7 * 33]);
        *(GAS v4u*)(WT + (size_t)(dst_row0 + n) * K + k0 + 8 * c) = o; }
    LDS_WAIT(); asm volatile("" ::: "memory");
}
__device__ __forceinline__ void p0_prologue(Frame& F) {
    LAS float* sc = (LAS float*)(F.lds + RING_OFF);
    LAS float* red = (LAS float*)(F.lds + RING_OFF + 16384);
    if (F.vcu < 192) {
        for (int i = F.tid; i < NB * D; i += NWAVES * 64) { const float v = F.c[i]; sc[i] = v / (1.0f + __expf(-v)); }
        __syncthreads();
        const int kr = F.lane >> 3, ch = F.lane & 7, n0 = 32 * F.vcu + 4 * ch;
        float a[4][4];
#pragma unroll
        for (int b = 0; b < 4; ++b)
#pragma unroll
            for (int j = 0; j < 4; ++j) a[b][j] = 0.f;
#pragma unroll 4
        for (int it = 0; it < 16; ++it) { const int k = 128 * F.wave + 8 * it + kr; const f32x4 wv = *(const f32x4*)(F.w_ada + (size_t)k * 6144 + n0);
#pragma unroll
            for (int b = 0; b < 4; ++b) { const float s = sc[b * D + k];
#pragma unroll
                for (int j = 0; j < 4; ++j) a[b][j] += s * wv[j]; } }
#pragma unroll
        for (int b = 0; b < 4; ++b)
#pragma unroll
            for (int j = 0; j < 4; ++j) { float v = a[b][j]; v += __shfl_xor(v, 8); v += __shfl_xor(v, 16); v += __shfl_xor(v, 32); a[b][j] = v; }
        if (kr == 0) {
#pragma unroll
            for (int b = 0; b < 4; ++b)
#pragma unroll
                for (int j = 0; j < 4; ++j) red[(F.wave * 4 + b) * 32 + 4 * ch + j] = a[b][j]; }
        __syncthreads();
        if (F.tid < 128) { const int b = F.tid >> 5, col = F.tid & 31; float s = F.b_ada[32 * F.vcu + col];
#pragma unroll
            for (int w = 0; w < 8; ++w) s += red[(w * 4 + b) * 32 + col];
            F.MOD[b * 6144 + 32 * F.vcu + col] = s; }
        __syncthreads();
    }
    LAS float* scr = (LAS float*)(F.lds + RING_OFF + 32768 + F.wave * 9216);
    const int gw = F.vcu * NWAVES + F.wave, NGW = F.G * NWAVES;
    constexpr int I_IN = (D / 64) * (NPROJ / 32), I_OUT = (D / 64) * (D / 32), I_R = (D / 64) * (NE / 32);
    for (int it = gw; it < I_IN + I_OUT + I_R; it += NGW) {
        int r = it;
        if (r < I_IN) { const int nblk = NPROJ / 32, kb = r / nblk, nb = r % nblk, n0 = 32 * nb;
            const int cl = n0 & 255, dst = (n0 & ~255) + 128 * ((cl >> 5) & 1) + 32 * (cl >> 6);
            p0_transpose_item(F.w_in, D, NPROJ, F.WIN, 64 * kb, n0, dst, scr, F.lane); continue; }
        r -= I_IN;
        if (r < I_OUT) { const int nblk = D / 32, kb = r / nblk, nb = r % nblk; p0_transpose_item(F.w_out, D, D, F.WOUT, 64 * kb, 32 * nb, 32 * nb, scr, F.lane); continue; }
        r -= I_OUT;
        { const int nblk = NE / 32, kb = r / nblk, nb = r % nblk; p0_transpose_item(F.w_router, D, NE, F.WR, 64 * kb, 32 * nb, 32 * nb, scr, F.lane); }
    }
    for (int idx = (int)blockIdx.x * (NWAVES * 64) + F.tid; idx < T * 32; idx += F.G * NWAVES * 64) {
        const int t = idx >> 5, i = idx & 31;
        const float inv = exp2f(-(float)i * (13.287712379549449f / 32.0f));
        const float ang = (float)F.positions[t] * inv;
        F.RCOS[idx] = cosf(ang); F.RSIN[idx] = sinf(ang);
    }
}
__device__ __forceinline__ void rows_adaln(Frame& F, const float* src, const float* g, const float* shift, const float* scale, bf16* dst) {
    const int gw = F.vcu * NWAVES + F.wave, NGW = F.G * NWAVES;
    for (int m = gw; m < T; m += NGW) {
        const int b = m >> 12;
        const GAS f32x4* xr = (const GAS f32x4*)(src + (size_t)m * D) + F.lane;
        f32x4 v[4]; float s2 = 0.f;
#pragma unroll
        for (int j = 0; j < 4; ++j) { v[j] = xr[64 * j]; s2 += (v[j].x * v[j].x + v[j].y * v[j].y) + (v[j].z * v[j].z + v[j].w * v[j].w); }
        const float rstd = 1.f / sqrtf(wave_sum(s2) * (1.f / D) + NORM_EPS);
        GAS v2u* o8 = (GAS v2u*)(dst + (size_t)m * D) + F.lane;
#pragma unroll
        for (int j = 0; j < 4; ++j) { const int c = 4 * F.lane + 256 * j;
            const f32x4 gv = *(const f32x4*)(g + c), sh = *(const f32x4*)(shift + b * 6144 + c), sc = *(const f32x4*)(scale + b * 6144 + c);
            const f32x4 y = v[j] * rstd * gv * (sc + 1.0f) + sh;
            v2u w; w.x = pk2(y.x, y.y); w.y = pk2(y.z, y.w); o8[64 * j] = w; }
    }
}
constexpr float SB_EXIT_LOG2 = 48.0f;
__device__ __forceinline__ int crow16(int r, int h) { return (r & 3) + 8 * (r >> 2) + 4 * h; }
__device__ __forceinline__ void sb_wave_tile(const bf16* PROJ, const bf16* SVT, bf16* MIXED, int b, int hd, int qt, int lane) {
    const int r32 = lane & 31, hi = lane >> 5;
    const bf16* Qp = PROJ + (size_t)(b * SEQ + 32 * qt + r32) * NPROJ + 1536 + hd * 64 + 8 * hi;
    bf16x8 qf[4];
#pragma unroll
    for (int s = 0; s < 4; ++s) qf[s] = *(const bf16x8*)(Qp + 16 * s);
    bf16x8 tf[2];
#pragma unroll
    for (int s = 0; s < 2; ++s)
#pragma unroll
        for (int j = 0; j < 8; ++j) tf[s][j] = (16 * s + 8 * (j >> 2) + 4 * hi + (j & 3)) >= r32 ? (short)0x3F80 : (short)0;
    f32x16 oT[2];
#pragma unroll
    for (int i = 0; i < 16; ++i) { oT[0][i] = 0.f; oT[1][i] = 0.f; }
    float R = 0.f;
    const bf16* Kb = PROJ + (size_t)(b * SEQ + r32) * NPROJ + 2048 + hd * 64 + 8 * hi;
    const bf16* Vb = SVT + ((size_t)(b * 8 + hd) * 64 + r32) * SEQ + 4 * hi;
    for (int kt = qt; kt >= 0; --kt) {
        const bf16* Kp = Kb + (size_t)(32 * kt) * NPROJ;
        bf16x8 kf[4];
#pragma unroll
        for (int s = 0; s < 4; ++s) kf[s] = *(const bf16x8*)(Kp + 16 * s);
        v2u vlo[2][2], vhi[2][2];
#pragma unroll
        for (int dt = 0; dt < 2; ++dt)
#pragma unroll
            for (int s = 0; s < 2; ++s) { const bf16* vp = Vb + (size_t)(32 * dt) * SEQ + 32 * kt + 16 * s; vlo[dt][s] = *(const v2u*)vp; vhi[dt][s] = *(const v2u*)(vp + 8); }
        f32x16 z;
#pragma unroll
        for (int i = 0; i < 16; ++i) z[i] = 0.f;
#pragma unroll
        for (int s = 0; s < 4; ++s) z = __builtin_amdgcn_mfma_f32_32x32x16_bf16(kf[s], qf[s], z, 0, 0, 0);
        const bool diag = (kt == qt);
        float sp[16];
#pragma unroll
        for (int i = 0; i < 16; ++i) { const float zz = z[i]; float v = fmaxf(zz, 0.f) + __builtin_amdgcn_logf(1.0f + __builtin_amdgcn_exp2f(-fabsf(zz)));
            if (diag && crow16(i, hi) >= r32) v = 0.f; sp[i] = v; }
        v4u p0, p1; p0.x = pk2(sp[0], sp[1]); p0.y = pk2(sp[2], sp[3]); p0.z = pk2(sp[4], sp[5]); p0.w = pk2(sp[6], sp[7]);
        p1.x = pk2(sp[8], sp[9]); p1.y = pk2(sp[10], sp[11]); p1.z = pk2(sp[12], sp[13]); p1.w = pk2(sp[14], sp[15]);
        f32x16 cs;
#pragma unroll
        for (int i = 0; i < 16; ++i) cs[i] = R;
        cs = __builtin_amdgcn_mfma_f32_32x32x16_bf16(tf[0], __builtin_bit_cast(bf16x8, p0), cs, 0, 0, 0);
        cs = __builtin_amdgcn_mfma_f32_32x32x16_bf16(tf[1], __builtin_bit_cast(bf16x8, p1), cs, 0, 0, 0);
        float w[16];
#pragma unroll
        for (int i = 0; i < 16; ++i) { float v = __builtin_amdgcn_exp2f(z[i] - cs[i]); if (diag && crow16(i, hi) >= r32) v = 0.f; w[i] = v; }
        R = __shfl(cs[0], r32);
        const bool done_ = __all(R > SB_EXIT_LOG2) != 0;
        v4u w0, w1; w0.x = pk2(w[0], w[1]); w0.y = pk2(w[2], w[3]); w0.z = pk2(w[4], w[5]); w0.w = pk2(w[6], w[7]);
        w1.x = pk2(w[8], w[9]); w1.y = pk2(w[10], w[11]); w1.z = pk2(w[12], w[13]); w1.w = pk2(w[14], w[15]);
#pragma unroll
        for (int dt = 0; dt < 2; ++dt) {
            v4u a0; a0.x = vlo[dt][0].x; a0.y = vlo[dt][0].y; a0.z = vhi[dt][0].x; a0.w = vhi[dt][0].y;
            v4u a1; a1.x = vlo[dt][1].x; a1.y = vlo[dt][1].y; a1.z = vhi[dt][1].x; a1.w = vhi[dt][1].y;
            oT[dt] = __builtin_amdgcn_mfma_f32_32x32x16_bf16(__builtin_bit_cast(bf16x8, a0), __builtin_bit_cast(bf16x8, w0), oT[dt], 0, 0, 0);
            oT[dt] = __builtin_amdgcn_mfma_f32_32x32x16_bf16(__builtin_bit_cast(bf16x8, a1), __builtin_bit_cast(bf16x8, w1), oT[dt], 0, 0, 0);
        }
        if (done_) break;
    }
    bf16* Op = MIXED + (size_t)(b * SEQ + 32 * qt + r32) * D + 512 + hd * 64 + 4 * hi;
#pragma unroll
    for (int dt = 0; dt < 2; ++dt)
#pragma unroll
        for (int g = 0; g < 4; ++g) { v2u o; o.x = pk2(oT[dt][4 * g], oT[dt][4 * g + 1]); o.y = pk2(oT[dt][4 * g + 2], oT[dt][4 * g + 3]); *(v2u*)(Op + 32 * dt + 8 * g) = o; }
}
__device__ __forceinline__ void sb_phase(Frame& F) {
    const int bh = F.vcu >> 3, s = F.vcu & 7;
    if (bh >= NB * 8) return;
#pragma unroll 1
    for (int i = 0; i < 2; ++i) { const int qb = i == 0 ? 15 - s : s; sb_wave_tile(F.PROJ, F.SVT, F.MIXED, bh >> 3, bh & 7, 8 * qb + F.wave, F.lane); }
}
__device__ __forceinline__ void combine_phase(Frame& F) {
    const int gw = F.vcu * NWAVES + F.wave, NGW = F.G * NWAVES;
    const float l01 = wave_sum(F.lam[F.lane] * F.lam[64 + F.lane]), l23 = wave_sum(F.lam[128 + F.lane] * F.lam[192 + F.lane]);
    const float lmbda = expf(l01) - expf(l23) + 0.2f;
    const float g0 = F.g_sub[2 * F.lane] * 0.8f, g1 = F.g_sub[2 * F.lane + 1] * 0.8f;
    for (int m = gw; m < T; m += NGW) {
        const unsigned* orow = (const unsigned*)(F.ORAW + (size_t)m * D);
        unsigned* mrow = (unsigned*)(F.MIXED + (size_t)m * D);
#pragma unroll
        for (int h = 0; h < 4; ++h) {
            const unsigned a = orow[h * 128 + F.lane], c = orow[h * 128 + 64 + F.lane];
            const float o0 = bflo(a) - lmbda * bflo(c), o1 = bfhi(a) - lmbda * bfhi(c);
            const float rstd = 1.f / sqrtf(wave_sum(o0 * o0 + o1 * o1) * (1.f / 128.f) + NORM_EPS);
            mrow[h * 64 + F.lane] = pk2(o0 * rstd * g0, o1 * rstd * g1);
        }
    }
}
__device__ __forceinline__ unsigned ex_pk8(float a, float b, float c, float d) { return (unsigned)__builtin_amdgcn_cvt_pk_fp8_f32(c, d, __builtin_amdgcn_cvt_pk_fp8_f32(a, b, 0, false), true); }
constexpr int RT_ROWS = 64, RT_HP = 2064, RT_LP = 1040;
static_assert(RT_ROWS * RT_HP <= RING_BYTES && T / RT_ROWS == 256, "router phase LDS map / one tile per workgroup");
__device__ __forceinline__ void route_phase(Frame& F) {
    LAS unsigned char* lds = F.lds + RING_OFF;
    const int tid = F.tid, lane = F.lane, wid = F.wave;
    const float NEG = -INFINITY;
    for (int tile = F.vcu; tile < T / RT_ROWS; tile += F.G) {
        const int row0 = tile * RT_ROWS, b = row0 >> 12;
        __syncthreads();
        const float* shift = F.MOD + b * 6144 + 3 * 1024; const float* scale = F.MOD + b * 6144 + 4 * 1024;
#pragma unroll 1
        for (int r0 = 0; r0 < 8; r0 += 4) {
            f32x4 v[4][4]; v2u dd[4][4];
#pragma unroll
            for (int r = 0; r < 4; ++r) { const int m = row0 + 8 * wid + r0 + r;
                const GAS f32x4* xr = (const GAS f32x4*)(F.x + (size_t)m * D) + lane; const GAS v2u* dr = (const GAS v2u*)(F.DLT + (size_t)m * D) + lane;
#pragma unroll
                for (int j = 0; j < 4; ++j) { v[r][j] = xr[64 * j]; dd[r][j] = dr[64 * j]; } }
#pragma unroll
            for (int r = 0; r < 4; ++r) { const int lr = 8 * wid + r0 + r, m = row0 + lr; float s2 = 0.f;
#pragma unroll
                for (int j = 0; j < 4; ++j) { const v2u d = dd[r][j]; v[r][j].x += bflo(d.x); v[r][j].y += bfhi(d.x); v[r][j].z += bflo(d.y); v[r][j].w += bfhi(d.y);
                    s2 += (v[r][j].x * v[r][j].x + v[r][j].y * v[r][j].y) + (v[r][j].z * v[r][j].z + v[r][j].w * v[r][j].w); }
                const float rstd = 1.f / sqrtf(wave_sum(s2) * (1.f / D) + NORM_EPS);
                GAS unsigned* o8 = (GAS unsigned*)((GAS unsigned char*)F.H2 + (size_t)m * D) + lane;
#pragma unroll
                for (int j = 0; j < 4; ++j) { const int c = 4 * lane + 256 * j;
                    const f32x4 gv = *(const f32x4*)(F.g_ffn + c), sh = *(const f32x4*)(shift + c), sc = *(const f32x4*)(scale + c);
                    const f32x4 y = v[r][j] * rstd * gv * (sc + 1.0f) + sh;
                    v2u w; w.x = pk2(y.x, y.y); w.y = pk2(y.z, y.w); o8[64 * j] = ex_pk8(y.x, y.y, y.z, y.w); *(LAS v2u*)(lds + lr * RT_HP + c * 2) = w; } }
        }
        __syncthreads();
        const int fr = lane & 15, fq = lane >> 4;
        f32x4 acc[4][2];
#pragma unroll
        for (int mt = 0; mt < 4; ++mt)
#pragma unroll
            for (int nt = 0; nt < 2; ++nt) acc[mt][nt] = (f32x4){0.f, 0.f, 0.f, 0.f};
        const bf16* wr0 = F.WR + (size_t)(32 * wid + fr) * D + 8 * fq;
#pragma unroll 8
        for (int ks = 0; ks < D / 32; ++ks) {
            const bf16x8 b0 = *(const bf16x8*)(wr0 + 32 * ks), b1 = *(const bf16x8*)(wr0 + (size_t)16 * D + 32 * ks);
#pragma unroll
            for (int mt = 0; mt < 4; ++mt) { const bf16x8 a = *(const LAS bf16x8*)(lds + (16 * mt + fr) * RT_HP + (32 * ks + 8 * fq) * 2);
                acc[mt][0] = __builtin_amdgcn_mfma_f32_16x16x32_bf16(a, b0, acc[mt][0], 0, 0, 0); acc[mt][1] = __builtin_amdgcn_mfma_f32_16x16x32_bf16(a, b1, acc[mt][1], 0, 0, 0); }
        }
        __syncthreads();
#pragma unroll
        for (int mt = 0; mt < 4; ++mt)
#pragma unroll
            for (int nt = 0; nt < 2; ++nt)
#pragma unroll
                for (int j = 0; j < 4; ++j) *(LAS float*)(lds + (16 * mt + 4 * fq + j) * RT_LP + (32 * wid + 16 * nt + fr) * 4) = acc[mt][nt][j];
        __syncthreads();
        const int tl = lane >> 3, g = lane & 7, t = row0 + 8 * wid + tl;
        float s[32], bz[32];
#pragma unroll
        for (int i4 = 0; i4 < 8; ++i4) { const f32x4 lg = *(const LAS f32x4*)(lds + (8 * wid + tl) * RT_LP + (32 * g + 4 * i4) * 4); const f32x4 eb = *(const f32x4*)(F.e_bias + 32 * g + 4 * i4);
#pragma unroll
            for (int j = 0; j < 4; ++j) { const float sg = __builtin_amdgcn_rcpf(1.0f + __expf(-lg[j])); s[4 * i4 + j] = sg; bz[4 * i4 + j] = sg + eb[j]; } }
        float m1 = NEG, m2 = NEG;
#pragma unroll
        for (int i = 0; i < 32; ++i) { const float v = bz[i]; m2 = fmaxf(m2, fminf(m1, v)); m1 = fmaxf(m1, v); }
        const float gs = m1 + m2; int rank = 0;
#pragma unroll
        for (int gp = 0; gp < 8; ++gp) { const float og = __shfl(gs, (lane & ~7) + gp); rank += (og > gs || (og == gs && gp < g)) ? 1 : 0; }
        unsigned taken = rank < 4 ? 0u : 0xffffffffu;
        int my_e = 0; float my_s = 0.f, ssum = 0.f;
#pragma unroll 1
        for (int k = 0; k < KSEL; ++k) {
            float lm = NEG, ls = 0.f; int li = 0;
#pragma unroll
            for (int i = 0; i < 32; ++i) { const float v = ((taken >> i) & 1u) ? NEG : bz[i]; const bool up = v > lm; lm = up ? v : lm; li = up ? i : li; ls = up ? s[i] : ls; }
            float wm = lm, ws = ls; int we = 32 * g + li;
#pragma unroll
            for (int off = 1; off < 8; off <<= 1) { const float ov = __shfl_xor(wm, off), os = __shfl_xor(ws, off); const int oe = __shfl_xor(we, off);
                const bool take = ov > wm || (ov == wm && oe < we); wm = take ? ov : wm; ws = take ? os : ws; we = take ? oe : we; }
            if ((we >> 5) == g) taken |= 1u << (we & 31);
            if (g == k) { my_e = we; my_s = ws; }
            ssum += ws;
        }
        { const int grp = F.vcu >> 5; unsigned* cnt = F.ctl + CW_COUNT + grp * NE; const unsigned rk = atomicAdd(cnt + my_e, 1u); const size_t p = (size_t)my_e * T + (size_t)grp * (T / 8) + rk; F.LTOK[p] = (unsigned)t | ((unsigned)g << 16); F.LW[p] = my_s / ssum * 2.5f; }
        if (g == 0) { const size_t p = (size_t)NE * T + t; F.LTOK[p] = (unsigned)t | (8u << 16); F.LW[p] = 1.0f; }
    }
}
constexpr int EX_TOK = 0, EX_WGT = 1024, EX_PFX = 2048, EX_QW = 3584, EX_A0 = 4096, EX_ASL = 8192, EX_NAS = 6, EX_W0 = EX_A0 + EX_NAS * EX_ASL, EX_WST = 32768, EX_NST = 3;
static_assert(EX_W0 + EX_NST * EX_WST <= RING_BYTES, "expert LDS map");
constexpr int EX_ROWS = 256, EX_XQ = 34;
__device__ __forceinline__ v4u ex_gld16v(const char* sbase, unsigned voff) { v4u v; asm volatile("global_load_dwordx4 %0, %1, %2" : "=v"(v) : "v"(voff), "s"(sbase) : "memory"); return v; }
template <int AUX> __device__ __forceinline__ void ex_dma(const void* g, LAS unsigned char* l) { __builtin_amdgcn_global_load_lds((const unsigned*)g, (LAS unsigned*)l, 16, 0, AUX); }
template <int MODE>
__device__ __forceinline__ void ex_tile(Frame& F, LAS unsigned char* lds, int tid_, const float* W, int j, int nrows, unsigned char* ACT) {
    int tid = tid_; asm volatile("" : "+v"(tid));
    LAS unsigned* tokL = (LAS unsigned*)(lds + EX_TOK); LAS float* wgtL = (LAS float*)(lds + EX_WGT);
    const int lane = tid & 63, wid = __builtin_amdgcn_readfirstlane(tid >> 6), wr = wid >> 2, wc = wid & 3, fr = lane & 15, fq = lane >> 4;
    constexpr int K = MODE == 0 ? D : FF, ldw = MODE == 0 ? 512 : D, NK = K / 32, NB = K / 128, APITCH = MODE == 0 ? D : FF;
    const int wcol = MODE == 0 ? (((lane & 3) >> 1) * 256 + 128 * j + 32 * (lane >> 4) + 8 * ((lane >> 2) & 3) + 4 * (lane & 1)) : (256 * j + 4 * lane);
    const char* wsrc = (const char*)(W + (size_t)(4 * wid) * ldw);
    const unsigned wvoff = 4u * (unsigned)wcol;
    const char* abase = MODE == 0 ? (const char*)F.H2 : (const char*)ACT;
    const int arow0 = 32 * wid + (lane >> 3), ac = lane & 7;
    const int awoff = EX_A0 + arow0 * 32 + (ac & 1) * 16;
#define EX_ISSUE_W(ks, st) do { LAS unsigned char* sb_ = lds + EX_W0 + (st) * EX_WST; \
        _Pragma("unroll") for (int i_ = 0; i_ < 4; ++i_) ex_dma<0>(wsrc + (size_t)(32 * (ks) + i_) * (ldw * 4) + wvoff, sb_ + (4 * wid + i_) * 1024); } while (0)
#define EX_LOAD_A(b) do { _Pragma("unroll") for (int i_ = 0; i_ < 4; ++i_) { const int r_ = arow0 + 8 * i_; \
        const unsigned o_ = (MODE == 0 ? (tokL[r_] & 0xffffu) : (unsigned)r_) * (unsigned)APITCH + 16u * (unsigned)ac + 128u * (unsigned)(b); ar[i_] = ex_gld16v(abase, o_); } } while (0)
#define EX_WRITE_A(sb0, WAITSTR) do {   \
          \
        int sl_ = (sb0) + (ac >> 1); sl_ = sl_ >= EX_NAS ? sl_ - EX_NAS : sl_; \
        const unsigned ae_ = (unsigned)(uintptr_t)(lds + awoff + sl_ * EX_ASL), ao_ = (unsigned)(uintptr_t)(lds + (awoff ^ 16) + sl_ * EX_ASL); \
        asm volatile(WAITSTR "\n\tds_write_b128 %4, %0\n\tds_write_b128 %5, %1 offset:256\n\tds_write_b128 %4, %2 offset:512\n\tds_write_b128 %5, %3 offset:768" \
                     :: "v"(ar[0]), "v"(ar[1]), "v"(ar[2]), "v"(ar[3]), "v"(ae_), "v"(ao_) : "memory"); } while (0)
    v4u ar[4];
    f32x4 acc[8][4];
#pragma unroll
    for (int m = 0; m < 8; ++m)
#pragma unroll
        for (int q = 0; q < 4; ++q) acc[m][q] = (f32x4){0.f, 0.f, 0.f, 0.f};
    const bool active = 128 * wr < nrows;
    const int boff = EX_W0 + fq * 8192 + wc * 256 + fr * 16;
    const int aoff_r = EX_A0 + (128 * wr + fr) * 32 + ((fq ^ (((fr >> 3) & 1) << 1)) * 8);
    EX_LOAD_A(0); EX_ISSUE_W(0, 0); EX_ISSUE_W(1, 1);
    EX_WRITE_A(0, "s_waitcnt vmcnt(8)");
    int st = 0, as = 0;
#pragma unroll 4
    for (int ks = 0; ks < NK; ++ks) {
        { const int after = (ks + 1 < NK ? 4 : 0) + ((((ks & 3) == 1 || (ks & 3) == 2) && (ks >> 2) + 1 < NB) ? 4 : 0);
          if (after >= 8) asm volatile("s_waitcnt vmcnt(8)" ::: "memory"); else if (after >= 4) asm volatile("s_waitcnt vmcnt(4)" ::: "memory"); else asm volatile("s_waitcnt vmcnt(0)" ::: "memory"); }
        asm volatile("s_waitcnt lgkmcnt(0)" ::: "memory");
        __builtin_amdgcn_s_barrier();
        asm volatile("" ::: "memory");
        f32x4 xw[8]; long af[8];
        if (active) {
            const LAS unsigned char* bp = lds + boff + st * EX_WST;
#pragma unroll
            for (int jj = 0; jj < 8; ++jj) xw[jj] = *(const LAS f32x4*)(bp + jj * 1024);
            const LAS unsigned char* ap = lds + aoff_r + as * EX_ASL;
#pragma unroll
            for (int m = 0; m < 8; ++m) af[m] = *(const LAS long*)(ap + m * 512);
        }
        const int s2 = st + 2 >= EX_NST ? st + 2 - EX_NST : st + 2;
        if (ks + 2 < NK) EX_ISSUE_W(ks + 2, s2);
        if (active) {
            long bw[4];
#pragma unroll
            for (int q = 0; q < 4; ++q) { const unsigned lo = ex_pk8(xw[0][q], xw[1][q], xw[2][q], xw[3][q]), hi = ex_pk8(xw[4][q], xw[5][q], xw[6][q], xw[7][q]);
                bw[q] = (long)(((unsigned long long)hi << 32) | (unsigned long long)lo); }
            __builtin_amdgcn_s_setprio(1);
#pragma unroll
            for (int m = 0; m < 8; ++m)
#pragma unroll
                for (int q = 0; q < 4; ++q) acc[m][q] = __builtin_amdgcn_mfma_f32_16x16x32_fp8_fp8(bw[q], af[m], acc[m][q], 0, 0, 0);
            __builtin_amdgcn_s_setprio(0);
        }
        if ((ks & 3) == 0 && (ks >> 2) + 1 < NB) EX_LOAD_A((ks >> 2) + 1);
        if ((ks & 3) == 3 && ks + 1 < NK) {
            const int sb0 = as + 1 >= EX_NAS ? 0 : as + 1;
            EX_WRITE_A(sb0, "s_waitcnt vmcnt(12)");
        }
        st = st + 1 >= EX_NST ? 0 : st + 1; as = as + 1 >= EX_NAS ? 0 : as + 1;
    }
#undef EX_ISSUE_W
#undef EX_LOAD_A
#undef EX_WRITE_A
    if (active) {
        if (MODE == 0) {
#pragma unroll
            for (int m = 0; m < 8; ++m) { float o[8];
#pragma unroll
                for (int rg = 0; rg < 2; ++rg)
#pragma unroll
                    for (int q = 0; q < 4; ++q) { const float g = acc[m][q][rg], u = acc[m][q][rg + 2]; o[4 * rg + q] = g * __builtin_amdgcn_rcpf(1.0f + __expf(-g)) * u; }
                v2u w; w.x = ex_pk8(o[0], o[1], o[2], o[3]); w.y = ex_pk8(o[4], o[5], o[6], o[7]);
                *(v2u*)(ACT + (size_t)(128 * wr + 16 * m + fr) * FF + 128 * j + 32 * wc + 8 * fq) = w; }
        } else {
#pragma unroll
            for (int m = 0; m < 8; ++m) { const int row = 128 * wr + 16 * m + fr;
                if (row < nrows) { const unsigned ti = tokL[row]; const float wv = wgtL[row];
                    unsigned char* yp = (unsigned char*)F.Y + ((size_t)(ti & 0xffffu) * NSLOT9 + (ti >> 16)) * D + 256 * j + 64 * wc + 16 * fq;
                    v4u w;
#pragma unroll
                    for (int rg = 0; rg < 4; ++rg) { unsigned p = __builtin_amdgcn_cvt_pk_fp8_f32(acc[m][0][rg] * wv, acc[m][1][rg] * wv, 0, false);
                        w[rg] = __builtin_amdgcn_cvt_pk_fp8_f32(acc[m][2][rg] * wv, acc[m][3][rg] * wv, p, true); }
                    *(v4u*)yp = w; } }
        }
    }
    __builtin_amdgcn_s_barrier();
    asm volatile("" ::: "memory");
}
__device__ __forceinline__ void expert_unit(Frame& F, int e, int chunk, int nrows) {
    LAS unsigned char* lds = F.lds + RING_OFF;
    LAS unsigned* tokL = (LAS unsigned*)(lds + EX_TOK); LAS float* wgtL = (LAS float*)(lds + EX_WGT);
    const int tid = F.tid;
    if (tid < EX_ROWS) { const bool ok = tid < nrows; size_t p = (size_t)e * T + (size_t)chunk * EX_ROWS + tid;
        if (e < NE) { const unsigned r = (unsigned)(chunk * EX_ROWS + tid); unsigned run = 0; p = (size_t)e * T;
#pragma unroll
            for (int g_ = 0; g_ < 8; ++g_) { const unsigned c = __hip_atomic_load(F.ctl + CW_COUNT + g_ * NE + e, RLX_AGENT); if (r >= run && r < run + c) p = (size_t)e * T + (size_t)g_ * (T / 8) + (r - run); run += c; } }
        tokL[tid] = ok ? F.LTOK[p] : 0u; wgtL[tid] = ok ? F.LW[p] : 0.f; }
    __syncthreads();
    const float* Wgu = e < NE ? F.w_gu + (size_t)e * D * 512 : F.w_sh_gu;
    const float* Wdn = e < NE ? F.w_down + (size_t)e * FF * D : F.w_sh_down;
    unsigned char* ACT = (unsigned char*)F.ACT + (size_t)F.vcu * EX_ROWS * FF;
#pragma unroll 1
    for (int j = 0; j < 2; ++j) ex_tile<0>(F, lds, tid, Wgu, j, nrows, ACT);
    VM_WAIT(); __syncthreads();
#pragma unroll 1
    for (int j = 0; j < 4; ++j) ex_tile<1>(F, lds, tid, Wdn, j, nrows, ACT);
}
__device__ __forceinline__ void expert_phase(Frame& F) {
    LAS unsigned char* lds = F.lds + RING_OFF;
    LAS unsigned* pfx = (LAS unsigned*)(lds + EX_PFX);
    LAS unsigned* qw = (LAS unsigned*)(lds + EX_QW);
    __syncthreads();
    LAS unsigned* cntL = (LAS unsigned*)(lds + EX_A0);
    if (F.tid < NE) { unsigned c = 0;
#pragma unroll
        for (int g_ = 0; g_ < 8; ++g_) c += __hip_atomic_load(F.ctl + CW_COUNT + g_ * NE + F.tid, RLX_AGENT);
        cntL[F.tid] = c; }
    __syncthreads();
    if (F.tid < 8) { const int x = F.tid; unsigned run = 0;
        for (int i = 0; i < 32; ++i) { pfx[x * EX_XQ + i] = run; run += (cntL[8 * i + x] + EX_ROWS - 1) / EX_ROWS; }
        pfx[x * EX_XQ + 32] = run; run += (T / EX_ROWS) / 8; pfx[x * EX_XQ + 33] = run; }
    __syncthreads();
    const int myx = (int)(xb_xcc_id() & 7u);
    int hop = 0;
#pragma unroll 1
    for (;;) {
        __syncthreads();
        if (F.tid == 0) { unsigned u = 0xffffffffu; int h = hop;
            for (; h < 8; ++h) { const int x = (myx + h) & 7; u = __hip_atomic_fetch_add(F.ctl + CW_QUEUE + 64 * x, 1u, RLX_AGENT); if (u < pfx[x * EX_XQ + 33]) break; }
            qw[0] = u; qw[1] = (unsigned)h; }
        __syncthreads();
        const int u = (int)qw[0]; hop = (int)qw[1];
        if (hop >= 8) break;
        const int x = (myx + hop) & 7;
        const LAS unsigned* px = pfx + x * EX_XQ;
        int lo = 0, hi = 32;
        while (lo < hi) { const int mid = (lo + hi + 1) >> 1; if ((int)px[mid] <= u) lo = mid; else hi = mid - 1; }
        int e, chunk, cnt;
        if (lo < 32) { e = 8 * lo + x; chunk = u - (int)px[lo]; cnt = 0;
#pragma unroll
            for (int g_ = 0; g_ < 8; ++g_) cnt += (int)__hip_atomic_load(F.ctl + CW_COUNT + g_ * NE + e, RLX_AGENT); }
        else { e = NE; chunk = 8 * x + (u - (int)px[32]); cnt = T; }
        const int nrows = min(EX_ROWS, cnt - EX_ROWS * chunk);
        expert_unit(F, e, chunk, nrows);
    }
}
__device__ __forceinline__ void final_phase(Frame& F) {
    typedef float f32x2 __attribute__((ext_vector_type(2)));
    const int gw = F.vcu * NWAVES + F.wave, NGW = F.G * NWAVES;
    for (int m = gw; m < T; m += NGW) {
        const float* gm = F.MOD + (size_t)(m >> 12) * 6144 + 5 * 1024;
        const unsigned* yrow = (const unsigned*)((const unsigned char*)F.Y + (size_t)m * NSLOT9 * D) + F.lane;
#pragma unroll
        for (int i = 0; i < 4; ++i) { const int c = 4 * F.lane + 256 * i; float a0 = 0.f, a1 = 0.f, a2 = 0.f, a3 = 0.f;
#pragma unroll
            for (int k = 0; k < NSLOT9; ++k) { const unsigned y = __builtin_nontemporal_load(yrow + k * (D / 4) + 64 * i);
                const f32x2 lo = __builtin_amdgcn_cvt_pk_f32_fp8(y, false), hi = __builtin_amdgcn_cvt_pk_f32_fp8(y, true); a0 += lo[0]; a1 += lo[1]; a2 += hi[0]; a3 += hi[1]; }
            f32x4 r = __builtin_nontemporal_load((const f32x4*)(F.x + (size_t)m * D + c));
            { const v2u d = __builtin_nontemporal_load((const v2u*)(F.DLT + (size_t)m * D + c)); r.x += bflo(d.x); r.y += bfhi(d.x); r.z += bflo(d.y); r.w += bfhi(d.y); }
            const f32x4 g = *(const f32x4*)(gm + c);
            f32x4 o; o.x = r.x + g.x * a0; o.y = r.y + g.y * a1; o.z = r.z + g.z * a2; o.w = r.w + g.w * a3;
            __builtin_nontemporal_store(o, (f32x4*)(F.out + (size_t)m * D + c)); }
    }
}
struct Args { const void* in[19]; float* out; unsigned char* ws; };
static_assert(sizeof(Args) == 21 * 8, "Args has no padding bytes");
__global__ void __launch_bounds__(NWAVES * 64, 2) hybrid_fwd(Args args) {
    extern __shared__ __attribute__((aligned(16))) unsigned char lds[];
    Frame F;
    F.lds = (LAS unsigned char*)lds;
    F.MISC = (volatile LAS unsigned*)(F.lds + MISC_OFF);
    F.tid = threadIdx.x; F.lane = F.tid & 63; F.wave = __builtin_amdgcn_readfirstlane(F.tid >> 6);
    F.G = gridDim.x; { const int bx = blockIdx.x; F.vcu = (F.G % 8 == 0) ? (bx % 8) * (F.G / 8) + bx / 8 : bx; }
    unsigned char* ws = args.ws;
    F.ctl = (unsigned*)(ws + WS_CTL);
    F.x = (const float*)args.in[0]; F.c = (const float*)args.in[1]; F.positions = (const int*)args.in[2]; F.w_ada = (const float*)args.in[3]; F.b_ada = (const float*)args.in[4];
    F.g_mix = (const float*)args.in[5]; F.w_in = (const float*)args.in[6]; F.g_q = (const float*)args.in[7]; F.g_k = (const float*)args.in[8]; F.lam = (const float*)args.in[9];
    F.g_sub = (const float*)args.in[10]; F.w_out = (const float*)args.in[11]; F.g_ffn = (const float*)args.in[12]; F.w_router = (const float*)args.in[13]; F.e_bias = (const float*)args.in[14];
    F.w_sh_gu = (const float*)args.in[15]; F.w_sh_down = (const float*)args.in[16]; F.w_gu = (const float*)args.in[17]; F.w_down = (const float*)args.in[18];
    F.out = args.out;
    F.MOD = (float*)(ws + WS_MOD); F.RCOS = (float*)(ws + WS_COS); F.RSIN = (float*)(ws + WS_SIN); F.DLT = (bf16*)(ws + WS_R); F.LW = (float*)(ws + WS_LW);
    F.WIN = (bf16*)(ws + WS_WIN); F.WOUT = (bf16*)(ws + WS_WOUT); F.WR = (bf16*)(ws + WS_WR); F.XN = (bf16*)(ws + WS_XN); F.PROJ = (bf16*)(ws + WS_PROJ); F.SVT = (bf16*)(ws + WS_SVT);
    F.ORAW = (bf16*)(ws + WS_ORAW); F.MIXED = (bf16*)(ws + WS_MIXED); F.H2 = (bf16*)(ws + WS_H2); F.Y = (bf16*)(ws + WS_Y); F.ACT = (bf16*)(ws + WS_ACT); F.LTOK = (unsigned*)(ws + WS_LTOK);
    for (int u = F.tid; u < (LDS_BYTES - LDSCTL_OFF) / 4; u += NWAVES * 64) ((LAS unsigned*)(F.lds + LDSCTL_OFF))[u] = 0u;
    __syncthreads();
    XcdBarrier bar = xcd_barrier_post(F.ctl + CW_BAR, F.MISC + 8);
#define GRID_BAR() xcd_barrier(bar)
#define PHASE_BEGIN() do { int t_ = threadIdx.x; asm volatile("" : "+v"(t_)); F.tid = t_; F.lane = t_ & 63; } while (0)

    PHASE_BEGIN(); p0_prologue(F);
    GRID_BAR();
    PHASE_BEGIN(); rows_adaln(F, F.x, F.g_mix, F.MOD + 0 * 1024, F.MOD + 1 * 1024, F.XN);
    GRID_BAR();
    {   pg8::Gemm g{F.XN, F.WIN, T, NPROJ, D}; pg8::StaticOrder S; S.init(T, NPROJ, F.G, (int)blockIdx.x);
        pg8::EpiProj E{F.PROJ, F.SVT, F.RCOS, F.RSIN, F.g_q, F.g_k};
        pg8::gemm_phase<pg8::EpiProj, pg8::StaticOrder, PG8_ALIGN, PG8_SP2>(F.lds + RING_OFF, g, S, E); }
    GRID_BAR();
    {   const attn_body::StaticOrder S((int)F.G, (int)blockIdx.x);
        attn_body::attn_phase<attn_body::StaticOrder>((char*)lds + RING_OFF, (const attn_body::bf16*)F.PROJ, (attn_body::bf16*)F.ORAW, S); }
    PHASE_BEGIN(); sb_phase(F);
    GRID_BAR();
    PHASE_BEGIN(); combine_phase(F);
    GRID_BAR();
    {   pg8::Gemm g{F.MIXED, F.WOUT, T, D, D}; pg8::StaticOrder S; S.init(T, D, F.G, (int)blockIdx.x);
        pg8::EpiGateBf16 E{F.MOD + 2 * 1024, F.DLT};
        pg8::gemm_phase<pg8::EpiGateBf16, pg8::StaticOrder, PG8_ALIGN, PG8_SP2>(F.lds + RING_OFF, g, S, E); }
    GRID_BAR();
    PHASE_BEGIN(); route_phase(F);
    GRID_BAR();
    PHASE_BEGIN(); expert_phase(F);
    GRID_BAR();
    PHASE_BEGIN(); final_phase(F);
}

extern "C" void kernel_launch(void* const* d_in, const int* in_sizes, int n_in, void* d_out, int out_size, void* d_ws, size_t ws_size, hipStream_t stream) {
    static int grid = 0;
    if (grid == 0) {
        if (n_in != 19 || out_size != T * D || ws_size < WS_END) { fprintf(stderr, "kernel_launch: unexpected problem shape (n_in %d, out %d, ws %zu); nothing launched\n", n_in, out_size, ws_size); grid = -1; return; }
        int dev = 0, cus = 0, per_cu = 0;
        if (hipGetDevice(&dev) != hipSuccess || hipDeviceGetAttribute(&cus, hipDeviceAttributeMultiprocessorCount, dev) != hipSuccess) { grid = -1; return; }
        if (hipFuncSetAttribute((const void*)hybrid_fwd, hipFuncAttributeMaxDynamicSharedMemorySize, LDS_BYTES) != hipSuccess) { fprintf(stderr, "kernel_launch: hipFuncSetAttribute failed\n"); grid = -1; return; }
        if (hipOccupancyMaxActiveBlocksPerMultiprocessor(&per_cu, (const void*)hybrid_fwd, NWAVES * 64, LDS_BYTES) != hipSuccess || per_cu < 1)
            fprintf(stderr, "kernel_launch: note: the occupancy query reports %d workgroups per CU\n", per_cu);
        (void)hipGetLastError();
        grid = cus;
        if (grid != 256) fprintf(stderr, "kernel_launch: %d CUs (expected 256)\n", grid);
    }
    if (grid < 0) return;
    if (hipMemsetAsync((char*)d_ws + WS_CTL, 0, CTL_ZERO_BYTES, stream) != hipSuccess) { fprintf(stderr, "kernel_launch: hipMemsetAsync failed\n"); return; }
    Args a{};
    for (int i = 0; i < 19; ++i) a.in[i] = d_in[i];
    a.out = (float*)d_out; a.ws = (unsigned char*)d_ws;
    hipLaunchKernelGGL(hybrid_fwd, dim3(grid), dim3(NWAVES * 64), LDS_BYTES, stream, a);
    const hipError_t le = hipPeekAtLastError();
    if (le != hipSuccess) fprintf(stderr, "kernel_launch: launch failed: %s\n", hipGetErrorName(le));
}
```

```cpp
#include <hip/hip_runtime.h>
#include <hip/hip_bf16.h>
#include <cstdio>
#include <cstdint>
#include <cmath>
namespace pg8 {
#define PG8_LAS __attribute__((address_space(3)))
typedef unsigned short bf16_t;
typedef short bf16x8 __attribute__((ext_vector_type(8)));
typedef float f32x4 __attribute__((ext_vector_type(4)));
typedef unsigned u32x4 __attribute__((ext_vector_type(4)));
constexpr int BM = 256, BK = 64, HALF = 128, HTB = HALF * BK * 2  , STAGE_BYTES = 8 * HTB, NXCD = 8, WGM = 8;

__host__ __device__ __forceinline__ int lds_byte(int r, int c) { const int st = (r >> 4) * 2 + (c >> 5), rr = r & 15, cc = c & 31, ob = rr * 64 + cc * 2; return st * 1024 + (ob ^ (((ob >> 9) & 1) << 5)); }
__host__ __device__ __forceinline__ void stage_rc(int b, int& R, int& C) { const int st = b / 1024, sb = b % 1024, swz = sb ^ (((sb >> 9) & 1) << 5); R = (st >> 1) * 16 + swz / 64; C = (st & 1) * 32 + (swz % 64) / 2; }
__host__ __device__ __forceinline__ int perm32(int rho) { const int n = rho >> 4, i = rho & 15; return 8 * (i >> 2) + 4 * n + (i & 3); }

struct Unit { int pm, pn; };
struct Gemm { const bf16_t* A; const bf16_t* Bt; int M, N, K; };

struct StaticOrder {
    int nM, nN, nwg, G, c;
    __host__ __device__ void init(int M, int N, int G_, int c_) { nM = M / BM; nN = N / BM; nwg = nM * nN; G = G_; c = c_; }
    __host__ __device__ bool next(int i, Unit& u) const {
        const long L = (long)i * G + c; if (L >= nwg) return false;
        int wgid = (int)L; { const int q = nwg / NXCD, r = nwg % NXCD, xcd = wgid % NXCD, off = wgid / NXCD; wgid = (xcd < r ? xcd * (q + 1) : r * (q + 1) + (xcd - r) * q) + off; }
        const int nig = WGM * nN, gid = wgid / nig, fm = gid * WGM, gsz = (nM - fm) < WGM ? (nM - fm) : WGM;
        u.pm = fm + ((wgid % nig) % gsz); u.pn = (wgid % nig) / gsz; return true;
    }
    __device__ __forceinline__ void a_ready(const Unit&) const {}
    __device__ __forceinline__ void done(const Unit&) const {}
};

__device__ __forceinline__ unsigned cvt_pk_bf16(float lo, float hi) { typedef float f2_t __attribute__((ext_vector_type(2))); typedef __bf16 b2_t __attribute__((ext_vector_type(2)));
    f2_t v = {lo, hi}; b2_t b = __builtin_convertvector(v, b2_t); return __builtin_bit_cast(unsigned, b); }
typedef unsigned u32x2 __attribute__((ext_vector_type(2)));
constexpr float QK_C2 = 0.125f * 1.4426950408889634f;

struct EpiGateBf16 {
    static constexpr bool PERM = false, AFTER_DRAIN = false;
    const float* gate; bf16_t* DLT;
    __device__ __forceinline__ void operator()(const f32x4 (&acc)[2][2][4][2], const Unit& u, int wr, int wc, int fr, int fq) const {
        const int row0 = u.pm * BM + wr * 64 + fr, col0 = u.pn * BM + wc * 32 + 4 * fq;
        const float* gb = gate + (size_t)(u.pm >> 4) * 6144 + col0;
        f32x4 gv[2][2];
#pragma unroll
        for (int bj = 0; bj < 2; ++bj)
#pragma unroll
            for (int n = 0; n < 2; ++n) gv[bj][n] = *(const f32x4*)(gb + bj * HALF + n * 16);
#pragma unroll
        for (int ai = 0; ai < 2; ++ai)
#pragma unroll
            for (int m = 0; m < 4; ++m) { bf16_t* rowp = DLT + (size_t)(row0 + ai * HALF + m * 16) * 1024 + col0;
#pragma unroll
                for (int bj = 0; bj < 2; ++bj)
#pragma unroll
                    for (int n = 0; n < 2; ++n) { const f32x4 v = gv[bj][n] * acc[ai][bj][m][n]; u32x2 w; w.x = cvt_pk_bf16(v[0], v[1]); w.y = cvt_pk_bf16(v[2], v[3]); *(u32x2*)(rowp + bj * HALF + n * 16) = w; } }
    }
};
struct EpiProj {
    static constexpr bool PERM = false, AFTER_DRAIN = false;
    bf16_t* P; bf16_t* SVT; const float* rcos; const float* rsin; const float* gq; const float* gk;
    __device__ __forceinline__ void operator()(const f32x4 (&acc)[2][2][4][2], const Unit& u, int wr, int wc, int fr, int fq) const {
        const int row0 = u.pm * BM + wr * 64 + fr, pn = u.pn;
        const int cbase = pn * BM + 64 * wc + 4 * fq;
        if (pn < 4) {
            const float* g = pn < 2 ? gq : gk; const float osc = pn < 2 ? QK_C2 : 1.0f;
            f32x4 gv[2][2];
#pragma unroll
            for (int bj = 0; bj < 2; ++bj)
#pragma unroll
                for (int n = 0; n < 2; ++n) gv[bj][n] = *(const f32x4*)(g + 32 * bj + 16 * n + 4 * fq);
#pragma unroll
            for (int ai = 0; ai < 2; ++ai)
#pragma unroll
                for (int m = 0; m < 4; ++m) { const int row = row0 + ai * HALF + m * 16; float ss = 0.f;
#pragma unroll
                    for (int bj = 0; bj < 2; ++bj)
#pragma unroll
                        for (int n = 0; n < 2; ++n) { const f32x4 v = acc[ai][bj][m][n]; ss += (v[0] * v[0] + v[1] * v[1]) + (v[2] * v[2] + v[3] * v[3]); }
                    ss += __shfl_xor(ss, 16); ss += __shfl_xor(ss, 32);
                    const float rstd = 1.0f / sqrtf(ss * (1.0f / 64.0f) + 1e-6f);
                    bf16_t* prow = P + (size_t)row * 3072 + cbase;
#pragma unroll
                    for (int n = 0; n < 2; ++n) { const f32x4 cs = *(const f32x4*)(rcos + (size_t)row * 32 + 16 * n + 4 * fq), sn = *(const f32x4*)(rsin + (size_t)row * 32 + 16 * n + 4 * fq);
                        const f32x4 lo = acc[ai][0][m][n] * rstd * gv[0][n], hi = acc[ai][1][m][n] * rstd * gv[1][n];
                        const f32x4 olo = (lo * cs - hi * sn) * osc, ohi = (hi * cs + lo * sn) * osc;
                        u32x2 w0, w1; w0.x = cvt_pk_bf16(olo[0], olo[1]); w0.y = cvt_pk_bf16(olo[2], olo[3]); w1.x = cvt_pk_bf16(ohi[0], ohi[1]); w1.y = cvt_pk_bf16(ohi[2], ohi[3]);
                        *(u32x2*)(prow + 16 * n) = w0; *(u32x2*)(prow + 32 + 16 * n) = w1; } }
        } else if (pn < 10) {
            const float osc = (pn == 6 || pn == 7) ? QK_C2 : 1.0f;
#pragma unroll
            for (int ai = 0; ai < 2; ++ai)
#pragma unroll
                for (int m = 0; m < 4; ++m) { bf16_t* prow = P + (size_t)(row0 + ai * HALF + m * 16) * 3072 + cbase;
#pragma unroll
                    for (int bj = 0; bj < 2; ++bj)
#pragma unroll
                        for (int n = 0; n < 2; ++n) { const f32x4 v = acc[ai][bj][m][n] * osc; u32x2 w; w.x = cvt_pk_bf16(v[0], v[1]); w.y = cvt_pk_bf16(v[2], v[3]); *(u32x2*)(prow + 32 * bj + 16 * n) = w; } }
        } else {
            const int hd = 4 * (pn - 10) + wc;
#pragma unroll
            for (int ai = 0; ai < 2; ++ai)
#pragma unroll
                for (int m = 0; m < 4; ++m) { const int row = row0 + ai * HALF + m * 16, b = row >> 12, t = row & 4095;
                    bf16_t* vb = SVT + ((size_t)(b * 8 + hd) * 64 + 4 * fq) * 4096 + t;
#pragma unroll
                    for (int bj = 0; bj < 2; ++bj)
#pragma unroll
                        for (int n = 0; n < 2; ++n) { const f32x4 v = acc[ai][bj][m][n]; const unsigned p0 = cvt_pk_bf16(v[0], v[1]), p1 = cvt_pk_bf16(v[2], v[3]);
                            bf16_t* d = vb + (size_t)(32 * bj + 16 * n) * 4096;
                            d[0] = (bf16_t)(p0 & 0xffffu); d[4096] = (bf16_t)(p0 >> 16); d[2 * 4096] = (bf16_t)(p1 & 0xffffu); d[3 * 4096] = (bf16_t)(p1 >> 16); } }
        }
    }
};

template <class Epi, class Sched, bool ALIGN_EPI = false, bool SP2 = false>
__device__ __forceinline__ void gemm_phase(PG8_LAS unsigned char* lds, const Gemm g, const Sched& S, const Epi& E) {
    int tid_ = threadIdx.x; asm volatile("" : "+v"(tid_));
    const int tid = tid_, wid = __builtin_amdgcn_readfirstlane(tid >> 6), lane = tid & 63, wr = wid >> 2, wc = wid & 3, fr = lane & 15, fq = lane >> 4;
    const int K = g.K, nt = K / BK;
    unsigned voffA[2], voffB[2];
#pragma unroll
    for (int i = 0; i < 2; ++i) { int R, C; stage_rc(tid * 16 + i * 8192, R, C); const int Rb = Epi::PERM ? ((R & ~31) + perm32(R & 31)) : R;
        voffA[i] = (unsigned)(R * K + C) * 2u; voffB[i] = (unsigned)(Rb * K + C) * 2u; }
    const size_t kstep = (size_t)(BK * 2);
    const size_t hstep = (size_t)HALF * K * 2;
    const size_t tstep = 2 * hstep;
    const unsigned ldsw = (unsigned)wid * 1024u;
    const int aoff = lds_byte(wr * 64 + fr, fq * 8), boff = lds_byte(wc * 32 + fr, fq * 8);
#define PG8_SA(b, h) (((b) * 2 + (h)) * HTB)
#define PG8_SB(b, h) ((4 + (b) * 2 + (h)) * HTB)
#define PG8_STAGE(bufoff, gbase, voff) do { _Pragma("unroll") for (int _i = 0; _i < 2; ++_i) \
        __builtin_amdgcn_global_load_lds((const unsigned*)((const char*)(gbase) + (voff)[_i]), (PG8_LAS unsigned*)(lds + (bufoff) + ldsw + _i * 8192), 16, 0, 0); } while (0)
#define PG8_LDA(dst, b, h) do { _Pragma("unroll") for (int m = 0; m < 4; ++m) _Pragma("unroll") for (int k = 0; k < 2; ++k) dst[m][k] = *(const PG8_LAS bf16x8*)(lds + PG8_SA(b, h) + aoff + m * 2048 + k * 1024); } while (0)
#define PG8_LDB(dst, b, h) do { _Pragma("unroll") for (int n = 0; n < 2; ++n) _Pragma("unroll") for (int k = 0; k < 2; ++k) dst[n][k] = *(const PG8_LAS bf16x8*)(lds + PG8_SB(b, h) + boff + n * 2048 + k * 1024); } while (0)
#define PG8_MMA(ai, bj, At, Bt) do { __builtin_amdgcn_s_setprio(1); _Pragma("unroll") for (int m = 0; m < 4; ++m) _Pragma("unroll") for (int n = 0; n < 2; ++n) _Pragma("unroll") for (int k = 0; k < 2; ++k) \
        acc[ai][bj][m][n] = __builtin_amdgcn_mfma_f32_16x16x32_bf16(Bt[n][k], At[m][k], acc[ai][bj][m][n], 0, 0, 0); __builtin_amdgcn_s_setprio(0); } while (0)
#define PG8_WAIT_V(n) asm volatile("s_waitcnt vmcnt(" #n ")" ::: "memory")
#define PG8_WAIT_L(n) asm volatile("s_waitcnt lgkmcnt(" #n ")" ::: "memory")
#define PG8_BAR __builtin_amdgcn_s_barrier()
#define PG8_SCHED __builtin_amdgcn_sched_barrier(0)
    Unit cur, nxt; int ui = 0;
    if (!S.next(0, cur)) return;
    f32x4 acc[2][2][4][2];
#pragma unroll
    for (int a = 0; a < 2; ++a)
#pragma unroll
        for (int b = 0; b < 2; ++b)
#pragma unroll
            for (int m = 0; m < 4; ++m)
#pragma unroll
                for (int n = 0; n < 2; ++n) acc[a][b][m][n] = (f32x4){0.f, 0.f, 0.f, 0.f};
    bf16x8 At[4][2], B0[2][2], B1[2][2];
    const char* cA = (const char*)g.A + (size_t)cur.pm * tstep; const char* cB = (const char*)g.Bt + (size_t)cur.pn * tstep;
    S.a_ready(cur);
    if constexpr (SP2) {
        PG8_STAGE(PG8_SB(0, 0), cB, voffB); PG8_STAGE(PG8_SB(0, 1), cB + hstep, voffB); PG8_STAGE(PG8_SA(0, 0), cA, voffA); PG8_STAGE(PG8_SA(0, 1), cA + hstep, voffA);
        if (wr == 1) PG8_BAR;
        PG8_WAIT_V(2); PG8_BAR;
        PG8_STAGE(PG8_SB(1, 0), cB + kstep, voffB); PG8_STAGE(PG8_SA(1, 0), cA + kstep, voffA); PG8_STAGE(PG8_SB(1, 1), cB + hstep + kstep, voffB);
        PG8_WAIT_V(6); PG8_BAR;
    } else {
        PG8_STAGE(PG8_SB(0, 0), cB, voffB); PG8_STAGE(PG8_SA(0, 0), cA, voffA); PG8_STAGE(PG8_SB(0, 1), cB + hstep, voffB); PG8_STAGE(PG8_SA(0, 1), cA + hstep, voffA);
        if (wr == 1) PG8_BAR;
        PG8_WAIT_V(4); PG8_BAR;
        PG8_STAGE(PG8_SB(1, 0), cB + kstep, voffB); PG8_STAGE(PG8_SA(1, 0), cA + kstep, voffA); PG8_STAGE(PG8_SB(1, 1), cB + hstep + kstep, voffB);
        PG8_WAIT_V(6); PG8_BAR;
    }
    for (;;) {
        const bool has_next = S.next(ui + 1, nxt);
        const char* nA = has_next ? (const char*)g.A + (size_t)nxt.pm * tstep : cA; const char* nB = has_next ? (const char*)g.Bt + (size_t)nxt.pn * tstep : cB;
        for (int t = 0; t < nt; t += 2) {
            const bool last = (t == nt - 2);
            const char* a1 = cA + (size_t)(t + 1) * kstep;
            const char* a2 = last ? nA : cA + (size_t)(t + 2) * kstep; const char* b2 = last ? nB : cB + (size_t)(t + 2) * kstep;
            const char* a3 = a2 + kstep; const char* b3 = b2 + kstep;
            if (last && has_next) S.a_ready(nxt);
            if constexpr (SP2) {
            PG8_LDB(B0, 0, 0); PG8_LDB(B1, 0, 1); PG8_SCHED; PG8_LDA(At, 0, 0); PG8_STAGE(PG8_SA(1, 1), a1 + hstep, voffA);
            PG8_WAIT_V(8); PG8_WAIT_L(0); PG8_BAR; PG8_MMA(0, 0, At, B0); PG8_MMA(0, 1, At, B1); PG8_BAR; PG8_SCHED;
            PG8_LDA(At, 0, 1); PG8_STAGE(PG8_SB(0, 0), b2, voffB); PG8_STAGE(PG8_SB(0, 1), b2 + hstep, voffB); PG8_STAGE(PG8_SA(0, 0), a2, voffA);
            PG8_WAIT_V(8); PG8_WAIT_L(0); PG8_BAR; PG8_MMA(1, 0, At, B0); PG8_MMA(1, 1, At, B1); PG8_BAR; PG8_SCHED;
            PG8_LDB(B0, 1, 0); PG8_LDB(B1, 1, 1); PG8_SCHED; PG8_LDA(At, 1, 0); PG8_STAGE(PG8_SA(0, 1), a2 + hstep, voffA);
            PG8_WAIT_V(8); PG8_WAIT_L(0); PG8_BAR; PG8_MMA(0, 0, At, B0); PG8_MMA(0, 1, At, B1); PG8_BAR; PG8_SCHED;
            PG8_LDA(At, 1, 1); PG8_STAGE(PG8_SB(1, 0), b3, voffB); PG8_STAGE(PG8_SB(1, 1), b3 + hstep, voffB); PG8_STAGE(PG8_SA(1, 0), a3, voffA);
            PG8_WAIT_V(8); PG8_WAIT_L(0); PG8_BAR; PG8_MMA(1, 0, At, B0); PG8_MMA(1, 1, At, B1); PG8_BAR; PG8_SCHED;
            } else {
            PG8_LDB(B0, 0, 0); PG8_SCHED; PG8_LDA(At, 0, 0); PG8_STAGE(PG8_SA(1, 1), a1 + hstep, voffA);
            PG8_WAIT_L(8); PG8_BAR; PG8_WAIT_L(0); PG8_MMA(0, 0, At, B0); PG8_BAR; PG8_SCHED;
            PG8_LDB(B1, 0, 1); PG8_STAGE(PG8_SB(0, 0), b2, voffB);
            PG8_BAR; PG8_WAIT_L(0); PG8_MMA(0, 1, At, B1); PG8_BAR;
            PG8_LDA(At, 0, 1); PG8_STAGE(PG8_SA(0, 0), a2, voffA);
            PG8_BAR; PG8_WAIT_L(0); PG8_MMA(1, 0, At, B0); PG8_BAR; PG8_SCHED;
            PG8_STAGE(PG8_SB(0, 1), b2 + hstep, voffB);
            PG8_WAIT_V(6); PG8_BAR; PG8_MMA(1, 1, At, B1); PG8_BAR;
            PG8_LDB(B0, 1, 0); PG8_SCHED; PG8_LDA(At, 1, 0); PG8_STAGE(PG8_SA(0, 1), a2 + hstep, voffA);
            PG8_WAIT_L(8); PG8_BAR; PG8_WAIT_L(0); PG8_MMA(0, 0, At, B0); PG8_BAR; PG8_SCHED;
            PG8_LDB(B1, 1, 1); PG8_STAGE(PG8_SB(1, 0), b3, voffB);
            PG8_BAR; PG8_WAIT_L(0); PG8_MMA(0, 1, At, B1); PG8_BAR;
            PG8_LDA(At, 1, 1); PG8_STAGE(PG8_SA(1, 0), a3, voffA);
            PG8_BAR; PG8_WAIT_L(0); PG8_MMA(1, 0, At, B0); PG8_BAR; PG8_SCHED;
            PG8_STAGE(PG8_SB(1, 1), b3 + hstep, voffB);
            PG8_WAIT_V(6); PG8_BAR; PG8_MMA(1, 1, At, B1); PG8_BAR;
            }
        }
        if constexpr (ALIGN_EPI) { if (wr == 0) PG8_BAR; }
        if constexpr (!Epi::AFTER_DRAIN) { E(acc, cur, wr, wc, fr, fq); S.done(cur); }
        if (!has_next) break;
#pragma unroll
        for (int a = 0; a < 2; ++a)
#pragma unroll
            for (int b = 0; b < 2; ++b)
#pragma unroll
                for (int m = 0; m < 4; ++m)
#pragma unroll
                    for (int n = 0; n < 2; ++n) acc[a][b][m][n] = (f32x4){0.f, 0.f, 0.f, 0.f};
        cur = nxt; cA = nA; cB = nB; ++ui;
        if constexpr (ALIGN_EPI) { if (wr == 1) PG8_BAR; }
    }
    PG8_WAIT_V(0);
    if constexpr (!ALIGN_EPI) { if (wr == 0) PG8_BAR; }
    PG8_BAR;
    if constexpr (Epi::AFTER_DRAIN) { E.fused(acc, cur, wr, wc, fr, fq, lds, wid, lane); S.done(cur); }
#undef PG8_SA
#undef PG8_SB
#undef PG8_STAGE
#undef PG8_LDA
#undef PG8_LDB
#undef PG8_MMA
#undef PG8_WAIT_V
#undef PG8_WAIT_L
#undef PG8_BAR
#undef PG8_SCHED
}
}

#ifndef PG8_SP2
#define PG8_SP2 true
#endif
#ifndef PG8_ALIGN
#define PG8_ALIGN true
#endif
namespace attn_body {
using bf16=__hip_bfloat16;
using bf16x8=__attribute__((ext_vector_type(8)))short;
using s16x4=__attribute__((ext_vector_type(4)))short;
using f32x16=__attribute__((ext_vector_type(16)))float;
using u32x4=__attribute__((ext_vector_type(4)))unsigned;
constexpr int BATCH=4,NHEAD=8,SEQ=4096,D=64,DV=128,PIN=3072,POUT=1024;
constexpr int NW=8,QBLK=32,QB=QBLK*NW,KVBLK=64,NQB=SEQ/QB;
constexpr int ATTN_UNIT_ROWS=QB;
__device__ __forceinline__ int crow(int r,int hi){return (r&3)+8*(r>>2)+4*hi;}
#define SBAR() __builtin_amdgcn_sched_barrier(0)
__device__ __forceinline__ void cmask(f32x16&p0,f32x16&p1,int jb,int qrel,int hi){
  const float NEG=-INFINITY; int kb=64*jb+4*hi;
  #pragma unroll
  for(int r=0;r<16;++r){int kv=kb+(r&3)+8*(r>>2); if(kv>qrel)p0[r]=NEG; if(kv+32>qrel)p1[r]=NEG;}
}

constexpr int NSLOT=3, SLOTB=8192;
constexpr int LDS_K=0, LDS_V=NSLOT*SLOTB, LDS_WS=3*NSLOT*SLOTB, LDS_OST=LDS_WS+NW*64*4, LDS_BYTES=LDS_OST+NW*8192;
constexpr float C2=0.125f*1.4426950408889634f;
__device__ __forceinline__ void glds16(const void*gsrc,unsigned lds_dst){unsigned keep;
  asm volatile("s_mov_b32 %0, m0\n\ts_mov_b32 m0, %2\n\ts_nop 0\n\tglobal_load_lds_dwordx4 %1, off\n\ts_mov_b32 m0, %0":"=&s"(keep):"v"(gsrc),"s"(lds_dst):"memory");}
__device__ __forceinline__ float max3f(float a,float b,float c){float r;asm("v_max3_f32 %0, %1, %2, %3":"=v"(r):"v"(a),"v"(b),"v"(c));return r;}
__device__ __forceinline__ float max2f(float a,float b){float r;asm("v_max_f32_e32 %0, %1, %2":"=v"(r):"v"(a),"v"(b));return r;}
__device__ __forceinline__ float fadd_s(float a,float b){float r;asm("v_add_f32_e32 %0, %1, %2":"=v"(r):"v"(a),"v"(b));return r;}
__device__ __forceinline__ float fsub_s(float a,float b){float r;asm("v_sub_f32_e32 %0, %1, %2":"=v"(r):"v"(a),"v"(b));return r;}
typedef float f32x2_t __attribute__((ext_vector_type(2))); typedef __bf16 bf16x2_t __attribute__((ext_vector_type(2)));
__device__ __forceinline__ unsigned cvtpk_s(float lo,float hi){f32x2_t v={lo,hi};bf16x2_t b=__builtin_convertvector(v,bf16x2_t);return __builtin_bit_cast(unsigned,b);}
#define WAIT_BAR(N) asm volatile("s_waitcnt vmcnt(" #N ") lgkmcnt(0)\n\ts_barrier":::"memory")

__device__ __forceinline__ void qkt(f32x16&p0,f32x16&p1,const char*Kslot,const bf16x8*qr,const f32x16&negm,int r32,int hi){
  const char*kb=Kslot+hi*1024+r32*16;
  #pragma unroll
  for(int d0=0;d0<4;++d0){
    const bf16x8 b0=*reinterpret_cast<const bf16x8*>(kb+d0*2048);
    const bf16x8 b1=*reinterpret_cast<const bf16x8*>(kb+d0*2048+512);
    if(d0==0){p0=__builtin_amdgcn_mfma_f32_32x32x16_bf16(b0,qr[0],negm,0,0,0);p1=__builtin_amdgcn_mfma_f32_32x32x16_bf16(b1,qr[0],negm,0,0,0);}
    else{p0=__builtin_amdgcn_mfma_f32_32x32x16_bf16(b0,qr[d0],p0,0,0,0);p1=__builtin_amdgcn_mfma_f32_32x32x16_bf16(b1,qr[d0],p1,0,0,0);}}
}
typedef __attribute__((address_space(3))) const char* lds_cptr;
typedef short v4i16_t __attribute__((ext_vector_type(4)));
__device__ __forceinline__ void kload8(bf16x8*kf,lds_cptr kp){
  kf[0]=*(const __attribute__((address_space(3))) bf16x8*)(kp);      kf[1]=*(const __attribute__((address_space(3))) bf16x8*)(kp+512);
  kf[2]=*(const __attribute__((address_space(3))) bf16x8*)(kp+2048); kf[3]=*(const __attribute__((address_space(3))) bf16x8*)(kp+2560);
  kf[4]=*(const __attribute__((address_space(3))) bf16x8*)(kp+4096); kf[5]=*(const __attribute__((address_space(3))) bf16x8*)(kp+4608);
  kf[6]=*(const __attribute__((address_space(3))) bf16x8*)(kp+6144); kf[7]=*(const __attribute__((address_space(3))) bf16x8*)(kp+6656);
}
__device__ __forceinline__ void kload2(bf16x8*kf,lds_cptr kp,int j){ kf[2*j]=*(const __attribute__((address_space(3))) bf16x8*)(kp+j*2048); kf[2*j+1]=*(const __attribute__((address_space(3))) bf16x8*)(kp+j*2048+512); }
__device__ __forceinline__ s16x4 vtr(lds_cptr p){ return __builtin_bit_cast(s16x4,__builtin_amdgcn_ds_read_tr16_b64_v4i16((__attribute__((address_space(3))) v4i16_t*)p)); }
__device__ __forceinline__ float rowmax(const f32x16&p0,const f32x16&p1){
  float a=max3f(p0[0],p0[1],p1[0]),b=max3f(p0[2],p0[3],p1[1]);a=max3f(a,p1[2],p1[3]);
  #pragma unroll
  for(int r=4;r<16;r+=4){a=max3f(a,p0[r],p0[r+1]);b=max3f(b,p0[r+2],p0[r+3]);a=max3f(a,p1[r],p1[r+1]);b=max3f(b,p1[r+2],p1[r+3]);}
  const float m=max2f(a,b);
  auto rr=__builtin_amdgcn_permlane32_swap(__float_as_uint(m),__float_as_uint(m),false,false);
  return max2f(__uint_as_float(rr[0]),__uint_as_float(rr[1]));
}
__device__ __forceinline__ void pv(f32x16*o,int vb,bf16x8 pa0,bf16x8 pa1,bf16x8 pa2,bf16x8 pa3){
  #pragma unroll
  for(int d0=0;d0<4;++d0){s16x4 lo[4],hi[4];
    #pragma unroll
    for(int ks=0;ks<4;++ks){
      asm volatile("ds_read_b64_tr_b16 %0,%1 offset:%c2":"=&v"(lo[ks]):"v"(vb),"i"(d0*4096+ks*1024):"memory");
      asm volatile("ds_read_b64_tr_b16 %0,%1 offset:%c2":"=&v"(hi[ks]):"v"(vb),"i"(d0*4096+ks*1024+512):"memory");}
    asm volatile("s_waitcnt lgkmcnt(0)":::"memory");SBAR();
    #define PK(k) (bf16x8){lo[k][0],lo[k][1],lo[k][2],lo[k][3],hi[k][0],hi[k][1],hi[k][2],hi[k][3]}
    o[d0]=__builtin_amdgcn_mfma_f32_32x32x16_bf16(pa0,PK(0),o[d0],0,0,0);
    o[d0]=__builtin_amdgcn_mfma_f32_32x32x16_bf16(pa1,PK(1),o[d0],0,0,0);
    o[d0]=__builtin_amdgcn_mfma_f32_32x32x16_bf16(pa2,PK(2),o[d0],0,0,0);
    o[d0]=__builtin_amdgcn_mfma_f32_32x32x16_bf16(pa3,PK(3),o[d0],0,0,0);
    #undef PK
  }
}

#ifndef ATTN_STORE16
#define ATTN_STORE16(p,v) (*(u32x4*)(p)=(v))
#endif
template<int THRL> __device__ __forceinline__ void attn_unit(int b,int vh,int qb,const bf16*P,bf16*O,char*shm){
  int tid_=threadIdx.x; asm volatile("":"+v"(tid_)); const int tid=tid_,lane=tid&63,r32=lane&31,hi=lane>>5; const int wid=__builtin_amdgcn_readfirstlane(tid>>6);
  const long rowbase=(long)b*SEQ; const int q0=qb*QB;
  const bf16*Qw=P+(rowbase+q0+wid*QBLK)*PIN+vh*D;
  const bf16*Kh=P+rowbase*PIN+512+vh*D,*Vh=P+rowbase*PIN+1024+(vh>>1)*DV;
  const unsigned lds0=(unsigned)(uintptr_t)shm;
  float*wsf=(float*)(shm+LDS_WS)+wid*64;
  const bf16*ksrc=Kh+(long)lane*PIN+wid*8;
  const bf16*vsrc=Vh+(long)(16*(wid&3)+(lane>>2))*PIN+(wid>>2)*32+(lane&3)*8;
  const unsigned kdst=lds0+LDS_K+wid*1024, vdst=lds0+LDS_V+wid*1024;
  #define DMA_K(t,slot) glds16(ksrc+(long)(t)*KVBLK*PIN,(unsigned)__builtin_amdgcn_readfirstlane(kdst+(slot)))
  #define DMA_V(t,slot) do{ glds16(vsrc+(long)(t)*KVBLK*PIN,(unsigned)__builtin_amdgcn_readfirstlane(vdst+2*(slot))); glds16(vsrc+(long)(t)*KVBLK*PIN+64,(unsigned)__builtin_amdgcn_readfirstlane(vdst+2*(slot)+8192)); }while(0)
  const int vb0=(int)(lds0+LDS_V)+((lane>>4)&1)*32+(lane&3)*8+(4*hi+((lane&15)>>2))*64;
  const char*Kbase=shm+LDS_K; bf16x8 kf[8];
  const lds_cptr shm3=(lds_cptr)shm; const lds_cptr kp0=shm3+LDS_K+hi*1024+r32*16; const lds_cptr vp0=shm3+LDS_V+((lane>>4)&1)*32+(lane&3)*8+(4*hi+((lane&15)>>2))*64;
  const int NT=(q0+QB)/KVBLK;
  DMA_K(0,0);DMA_V(0,0);DMA_K(1,SLOTB);
  bf16x8 qr[4];
  #pragma unroll
  for(int d0=0;d0<4;++d0)qr[d0]=*reinterpret_cast<const bf16x8*>(&Qw[(long)r32*PIN+d0*16+hi*8]);
  float mhat=0.f,l_reg=0.f;f32x16 o[4];o[0]=f32x16{};o[1]=f32x16{};o[2]=f32x16{};o[3]=f32x16{};f32x16 negm;{float nz_=0.f;asm volatile("":"+v"(nz_));_Pragma("unroll") for(int r=0;r<16;++r)negm[r]=nz_;}asm volatile("":"+v"(negm));
  const int qrel=wid*QBLK+r32;
  #define CMASK(P0,P1,t) do{int jb_=(t)-(NT-4); if(jb_>=0)cmask(P0,P1,jb_,qrel,hi);}while(0)
  bool resc=false;
  #define START(P0,P1) do{ const float rm=rowmax(P0,P1); resc=false; \
    { const float dl=rm; mhat=fadd_s(mhat,dl); \
      _Pragma("unroll") for(int r=0;r<16;++r){P0[r]=fsub_s(P0[r],dl);P1[r]=fsub_s(P1[r],dl);} \
      _Pragma("unroll") for(int r=0;r<16;++r)negm[r]=-mhat; asm volatile("":"+v"(negm)); } \
    _Pragma("unroll") for(int r=0;r<16;++r)P0[r]=__builtin_amdgcn_exp2f(P0[r]); }while(0)
  #define RESC() do{ if(resc){ asm volatile("s_waitcnt lgkmcnt(0)":::"memory"); \
      _Pragma("unroll") for(int d_=0;d_<4;++d_) _Pragma("unroll") for(int r=0;r<16;++r)o[d_][r]*=wsf[crow(r,hi)]; } }while(0)
  f32x16 pA0,pA1,pB0,pB1;
  int sl_prev=0,sl_cur=0,sl_next=SLOTB;
  #define ROT() do{sl_prev=sl_cur;sl_cur=sl_next;sl_next=(sl_next==(NSLOT-1)*SLOTB)?0:sl_next+SLOTB;}while(0)
  DMA_K(2,2*SLOTB);
  WAIT_BAR(3);
  qkt(pA0,pA1,Kbase,qr,negm,r32,hi);asm volatile("s_nop 15\n\ts_nop 7":"+v"(pA0),"+v"(pA1));CMASK(pA0,pA1,0);
  START(pA0,pA1);
  _Pragma("unroll") for(int r=0;r<16;++r)pA1[r]=__builtin_amdgcn_exp2f(pA1[r]);
  WAIT_BAR(0);
  DMA_K(3,0);DMA_V(1,SLOTB);
  ROT();
  kload8(kf,kp0+sl_cur);
  WAIT_BAR(3);
  s16x4 vlo[4],vhi[4]; u32x4 pw0,pw1,pw2,pw3;
  #define PKW(P,B) cvtpk_s(P[B],P[B+1])
  #define PAF(k) __builtin_bit_cast(bf16x8,pw##k)
  #define VFR(i) (bf16x8){vlo[i][0],vlo[i][1],vlo[i][2],vlo[i][3],vhi[i][0],vhi[i][1],vhi[i][2],vhi[i][3]}
  #define PIN(x) asm volatile("":"+v"(x))
  #define MX3(a,b,c) __builtin_fmaxf(__builtin_fmaxf((a),(b)),(c))
  #define GAPA(MF,A0,A1,A2,A3,W0,W1,PW) do{ MF; sacc+=A0; sacc+=A1; sacc+=A2; sacc+=A3; PIN(sacc); W0; W1; PIN(PW); SBAR(); }while(0)
  #define EX(v) __builtin_amdgcn_exp2f(v)
  #define VRD(dq,ks) do{ vlo[dq]=vtr(vp_+((dq)*4096+(ks)*1024)); vhi[dq]=vtr(vp_+((dq)*4096+(ks)*1024+512)); }while(0)
  #define GAPB(DQ,KS,X,B) do{ o[DQ]=__builtin_amdgcn_mfma_f32_32x32x16_bf16(PAF(KS),VFR(DQ),o[DQ],0,0,0); if((KS)<3){ VRD(DQ,(KS)+1); } X[B]=EX(X[B]); X[B+1]=EX(X[B+1]); PIN(X); SBAR(); }while(0)
  #define KRD(G,j) do{ if(G){ kload2(kf,kp0+sl_next,j); SBAR(); } }while(0)
  #define STEP(C0,C1,P0,P1,t,GK,GV,GL) do{ SBAR(); \
    const lds_cptr vp_=vp0+2*sl_prev; \
    float sacc=(P0[0]+P0[1]); \
    GAPA(C0=__builtin_amdgcn_mfma_f32_32x32x16_bf16(kf[0],qr[0],negm,0,0,0), P0[2],P0[3],P0[4],P0[5],     pw0[0]=PKW(P0,0), pw0[1]=PKW(P0,2), pw0); \
    GAPA(C1=__builtin_amdgcn_mfma_f32_32x32x16_bf16(kf[1],qr[0],negm,0,0,0), P0[6],P0[7],P0[8],P0[9],     pw0[2]=PKW(P0,4), pw0[3]=PKW(P0,6), pw0); \
    GAPA(C0=__builtin_amdgcn_mfma_f32_32x32x16_bf16(kf[2],qr[1],C0,0,0,0),   P0[10],P0[11],P0[12],P0[13], pw1[0]=PKW(P0,8), pw1[1]=PKW(P0,10), pw1); \
    GAPA(C1=__builtin_amdgcn_mfma_f32_32x32x16_bf16(kf[3],qr[1],C1,0,0,0),   P0[14],P0[15],P1[0],P1[1],   pw1[2]=PKW(P0,12),pw1[3]=PKW(P0,14), pw1); \
    VRD(0,0); SBAR(); GAPA(C0=__builtin_amdgcn_mfma_f32_32x32x16_bf16(kf[4],qr[2],C0,0,0,0),   P1[2],P1[3],P1[4],P1[5],     pw2[0]=PKW(P1,0), pw2[1]=PKW(P1,2), pw2); \
    VRD(1,0); SBAR(); GAPA(C1=__builtin_amdgcn_mfma_f32_32x32x16_bf16(kf[5],qr[2],C1,0,0,0),   P1[6],P1[7],P1[8],P1[9],     pw2[2]=PKW(P1,4), pw2[3]=PKW(P1,6), pw2); \
    VRD(2,0); SBAR(); GAPA(C0=__builtin_amdgcn_mfma_f32_32x32x16_bf16(kf[6],qr[3],C0,0,0,0),   P1[10],P1[11],P1[12],P1[13], pw3[0]=PKW(P1,8), pw3[1]=PKW(P1,10), pw3); \
    VRD(3,0); SBAR(); GAPA(C1=__builtin_amdgcn_mfma_f32_32x32x16_bf16(kf[7],qr[3],C1,0,0,0),   P1[14],P1[15],0.f,0.f,       pw3[2]=PKW(P1,12),pw3[3]=PKW(P1,14), pw3); \
    l_reg+=sacc; \
    if(GK){DMA_K((t)+3,sl_cur);} if(GV){DMA_V((t)+1,sl_next);} \
    CMASK(C0,C1,t); \
    { float a=MX3(C0[0],C0[1],C1[0]),b=MX3(C0[2],C0[3],C1[1]); a=MX3(a,C1[2],C1[3]); \
      _Pragma("unroll") for(int r=4;r<16;r+=4){a=MX3(a,C0[r],C0[r+1]);b=MX3(b,C0[r+2],C0[r+3]);a=MX3(a,C1[r],C1[r+1]);b=MX3(b,C1[r+2],C1[r+3]);} \
      float rm=__builtin_fmaxf(a,b); { auto rr=__builtin_amdgcn_permlane32_swap(__float_as_uint(rm),__float_as_uint(rm),false,false); rm=__builtin_fmaxf(__uint_as_float(rr[0]),__uint_as_float(rr[1])); } \
      resc=false; \
      if(__builtin_expect(__any(rm>(float)THRL),0)){ const float dl=__builtin_fmaxf(rm,0.f); mhat+=dl; \
        _Pragma("unroll") for(int r=0;r<16;++r){C0[r]-=dl;C1[r]-=dl;} \
        _Pragma("unroll") for(int r=0;r<16;++r)negm[r]=-mhat; asm volatile("":"+v"(negm)); \
        const float f=__builtin_amdgcn_exp2f(-dl); l_reg*=f; if(hi==0)wsf[r32]=f; resc=true; } } \
    SBAR(); \
    GAPB(0,0,C0,0);  GAPB(1,0,C0,2);  GAPB(2,0,C0,4);  GAPB(3,0,C0,6); \
    KRD(GL,0); GAPB(0,1,C0,8);  GAPB(1,1,C0,10); KRD(GL,1); GAPB(2,1,C0,12); GAPB(3,1,C0,14); \
    KRD(GL,2); GAPB(0,2,C1,0);  GAPB(1,2,C1,2);  KRD(GL,3); GAPB(2,2,C1,4);  GAPB(3,2,C1,6); \
    GAPB(0,3,C1,8);  GAPB(1,3,C1,10); GAPB(2,3,C1,12); GAPB(3,3,C1,14); \
    }while(0)
  int t=1;
  #undef CMASK
  #define CMASK(P0,P1,t) do{}while(0)
  for(;t+5<NT;t+=2){
    STEP(pB0,pB1,pA0,pA1,t,true,true,true);     WAIT_BAR(3); RESC(); ROT();
    STEP(pA0,pA1,pB0,pB1,t+1,true,true,true);   WAIT_BAR(3); RESC(); ROT();
  }
  #undef CMASK
  #define CMASK(P0,P1,t) do{int jb_=(t)-(NT-4); if(jb_>=0)cmask(P0,P1,jb_,qrel,hi);}while(0)
  #define ENDW(tt) do{ if((tt)+3<NT){WAIT_BAR(3);} else if((tt)+2<NT){WAIT_BAR(2);} else {WAIT_BAR(0);} }while(0)
  for(;t+1<NT;t+=2){
    STEP(pB0,pB1,pA0,pA1,t,(t+3<NT),(t+1<NT),(t+1<NT));       ENDW(t);   RESC(); ROT();
    STEP(pA0,pA1,pB0,pB1,t+1,(t+4<NT),(t+2<NT),(t+2<NT));     ENDW(t+1); RESC(); ROT();
  }
  STEP(pB0,pB1,pA0,pA1,NT-1,false,false,false); RESC();
  { float sacc=pB0[0]+pB0[1]; _Pragma("unroll") for(int r=2;r<16;++r)sacc+=pB0[r]; _Pragma("unroll") for(int r=0;r<16;++r)sacc+=pB1[r]; l_reg+=sacc;
    pw0=(u32x4){PKW(pB0,0),PKW(pB0,2),PKW(pB0,4),PKW(pB0,6)};pw1=(u32x4){PKW(pB0,8),PKW(pB0,10),PKW(pB0,12),PKW(pB0,14)};pw2=(u32x4){PKW(pB1,0),PKW(pB1,2),PKW(pB1,4),PKW(pB1,6)};pw3=(u32x4){PKW(pB1,8),PKW(pB1,10),PKW(pB1,12),PKW(pB1,14)};
    SBAR(); pv(o,vb0+2*sl_cur,PAF(0),PAF(1),PAF(2),PAF(3)); }
  #undef PKW
  #undef PAF
  #undef VFR
  #undef PIN
  #undef MX3
  #undef GAPA
  #undef GAPB
  #undef EX
  #undef VRD
  #undef KRD
  #undef STEP
  #undef ENDW
  {auto rr=__builtin_amdgcn_permlane32_swap(__float_as_uint(l_reg),__float_as_uint(l_reg),false,false);l_reg=__uint_as_float(rr[0])+__uint_as_float(rr[1]);}
  if(hi==0)wsf[32+r32]=l_reg;asm volatile("s_waitcnt lgkmcnt(0)":::"memory");
  float rli[16];
  #pragma unroll
  for(int r=0;r<16;++r)rli[r]=__builtin_amdgcn_rcpf(wsf[32+crow(r,hi)]);
  bf16*Ow=O+(rowbase+q0+wid*QBLK)*POUT+vh*DV;
  { bf16*stg=(bf16*)(shm+LDS_OST)+wid*4096;
    #pragma unroll
    for(int r=0;r<16;++r){const int orow=crow(r,hi);
      #pragma unroll
      for(int d0=0;d0<4;++d0)stg[orow*128+d0*32+r32]=__float2bfloat16(o[d0][r]*rli[r]);}
    asm volatile("s_waitcnt lgkmcnt(0)":::"memory");
    #pragma unroll
    for(int i=0;i<8;++i){const int row=i*4+(lane>>4),ch=lane&15; const u32x4 v=*(const u32x4*)(stg+row*128+ch*8); ATTN_STORE16(Ow+(long)row*POUT+ch*8,v);} }
  asm volatile("s_waitcnt lgkmcnt(0)\n\ts_barrier":::"memory");
  #undef DMA_K
  #undef DMA_V
  #undef CMASK
  #undef START
  #undef RESC
  #undef ROT
}
constexpr int ATTN_LDS_BYTES=LDS_BYTES;
struct AttnUnit { int bh; int qb; };
struct StaticOrder {
  int vcu;
  __device__ __forceinline__ explicit StaticOrder(int grid,int block):vcu((block%8)*(grid/8)+block/8){}
  __device__ __forceinline__ bool next(int i,AttnUnit&u)const{ if(i>=2)return false; const int s=vcu&7; u.bh=vcu>>3; u.qb=(i==0)?15-s:s; return true; }
};
template<class Sched,int THRL=8> __device__ __forceinline__ void attn_phase(char*lds,const bf16*P,bf16*O,const Sched&S){
  AttnUnit u;
  for(int i=0;S.next(i,u);++i){ attn_unit<THRL>(u.bh/NHEAD,u.bh%NHEAD,u.qb,P,O,lds); }
}
#undef SBAR
#undef WAIT_BAR
}
constexpr int NWAVES = 8;
constexpr int NB = 4, SEQ = 4096, D = 1024, T = NB * SEQ, NPROJ = 3072, NE = 256, FF = 256, KSEL = 8, NSLOT9 = 9;
constexpr float NORM_EPS = 1e-6f;
constexpr size_t MiB = 1u << 20;
constexpr size_t WS_CTL = 0, CTL_ZERO_BYTES = 65536;
constexpr size_t WS_MOD = 1 * MiB;
constexpr size_t WS_COS = 2 * MiB, WS_SIN = 4 * MiB;
constexpr size_t WS_WIN = 6 * MiB, WS_WOUT = 12 * MiB, WS_WR = 14 * MiB;
constexpr size_t WS_XN = 16 * MiB;
constexpr size_t WS_PROJ = 48 * MiB;
constexpr size_t WS_SVT = 144 * MiB;
constexpr size_t WS_ORAW = 160 * MiB;
constexpr size_t WS_MIXED = 192 * MiB;
constexpr size_t WS_R = 224 * MiB;
constexpr size_t WS_LTOK = 304 * MiB, WS_LW = 321 * MiB;
constexpr size_t WS_H2 = 338 * MiB;
constexpr size_t WS_ACT = 372 * MiB;
constexpr size_t WS_Y = 416 * MiB;
constexpr size_t WS_END = WS_Y + (size_t)T * NSLOT9 * D * 2;
constexpr int CW_QUEUE = 8192;
constexpr int CW_COUNT = 1024;
constexpr int CW_BAR = 4096;
constexpr int RING_OFF = 0, RING_BYTES = 151552;
constexpr int LDSCTL_OFF = RING_BYTES, MISC_OFF = LDSCTL_OFF + 320;
constexpr int LDS_BYTES = 152576;
static_assert(MISC_OFF + 128 <= LDS_BYTES, "LDS map");

#define GAS __attribute__((address_space(1)))
#define LAS __attribute__((address_space(3)))
typedef unsigned short bf16;
typedef unsigned v4u __attribute__((ext_vector_type(4)));
typedef unsigned v2u __attribute__((ext_vector_type(2)));
typedef float f32x4 __attribute__((ext_vector_type(4)));
typedef float f32x16 __attribute__((ext_vector_type(16)));
typedef short bf16x8 __attribute__((ext_vector_type(8)));
typedef GAS unsigned gu32;
#define RLX_AGENT __ATOMIC_RELAXED, __HIP_MEMORY_SCOPE_AGENT
#define LDS_WAIT() asm volatile("s_waitcnt lgkmcnt(0)" ::: "memory")
#define VM_WAIT() asm volatile("s_waitcnt vmcnt(0)" ::: "memory")
__device__ __forceinline__ unsigned pk2(float lo, float hi) { return pg8::cvt_pk_bf16(lo, hi); }
__device__ __forceinline__ float bflo(unsigned w) { return __uint_as_float(w << 16); }
__device__ __forceinline__ float bfhi(unsigned w) { return __uint_as_float(w & 0xffff0000u); }

#define XB_TMO      128
#define XB_XCNT(j)  (256  + 64 * (j))
#define XB_XSUB(j)  (1280 + 64 * (j))
#define XB_XGEN(j)  (2304 + 64 * (j))
#define XB_TOP      3328
#define XB_TOPGEN   3392
#define XCD_BAR_WORDS 3456
#define XB_SPIN_CAP (1u << 18)

__device__ __forceinline__ unsigned xb_ld(unsigned* p)              { return __hip_atomic_load(p, __ATOMIC_RELAXED, __HIP_MEMORY_SCOPE_AGENT); }
__device__ __forceinline__ unsigned xb_add(unsigned* p, unsigned v) { return __hip_atomic_fetch_add(p, v, __ATOMIC_RELAXED, __HIP_MEMORY_SCOPE_AGENT); }
__device__ __forceinline__ unsigned xb_xcc_id() { return (unsigned)__builtin_amdgcn_s_getreg((3 << 11) | 20) & 0xFu; }
#define XB_SPIN(cond, bar) do { unsigned _sp = 0; while (cond) { __builtin_amdgcn_s_sleep(1); \
    if ((++_sp & 255u) == 0u) { if (xb_ld(&(bar)[XB_TMO])) break; if (_sp > XB_SPIN_CAP) { atomicAdd(&(bar)[XB_TMO], 1u); break; } } } } while (0)

struct XcdBarrier {
    unsigned* bar; unsigned x;
    volatile LAS unsigned* st;
};

__device__ __forceinline__ XcdBarrier xcd_barrier_post(unsigned* bar, volatile LAS unsigned* st) {
    XcdBarrier b; b.bar = bar; b.x = xb_xcc_id(); b.st = st;
    if (threadIdx.x == 0) (void)xb_add(&bar[XB_XCNT(b.x)], 1u);
    return b;
}
__device__ __forceinline__ void xcd_barrier_complete(unsigned* bar, unsigned x, unsigned& nloc, unsigned& nx) {
    const unsigned G = gridDim.x * gridDim.y * gridDim.z;
    unsigned sum, cnt, mine, sp = 0u;
    for (;;) {
        sum = 0u; cnt = 0u; mine = 0u;
#pragma unroll
        for (unsigned j = 0; j < 16; ++j) { const unsigned c = xb_ld(&bar[XB_XCNT(j)]); sum += c; cnt += (c > 0u) ? 1u : 0u; mine = (j == x) ? c : mine; }
        if (sum == G) break;
        __builtin_amdgcn_s_sleep(1);
        if ((++sp & 255u) == 0u) { if (xb_ld(&bar[XB_TMO])) break; if (sp > XB_SPIN_CAP) { atomicAdd(&bar[XB_TMO], 1u); break; } }
    }
    nloc = mine > 0u ? mine : 1u; nx = cnt > 0u ? cnt : 1u;
}

__device__ __forceinline__ void xcd_barrier(const XcdBarrier& b) {
    asm volatile("s_waitcnt vmcnt(0)" ::: "memory");
    __syncthreads();
    if (threadIdx.x == 0) {
        unsigned* bar = b.bar;
        __builtin_amdgcn_s_waitcnt(0);
        unsigned nloc = b.st[0], nx = b.st[1];
        if (nloc == 0u) { xcd_barrier_complete(bar, b.x, nloc, nx); b.st[0] = nloc; b.st[1] = nx; }
        const unsigned old = xb_add(&bar[XB_XSUB(b.x)], 1u);
        const unsigned gen = old / nloc;
        if (old + 1u == (gen + 1u) * nloc) {
            __builtin_amdgcn_fence(__ATOMIC_RELEASE, "agent");
            asm volatile("s_waitcnt vmcnt(0)" ::: "memory");
            const unsigned og = xb_add(&bar[XB_TOP], 1u);
            const unsigned tg = og / nx;
            if (og + 1u == (tg + 1u) * nx) xb_add(&bar[XB_TOPGEN], 1u);
            else XB_SPIN(xb_ld(&bar[XB_TOPGEN]) == tg, bar);
            __builtin_amdgcn_fence(__ATOMIC_ACQUIRE, "agent");
            xb_add(&bar[XB_XGEN(b.x)], 1u);
            asm volatile("s_waitcnt vmcnt(0)" ::: "memory");
        } else {
            XB_SPIN(xb_ld(&bar[XB_XGEN(b.x)]) == gen, bar);
            __builtin_amdgcn_fence(__ATOMIC_ACQUIRE, "agent");
            asm volatile("s_waitcnt vmcnt(0)" ::: "memory");
        }
    }
    __syncthreads();
}


struct Frame {
    LAS unsigned char* lds;
    volatile LAS unsigned* MISC;
    unsigned* ctl;
    int tid, lane, wave;
    int vcu, G;
    const float *x, *c, *w_ada, *b_ada, *g_mix, *w_in, *g_q, *g_k, *lam, *g_sub, *w_out, *g_ffn, *w_router, *e_bias, *w_sh_gu, *w_sh_down, *w_gu, *w_down;
    const int* positions;
    float* out;
    float *MOD, *RCOS, *RSIN, *LW;
    bf16 *WIN, *WOUT, *WR, *XN, *PROJ, *SVT, *ORAW, *MIXED, *H2, *Y, *ACT, *DLT;
    unsigned* LTOK;
};
__device__ __forceinline__ float wave_sum(float v) {
#pragma unroll
    for (int o = 1; o < 64; o <<= 1) v += __shfl_xor(v, o);
    return v;
}
__device__ __forceinline__ float wave_max(float v) {
#pragma unroll
    for (int o = 1; o < 64; o <<= 1) v = fmaxf(v, __shfl_xor(v, o));
    return v;
}
__device__ __forceinline__ void p0_transpose_item(const float* W, int K, int N, bf16* WT, int k0, int n0, int dst_row0, LAS float* scr, int lane) {
#pragma unroll 8
    for (int i = 0; i < 32; ++i) { const int kk = 2 * i + (lane >> 5); scr[kk * 33 + (lane & 31)] = W[(size_t)(k0 + kk) * N + n0 + (lane & 31)]; }
    LDS_WAIT(); asm volatile("" ::: "memory");
    const int c = lane & 7;
#pragma unroll
    for (int j = 0; j < 4; ++j) { const int n = (lane >> 3) + 8 * j; const LAS float* s = scr + (8 * c) * 33 + n;
        v4u o; o.x = pk2(s[0 * 33], s[1 * 33]); o.y = pk2(s[2 * 33], s[3 * 33]); o.z = pk2(s[4 * 33], s[5 * 33]); o.w = pk2(s[6 * 33], s[7 * 33]);
        *(GAS v4u*)(WT + (size_t)(dst_row0 + n) * K + k0 + 8 * c) = o; }
    LDS_WAIT(); asm volatile("" ::: "memory");
}
__device__ __forceinline__ void p0_prologue(Frame& F) {
    LAS float* sc = (LAS float*)(F.lds + RING_OFF);
    LAS float* red = (LAS float*)(F.lds + RING_OFF + 16384);
    if (F.vcu < 192) {
        for (int i = F.tid; i < NB * D; i += NWAVES * 64) { const float v = F.c[i]; sc[i] = v / (1.0f + __expf(-v)); }
        __syncthreads();
        const int kr = F.lane >> 3, ch = F.lane & 7, n0 = 32 * F.vcu + 4 * ch;
        float a[4][4];
#pragma unroll
        for (int b = 0; b < 4; ++b)
#pragma unroll
            for (int j = 0; j < 4; ++j) a[b][j] = 0.f;
#pragma unroll 4
        for (int it = 0; it < 16; ++it) { const int k = 128 * F.wave + 8 * it + kr; const f32x4 wv = *(const f32x4*)(F.w_ada + (size_t)k * 6144 + n0);
#pragma unroll
            for (int b = 0; b < 4; ++b) { const float s = sc[b * D + k];
#pragma unroll
                for (int j = 0; j < 4; ++j) a[b][j] += s * wv[j]; } }
#pragma unroll
        for (int b = 0; b < 4; ++b)
#pragma unroll
            for (int j = 0; j < 4; ++j) { float v = a[b][j]; v += __shfl_xor(v, 8); v += __shfl_xor(v, 16); v += __shfl_xor(v, 32); a[b][j] = v; }
        if (kr == 0) {
#pragma unroll
            for (int b = 0; b < 4; ++b)
#pragma unroll
                for (int j = 0; j < 4; ++j) red[(F.wave * 4 + b) * 32 + 4 * ch + j] = a[b][j]; }
        __syncthreads();
        if (F.tid < 128) { const int b = F.tid >> 5, col = F.tid & 31; float s = F.b_ada[32 * F.vcu + col];
#pragma unroll
            for (int w = 0; w < 8; ++w) s += red[(w * 4 + b) * 32 + col];
            F.MOD[b * 6144 + 32 * F.vcu + col] = s; }
        __syncthreads();
    }
    LAS float* scr = (LAS float*)(F.lds + RING_OFF + 32768 + F.wave * 9216);
    const int gw = F.vcu * NWAVES + F.wave, NGW = F.G * NWAVES;
    constexpr int I_IN = (D / 64) * (NPROJ / 32), I_OUT = (D / 64) * (D / 32), I_R = (D / 64) * (NE / 32);
    for (int it = gw; it < I_IN + I_OUT + I_R; it += NGW) {
        int r = it;
        if (r < I_IN) { const int nblk = NPROJ / 32, kb = r / nblk, nb = r % nblk, n0 = 32 * nb;
            const int cl = n0 & 255, dst = (n0 & ~255) + 128 * ((cl >> 5) & 1) + 32 * (cl >> 6);
            p0_transpose_item(F.w_in, D, NPROJ, F.WIN, 64 * kb, n0, dst, scr, F.lane); continue; }
        r -= I_IN;
        if (r < I_OUT) { const int nblk = D / 32, kb = r / nblk, nb = r % nblk; p0_transpose_item(F.w_out, D, D, F.WOUT, 64 * kb, 32 * nb, 32 * nb, scr, F.lane); continue; }
        r -= I_OUT;
        { const int nblk = NE / 32, kb = r / nblk, nb = r % nblk; p0_transpose_item(F.w_router, D, NE, F.WR, 64 * kb, 32 * nb, 32 * nb, scr, F.lane); }
    }
    for (int idx = (int)blockIdx.x * (NWAVES * 64) + F.tid; idx < T * 32; idx += F.G * NWAVES * 64) {
        const int t = idx >> 5, i = idx & 31;
        const float inv = exp2f(-(float)i * (13.287712379549449f / 32.0f));
        const float ang = (float)F.positions[t] * inv;
        F.RCOS[idx] = cosf(ang); F.RSIN[idx] = sinf(ang);
    }
}
__device__ __forceinline__ void rows_adaln(Frame& F, const float* src, const float* g, const float* shift, const float* scale, bf16* dst) {
    const int gw = F.vcu * NWAVES + F.wave, NGW = F.G * NWAVES;
    for (int m = gw; m < T; m += NGW) {
        const int b = m >> 12;
        const GAS f32x4* xr = (const GAS f32x4*)(src + (size_t)m * D) + F.lane;
        f32x4 v[4]; float s2 = 0.f;
#pragma unroll
        for (int j = 0; j < 4; ++j) { v[j] = xr[64 * j]; s2 += (v[j].x * v[j].x + v[j].y * v[j].y) + (v[j].z * v[j].z + v[j].w * v[j].w); }
        const float rstd = 1.f / sqrtf(wave_sum(s2) * (1.f / D) + NORM_EPS);
        GAS v2u* o8 = (GAS v2u*)(dst + (size_t)m * D) + F.lane;
#pragma unroll
        for (int j = 0; j < 4; ++j) { const int c = 4 * F.lane + 256 * j;
            const f32x4 gv = *(const f32x4*)(g + c), sh = *(const f32x4*)(shift + b * 6144 + c), sc = *(const f32x4*)(scale + b * 6144 + c);
            const f32x4 y = v[j] * rstd * gv * (sc + 1.0f) + sh;
            v2u w; w.x = pk2(y.x, y.y); w.y = pk2(y.z, y.w); o8[64 * j] = w; }
    }
}
constexpr float SB_EXIT_LOG2 = 48.0f;
__device__ __forceinline__ int crow16(int r, int h) { return (r & 3) + 8 * (r >> 2) + 4 * h; }
__device__ __forceinline__ void sb_wave_tile(const bf16* PROJ, const bf16* SVT, bf16* MIXED, int b, int hd, int qt, int lane) {
    const int r32 = lane & 31, hi = lane >> 5;
    const bf16* Qp = PROJ + (size_t)(b * SEQ + 32 * qt + r32) * NPROJ + 1536 + hd * 64 + 8 * hi;
    bf16x8 qf[4];
#pragma unroll
    for (int s = 0; s < 4; ++s) qf[s] = *(const bf16x8*)(Qp + 16 * s);
    bf16x8 tf[2];
#pragma unroll
    for (int s = 0; s < 2; ++s)
#pragma unroll
        for (int j = 0; j < 8; ++j) tf[s][j] = (16 * s + 8 * (j >> 2) + 4 * hi + (j & 3)) >= r32 ? (short)0x3F80 : (short)0;
    f32x16 oT[2];
#pragma unroll
    for (int i = 0; i < 16; ++i) { oT[0][i] = 0.f; oT[1][i] = 0.f; }
    float R = 0.f;
    const bf16* Kb = PROJ + (size_t)(b * SEQ + r32) * NPROJ + 2048 + hd * 64 + 8 * hi;
    const bf16* Vb = SVT + ((size_t)(b * 8 + hd) * 64 + r32) * SEQ + 4 * hi;
    for (int kt = qt; kt >= 0; --kt) {
        const bf16* Kp = Kb + (size_t)(32 * kt) * NPROJ;
        bf16x8 kf[4];
#pragma unroll
        for (int s = 0; s < 4; ++s) kf[s] = *(const bf16x8*)(Kp + 16 * s);
        v2u vlo[2][2], vhi[2][2];
#pragma unroll
        for (int dt = 0; dt < 2; ++dt)
#pragma unroll
            for (int s = 0; s < 2; ++s) { const bf16* vp = Vb + (size_t)(32 * dt) * SEQ + 32 * kt + 16 * s; vlo[dt][s] = *(const v2u*)vp; vhi[dt][s] = *(const v2u*)(vp + 8); }
        f32x16 z;
#pragma unroll
        for (int i = 0; i < 16; ++i) z[i] = 0.f;
#pragma unroll
        for (int s = 0; s < 4; ++s) z = __builtin_amdgcn_mfma_f32_32x32x16_bf16(kf[s], qf[s], z, 0, 0, 0);
        const bool diag = (kt == qt);
        float sp[16];
#pragma unroll
        for (int i = 0; i < 16; ++i) { const float zz = z[i]; float v = fmaxf(zz, 0.f) + __builtin_amdgcn_logf(1.0f + __builtin_amdgcn_exp2f(-fabsf(zz)));
            if (diag && crow16(i, hi) >= r32) v = 0.f; sp[i] = v; }
        v4u p0, p1; p0.x = pk2(sp[0], sp[1]); p0.y = pk2(sp[2], sp[3]); p0.z = pk2(sp[4], sp[5]); p0.w = pk2(sp[6], sp[7]);
        p1.x = pk2(sp[8], sp[9]); p1.y = pk2(sp[10], sp[11]); p1.z = pk2(sp[12], sp[13]); p1.w = pk2(sp[14], sp[15]);
        f32x16 cs;
#pragma unroll
        for (int i = 0; i < 16; ++i) cs[i] = R;
        cs = __builtin_amdgcn_mfma_f32_32x32x16_bf16(tf[0], __builtin_bit_cast(bf16x8, p0), cs, 0, 0, 0);
        cs = __builtin_amdgcn_mfma_f32_32x32x16_bf16(tf[1], __builtin_bit_cast(bf16x8, p1), cs, 0, 0, 0);
        float w[16];
#pragma unroll
        for (int i = 0; i < 16; ++i) { float v = __builtin_amdgcn_exp2f(z[i] - cs[i]); if (diag && crow16(i, hi) >= r32) v = 0.f; w[i] = v; }
        R = __shfl(cs[0], r32);
        const bool done_ = __all(R > SB_EXIT_LOG2) != 0;
        v4u w0, w1; w0.x = pk2(w[0], w[1]); w0.y = pk2(w[2], w[3]); w0.z = pk2(w[4], w[5]); w0.w = pk2(w[6], w[7]);
        w1.x = pk2(w[8], w[9]); w1.y = pk2(w[10], w[11]); w1.z = pk2(w[12], w[13]); w1.w = pk2(w[14], w[15]);
#pragma unroll
        for (int dt = 0; dt < 2; ++dt) {
            v4u a0; a0.x = vlo[dt][0].x; a0.y = vlo[dt][0].y; a0.z = vhi[dt][0].x; a0.w = vhi[dt][0].y;
            v4u a1; a1.x = vlo[dt][1].x; a1.y = vlo[dt][1].y; a1.z = vhi[dt][1].x; a1.w = vhi[dt][1].y;
            oT[dt] = __builtin_amdgcn_mfma_f32_32x32x16_bf16(__builtin_bit_cast(bf16x8, a0), __builtin_bit_cast(bf16x8, w0), oT[dt], 0, 0, 0);
            oT[dt] = __builtin_amdgcn_mfma_f32_32x32x16_bf16(__builtin_bit_cast(bf16x8, a1), __builtin_bit_cast(bf16x8, w1), oT[dt], 0, 0, 0);
        }
        if (done_) break;
    }
    bf16* Op = MIXED + (size_t)(b * SEQ + 32 * qt + r32) * D + 512 + hd * 64 + 4 * hi;
#pragma unroll
    for (int dt = 0; dt < 2; ++dt)
#pragma unroll
        for (int g = 0; g < 4; ++g) { v2u o; o.x = pk2(oT[dt][4 * g], oT[dt][4 * g + 1]); o.y = pk2(oT[dt][4 * g + 2], oT[dt][4 * g + 3]); *(v2u*)(Op + 32 * dt + 8 * g) = o; }
}
__device__ __forceinline__ void sb_phase(Frame& F) {
    const int bh = F.vcu >> 3, s = F.vcu & 7;
    if (bh >= NB * 8) return;
#pragma unroll 1
    for (int i = 0; i < 2; ++i) { const int qb = i == 0 ? 15 - s : s; sb_wave_tile(F.PROJ, F.SVT, F.MIXED, bh >> 3, bh & 7, 8 * qb + F.wave, F.lane); }
}
__device__ __forceinline__ void combine_phase(Frame& F) {
    const int gw = F.vcu * NWAVES + F.wave, NGW = F.G * NWAVES;
    const float l01 = wave_sum(F.lam[F.lane] * F.lam[64 + F.lane]), l23 = wave_sum(F.lam[128 + F.lane] * F.lam[192 + F.lane]);
    const float lmbda = expf(l01) - expf(l23) + 0.2f;
    const float g0 = F.g_sub[2 * F.lane] * 0.8f, g1 = F.g_sub[2 * F.lane + 1] * 0.8f;
    for (int m = gw; m < T; m += NGW) {
        const unsigned* orow = (const unsigned*)(F.ORAW + (size_t)m * D);
        unsigned* mrow = (unsigned*)(F.MIXED + (size_t)m * D);
#pragma unroll
        for (int h = 0; h < 4; ++h) {
            const unsigned a = orow[h * 128 + F.lane], c = orow[h * 128 + 64 + F.lane];
            const float o0 = bflo(a) - lmbda * bflo(c), o1 = bfhi(a) - lmbda * bfhi(c);
            const float rstd = 1.f / sqrtf(wave_sum(o0 * o0 + o1 * o1) * (1.f / 128.f) + NORM_EPS);
            mrow[h * 64 + F.lane] = pk2(o0 * rstd * g0, o1 * rstd * g1);
        }
    }
}
__device__ __forceinline__ unsigned ex_pk8(float a, float b, float c, float d) { return (unsigned)__builtin_amdgcn_cvt_pk_fp8_f32(c, d, __builtin_amdgcn_cvt_pk_fp8_f32(a, b, 0, false), true); }
constexpr int RT_ROWS = 64, RT_HP = 2064, RT_LP = 1040;
static_assert(RT_ROWS * RT_HP <= RING_BYTES && T / RT_ROWS == 256, "router phase LDS map / one tile per workgroup");
__device__ __forceinline__ void route_phase(Frame& F) {
    LAS unsigned char* lds = F.lds + RING_OFF;
    const int tid = F.tid, lane = F.lane, wid = F.wave;
    const float NEG = -INFINITY;
    for (int tile = F.vcu; tile < T / RT_ROWS; tile += F.G) {
        const int row0 = tile * RT_ROWS, b = row0 >> 12;
        __syncthreads();
        const float* shift = F.MOD + b * 6144 + 3 * 1024; const float* scale = F.MOD + b * 6144 + 4 * 1024;
#pragma unroll 1
        for (int r0 = 0; r0 < 8; r0 += 4) {
            f32x4 v[4][4]; v2u dd[4][4];
#pragma unroll
            for (int r = 0; r < 4; ++r) { const int m = row0 + 8 * wid + r0 + r;
                const GAS f32x4* xr = (const GAS f32x4*)(F.x + (size_t)m * D) + lane; const GAS v2u* dr = (const GAS v2u*)(F.DLT + (size_t)m * D) + lane;
#pragma unroll
                for (int j = 0; j < 4; ++j) { v[r][j] = xr[64 * j]; dd[r][j] = dr[64 * j]; } }
#pragma unroll
            for (int r = 0; r < 4; ++r) { const int lr = 8 * wid + r0 + r, m = row0 + lr; float s2 = 0.f;
#pragma unroll
                for (int j = 0; j < 4; ++j) { const v2u d = dd[r][j]; v[r][j].x += bflo(d.x); v[r][j].y += bfhi(d.x); v[r][j].z += bflo(d.y); v[r][j].w += bfhi(d.y);
                    s2 += (v[r][j].x * v[r][j].x + v[r][j].y * v[r][j].y) + (v[r][j].z * v[r][j].z + v[r][j].w * v[r][j].w); }
                const float rstd = 1.f / sqrtf(wave_sum(s2) * (1.f / D) + NORM_EPS);
                GAS unsigned* o8 = (GAS unsigned*)((GAS unsigned char*)F.H2 + (size_t)m * D) + lane;
#pragma unroll
                for (int j = 0; j < 4; ++j) { const int c = 4 * lane + 256 * j;
                    const f32x4 gv = *(const f32x4*)(F.g_ffn + c), sh = *(const f32x4*)(shift + c), sc = *(const f32x4*)(scale + c);
                    const f32x4 y = v[r][j] * rstd * gv * (sc + 1.0f) + sh;
                    v2u w; w.x = pk2(y.x, y.y); w.y = pk2(y.z, y.w); o8[64 * j] = ex_pk8(y.x, y.y, y.z, y.w); *(LAS v2u*)(lds + lr * RT_HP + c * 2) = w; } }
        }
        __syncthreads();
        const int fr = lane & 15, fq = lane >> 4;
        f32x4 acc[4][2];
#pragma unroll
        for (int mt = 0; mt < 4; ++mt)
#pragma unroll
            for (int nt = 0; nt < 2; ++nt) acc[mt][nt] = (f32x4){0.f, 0.f, 0.f, 0.f};
        const bf16* wr0 = F.WR + (size_t)(32 * wid + fr) * D + 8 * fq;
#pragma unroll 8
        for (int ks = 0; ks < D / 32; ++ks) {
            const bf16x8 b0 = *(const bf16x8*)(wr0 + 32 * ks), b1 = *(const bf16x8*)(wr0 + (size_t)16 * D + 32 * ks);
#pragma unroll
            for (int mt = 0; mt < 4; ++mt) { const bf16x8 a = *(const LAS bf16x8*)(lds + (16 * mt + fr) * RT_HP + (32 * ks + 8 * fq) * 2);
                acc[mt][0] = __builtin_amdgcn_mfma_f32_16x16x32_bf16(a, b0, acc[mt][0], 0, 0, 0); acc[mt][1] = __builtin_amdgcn_mfma_f32_16x16x32_bf16(a, b1, acc[mt][1], 0, 0, 0); }
        }
        __syncthreads();
#pragma unroll
        for (int mt = 0; mt < 4; ++mt)
#pragma unroll
            for (int nt = 0; nt < 2; ++nt)
#pragma unroll
                for (int j = 0; j < 4; ++j) *(LAS float*)(lds + (16 * mt + 4 * fq + j) * RT_LP + (32 * wid + 16 * nt + fr) * 4) = acc[mt][nt][j];
        LAS unsigned* hist = (LAS unsigned*)(lds + RT_ROWS * RT_LP + 1024);
        if (tid < NE) hist[tid] = 0u;
        __syncthreads();
        const int tl = lane >> 3, g = lane & 7, t = row0 + 8 * wid + tl;
        float s[32], bz[32];
#pragma unroll
        for (int i4 = 0; i4 < 8; ++i4) { const f32x4 lg = *(const LAS f32x4*)(lds + (8 * wid + tl) * RT_LP + (32 * g + 4 * i4) * 4); const f32x4 eb = *(const f32x4*)(F.e_bias + 32 * g + 4 * i4);
#pragma unroll
            for (int j = 0; j < 4; ++j) { const float sg = __builtin_amdgcn_rcpf(1.0f + __expf(-lg[j])); s[4 * i4 + j] = sg; bz[4 * i4 + j] = sg + eb[j]; } }
        float m1 = NEG, m2 = NEG;
#pragma unroll
        for (int i = 0; i < 32; ++i) { const float v = bz[i]; m2 = fmaxf(m2, fminf(m1, v)); m1 = fmaxf(m1, v); }
        const float gs = m1 + m2; int rank = 0;
#pragma unroll
        for (int gp = 0; gp < 8; ++gp) { const float og = __shfl(gs, (lane & ~7) + gp); rank += (og > gs || (og == gs && gp < g)) ? 1 : 0; }
        unsigned taken = rank < 4 ? 0u : 0xffffffffu;
        int my_e = 0; float my_s = 0.f, ssum = 0.f;
#pragma unroll 1
        for (int k = 0; k < KSEL; ++k) {
            float lm = NEG, ls = 0.f; int li = 0;
#pragma unroll
            for (int i = 0; i < 32; ++i) { const float v = ((taken >> i) & 1u) ? NEG : bz[i]; const bool up = v > lm; lm = up ? v : lm; li = up ? i : li; ls = up ? s[i] : ls; }
            float wm = lm, ws = ls; int we = 32 * g + li;
#pragma unroll
            for (int off = 1; off < 8; off <<= 1) { const float ov = __shfl_xor(wm, off), os = __shfl_xor(ws, off); const int oe = __shfl_xor(we, off);
                const bool take = ov > wm || (ov == wm && oe < we); wm = take ? ov : wm; ws = take ? os : ws; we = take ? oe : we; }
            if ((we >> 5) == g) taken |= 1u << (we & 31);
            if (g == k) { my_e = we; my_s = ws; }
            ssum += ws;
        }
        { const int grp = F.vcu >> 5; unsigned* cnt = F.ctl + CW_COUNT + grp * NE;
          const unsigned lr = __hip_atomic_fetch_add(hist + my_e, 1u, __ATOMIC_RELAXED, __HIP_MEMORY_SCOPE_WORKGROUP);
          __syncthreads();
          if (tid < NE) { const unsigned c = hist[tid]; if (c) hist[NE + tid] = atomicAdd(cnt + tid, c); }
          __syncthreads();
          const unsigned rk = hist[NE + my_e] + lr; const size_t p = (size_t)my_e * T + (size_t)grp * (T / 8) + rk; F.LTOK[p] = (unsigned)t | ((unsigned)g << 16); F.LW[p] = my_s / ssum * 2.5f; }
        if (g == 0) { const size_t p = (size_t)NE * T + t; F.LTOK[p] = (unsigned)t | (8u << 16); F.LW[p] = 1.0f; }
    }
}
constexpr int EX_TOK = 0, EX_WGT = 1024, EX_PFX = 2048, EX_QW = 3584, EX_A0 = 4096, EX_ASL = 8192, EX_NAS = 6, EX_W0 = EX_A0 + EX_NAS * EX_ASL, EX_WST = 32768, EX_NST = 3;
static_assert(EX_W0 + EX_NST * EX_WST <= RING_BYTES, "expert LDS map");
constexpr int EX_ROWS = 256, EX_XQ = 34;
__device__ __forceinline__ v4u ex_gld16v(const char* sbase, unsigned voff) { v4u v; asm volatile("global_load_dwordx4 %0, %1, %2" : "=v"(v) : "v"(voff), "s"(sbase) : "memory"); return v; }
template <int AUX> __device__ __forceinline__ void ex_dma(const void* g, LAS unsigned char* l) { __builtin_amdgcn_global_load_lds((const unsigned*)g, (LAS unsigned*)l, 16, 0, AUX); }
template <int MODE>
__device__ __forceinline__ void ex_tile(Frame& F, LAS unsigned char* lds, int tid_, const float* W, int j, int nrows, unsigned char* ACT) {
    int tid = tid_; asm volatile("" : "+v"(tid));
    LAS unsigned* tokL = (LAS unsigned*)(lds + EX_TOK); LAS float* wgtL = (LAS float*)(lds + EX_WGT);
    const int lane = tid & 63, wid = __builtin_amdgcn_readfirstlane(tid >> 6), wr = wid >> 2, wc = wid & 3, fr = lane & 15, fq = lane >> 4;
    constexpr int K = MODE == 0 ? D : FF, ldw = MODE == 0 ? 512 : D, NK = K / 32, NB = K / 128, APITCH = MODE == 0 ? D : FF;
    const int wcol = MODE == 0 ? (((lane & 3) >> 1) * 256 + 128 * j + 32 * (lane >> 4) + 8 * ((lane >> 2) & 3) + 4 * (lane & 1)) : (256 * j + 4 * lane);
    const char* wsrc = (const char*)(W + (size_t)(4 * wid) * ldw);
    const unsigned wvoff = 4u * (unsigned)wcol;
    const char* abase = MODE == 0 ? (const char*)F.H2 : (const char*)ACT;
    const int arow0 = 32 * wid + (lane >> 3), ac = lane & 7;
    const int awoff = EX_A0 + arow0 * 32 + (ac & 1) * 16;
#define EX_ISSUE_W(ks, st) do { LAS unsigned char* sb_ = lds + EX_W0 + (st) * EX_WST; \
        _Pragma("unroll") for (int i_ = 0; i_ < 4; ++i_) ex_dma<0>(wsrc + (size_t)(32 * (ks) + i_) * (ldw * 4) + wvoff, sb_ + (4 * wid + i_) * 1024); } while (0)
#define EX_LOAD_A(b) do { _Pragma("unroll") for (int i_ = 0; i_ < 4; ++i_) { const int r_ = arow0 + 8 * i_; \
        const unsigned o_ = (MODE == 0 ? (tokL[r_] & 0xffffu) : (unsigned)r_) * (unsigned)APITCH + 16u * (unsigned)ac + 128u * (unsigned)(b); ar[i_] = ex_gld16v(abase, o_); } } while (0)
#define EX_WRITE_A(sb0, WAITSTR) do {   \
          \
        int sl_ = (sb0) + (ac >> 1); sl_ = sl_ >= EX_NAS ? sl_ - EX_NAS : sl_; \
        const unsigned ae_ = (unsigned)(uintptr_t)(lds + awoff + sl_ * EX_ASL), ao_ = (unsigned)(uintptr_t)(lds + (awoff ^ 16) + sl_ * EX_ASL); \
        asm volatile(WAITSTR "\n\tds_write_b128 %4, %0\n\tds_write_b128 %5, %1 offset:256\n\tds_write_b128 %4, %2 offset:512\n\tds_write_b128 %5, %3 offset:768" \
                     :: "v"(ar[0]), "v"(ar[1]), "v"(ar[2]), "v"(ar[3]), "v"(ae_), "v"(ao_) : "memory"); } while (0)
    v4u ar[4];
    f32x4 acc[8][4];
#pragma unroll
    for (int m = 0; m < 8; ++m)
#pragma unroll
        for (int q = 0; q < 4; ++q) acc[m][q] = (f32x4){0.f, 0.f, 0.f, 0.f};
    const bool active = 128 * wr < nrows;
    const int boff = EX_W0 + fq * 8192 + wc * 256 + fr * 16;
    const int aoff_r = EX_A0 + (128 * wr + fr) * 32 + ((fq ^ (((fr >> 3) & 1) << 1)) * 8);
    EX_LOAD_A(0); EX_ISSUE_W(0, 0); EX_ISSUE_W(1, 1);
    EX_WRITE_A(0, "s_waitcnt vmcnt(8)");
    int st = 0, as = 0;
#pragma unroll 4
    for (int ks = 0; ks < NK; ++ks) {
        { const int after = (ks + 1 < NK ? 4 : 0) + ((((ks & 3) == 1 || (ks & 3) == 2) && (ks >> 2) + 1 < NB) ? 4 : 0);
          if (after >= 8) asm volatile("s_waitcnt vmcnt(8)" ::: "memory"); else if (after >= 4) asm volatile("s_waitcnt vmcnt(4)" ::: "memory"); else asm volatile("s_waitcnt vmcnt(0)" ::: "memory"); }
        asm volatile("s_waitcnt lgkmcnt(0)" ::: "memory");
        __builtin_amdgcn_s_barrier();
        asm volatile("" ::: "memory");
        f32x4 xw[8]; long af[8];
        if (active) {
            const LAS unsigned char* bp = lds + boff + st * EX_WST;
#pragma unroll
            for (int jj = 0; jj < 8; ++jj) xw[jj] = *(const LAS f32x4*)(bp + jj * 1024);
            const LAS unsigned char* ap = lds + aoff_r + as * EX_ASL;
#pragma unroll
            for (int m = 0; m < 8; ++m) af[m] = *(const LAS long*)(ap + m * 512);
        }
        const int s2 = st + 2 >= EX_NST ? st + 2 - EX_NST : st + 2;
        if (ks + 2 < NK) EX_ISSUE_W(ks + 2, s2);
        if (active) {
            long bw[4];
#pragma unroll
            for (int q = 0; q < 4; ++q) { const unsigned lo = ex_pk8(xw[0][q], xw[1][q], xw[2][q], xw[3][q]), hi = ex_pk8(xw[4][q], xw[5][q], xw[6][q], xw[7][q]);
                bw[q] = (long)(((unsigned long long)hi << 32) | (unsigned long long)lo); }
            __builtin_amdgcn_s_setprio(1);
#pragma unroll
            for (int m = 0; m < 8; ++m)
#pragma unroll
                for (int q = 0; q < 4; ++q) acc[m][q] = __builtin_amdgcn_mfma_f32_16x16x32_fp8_fp8(bw[q], af[m], acc[m][q], 0, 0, 0);
            __builtin_amdgcn_s_setprio(0);
        }
        if ((ks & 3) == 0 && (ks >> 2) + 1 < NB) EX_LOAD_A((ks >> 2) + 1);
        if ((ks & 3) == 3 && ks + 1 < NK) {
            const int sb0 = as + 1 >= EX_NAS ? 0 : as + 1;
            EX_WRITE_A(sb0, "s_waitcnt vmcnt(12)");
        }
        st = st + 1 >= EX_NST ? 0 : st + 1; as = as + 1 >= EX_NAS ? 0 : as + 1;
    }
#undef EX_ISSUE_W
#undef EX_LOAD_A
#undef EX_WRITE_A
    if (active) {
        if (MODE == 0) {
#pragma unroll
            for (int m = 0; m < 8; ++m) { float o[8];
#pragma unroll
                for (int rg = 0; rg < 2; ++rg)
#pragma unroll
                    for (int q = 0; q < 4; ++q) { const float g = acc[m][q][rg], u = acc[m][q][rg + 2]; o[4 * rg + q] = g * __builtin_amdgcn_rcpf(1.0f + __expf(-g)) * u; }
                v2u w; w.x = ex_pk8(o[0], o[1], o[2], o[3]); w.y = ex_pk8(o[4], o[5], o[6], o[7]);
                *(v2u*)(ACT + (size_t)(128 * wr + 16 * m + fr) * FF + 128 * j + 32 * wc + 8 * fq) = w; }
        } else {
#pragma unroll
            for (int m = 0; m < 8; ++m) { const int row = 128 * wr + 16 * m + fr;
                if (row < nrows) { const unsigned ti = tokL[row]; const float wv = wgtL[row];
                    unsigned char* yp = (unsigned char*)F.Y + ((size_t)(ti & 0xffffu) * NSLOT9 + (ti >> 16)) * D + 256 * j + 64 * wc + 16 * fq;
                    v4u w;
#pragma unroll
                    for (int rg = 0; rg < 4; ++rg) { unsigned p = __builtin_amdgcn_cvt_pk_fp8_f32(acc[m][0][rg] * wv, acc[m][1][rg] * wv, 0, false);
                        w[rg] = __builtin_amdgcn_cvt_pk_fp8_f32(acc[m][2][rg] * wv, acc[m][3][rg] * wv, p, true); }
                    *(v4u*)yp = w; } }
        }
    }
    __builtin_amdgcn_s_barrier();
    asm volatile("" ::: "memory");
}
__device__ __forceinline__ void expert_unit(Frame& F, int e, int chunk, int nrows) {
    LAS unsigned char* lds = F.lds + RING_OFF;
    LAS unsigned* tokL = (LAS unsigned*)(lds + EX_TOK); LAS float* wgtL = (LAS float*)(lds + EX_WGT);
    const int tid = F.tid;
    if (tid < EX_ROWS) { const bool ok = tid < nrows; size_t p = (size_t)e * T + (size_t)chunk * EX_ROWS + tid;
        if (e < NE) { const unsigned r = (unsigned)(chunk * EX_ROWS + tid); unsigned run = 0; p = (size_t)e * T;
#pragma unroll
            for (int g_ = 0; g_ < 8; ++g_) { const unsigned c = __hip_atomic_load(F.ctl + CW_COUNT + g_ * NE + e, RLX_AGENT); if (r >= run && r < run + c) p = (size_t)e * T + (size_t)g_ * (T / 8) + (r - run); run += c; } }
        tokL[tid] = ok ? F.LTOK[p] : 0u; wgtL[tid] = ok ? F.LW[p] : 0.f; }
    __syncthreads();
    const float* Wgu = e < NE ? F.w_gu + (size_t)e * D * 512 : F.w_sh_gu;
    const float* Wdn = e < NE ? F.w_down + (size_t)e * FF * D : F.w_sh_down;
    unsigned char* ACT = (unsigned char*)F.ACT + (size_t)F.vcu * EX_ROWS * FF;
#pragma unroll 1
    for (int j = 0; j < 2; ++j) ex_tile<0>(F, lds, tid, Wgu, j, nrows, ACT);
    VM_WAIT(); __syncthreads();
#pragma unroll 1
    for (int j = 0; j < 4; ++j) ex_tile<1>(F, lds, tid, Wdn, j, nrows, ACT);
}
__device__ __forceinline__ void expert_phase(Frame& F) {
    LAS unsigned char* lds = F.lds + RING_OFF;
    LAS unsigned* pfx = (LAS unsigned*)(lds + EX_PFX);
    LAS unsigned* qw = (LAS unsigned*)(lds + EX_QW);
    __syncthreads();
    LAS unsigned* cntL = (LAS unsigned*)(lds + EX_A0);
    if (F.tid < NE) { unsigned c = 0;
#pragma unroll
        for (int g_ = 0; g_ < 8; ++g_) c += __hip_atomic_load(F.ctl + CW_COUNT + g_ * NE + F.tid, RLX_AGENT);
        cntL[F.tid] = c; }
    __syncthreads();
    if (F.tid < 8) { const int x = F.tid; unsigned run = 0;
        for (int i = 0; i < 32; ++i) { pfx[x * EX_XQ + i] = run; run += (cntL[8 * i + x] + EX_ROWS - 1) / EX_ROWS; }
        pfx[x * EX_XQ + 32] = run; run += (T / EX_ROWS) / 8; pfx[x * EX_XQ + 33] = run; }
    __syncthreads();
    const int myx = (int)(xb_xcc_id() & 7u);
    int hop = 0;
#pragma unroll 1
    for (;;) {
        __syncthreads();
        if (F.tid == 0) { unsigned u = 0xffffffffu; int h = hop;
            for (; h < 8; ++h) { const int x = (myx + h) & 7; u = __hip_atomic_fetch_add(F.ctl + CW_QUEUE + 64 * x, 1u, RLX_AGENT); if (u < pfx[x * EX_XQ + 33]) break; }
            qw[0] = u; qw[1] = (unsigned)h; }
        __syncthreads();
        const int u = (int)qw[0]; hop = (int)qw[1];
        if (hop >= 8) break;
        const int x = (myx + hop) & 7;
        const LAS unsigned* px = pfx + x * EX_XQ;
        int lo = 0, hi = 32;
        while (lo < hi) { const int mid = (lo + hi + 1) >> 1; if ((int)px[mid] <= u) lo = mid; else hi = mid - 1; }
        int e, chunk, cnt;
        if (lo < 32) { e = 8 * lo + x; chunk = u - (int)px[lo]; cnt = 0;
#pragma unroll
            for (int g_ = 0; g_ < 8; ++g_) cnt += (int)__hip_atomic_load(F.ctl + CW_COUNT + g_ * NE + e, RLX_AGENT); }
        else { e = NE; chunk = 8 * x + (u - (int)px[32]); cnt = T; }
        const int nrows = min(EX_ROWS, cnt - EX_ROWS * chunk);
        expert_unit(F, e, chunk, nrows);
    }
}
__device__ __forceinline__ void final_phase(Frame& F) {
    typedef float f32x2 __attribute__((ext_vector_type(2)));
    const int gw = F.vcu * NWAVES + F.wave, NGW = F.G * NWAVES;
    for (int m = gw; m < T; m += NGW) {
        const float* gm = F.MOD + (size_t)(m >> 12) * 6144 + 5 * 1024;
        const unsigned* yrow = (const unsigned*)((const unsigned char*)F.Y + (size_t)m * NSLOT9 * D) + F.lane;
#pragma unroll
        for (int i = 0; i < 4; ++i) { const int c = 4 * F.lane + 256 * i; float a0 = 0.f, a1 = 0.f, a2 = 0.f, a3 = 0.f;
#pragma unroll
            for (int k = 0; k < NSLOT9; ++k) { const unsigned y = __builtin_nontemporal_load(yrow + k * (D / 4) + 64 * i);
                const f32x2 lo = __builtin_amdgcn_cvt_pk_f32_fp8(y, false), hi = __builtin_amdgcn_cvt_pk_f32_fp8(y, true); a0 += lo[0]; a1 += lo[1]; a2 += hi[0]; a3 += hi[1]; }
            f32x4 r = __builtin_nontemporal_load((const f32x4*)(F.x + (size_t)m * D + c));
            { const v2u d = __builtin_nontemporal_load((const v2u*)(F.DLT + (size_t)m * D + c)); r.x += bflo(d.x); r.y += bfhi(d.x); r.z += bflo(d.y); r.w += bfhi(d.y); }
            const f32x4 g = *(const f32x4*)(gm + c);
            f32x4 o; o.x = r.x + g.x * a0; o.y = r.y + g.y * a1; o.z = r.z + g.z * a2; o.w = r.w + g.w * a3;
            __builtin_nontemporal_store(o, (f32x4*)(F.out + (size_t)m * D + c)); }
    }
}
struct Args { const void* in[19]; float* out; unsigned char* ws; };
static_assert(sizeof(Args) == 21 * 8, "Args has no padding bytes");
__global__ void __launch_bounds__(NWAVES * 64, 2) hybrid_fwd(Args args) {
    extern __shared__ __attribute__((aligned(16))) unsigned char lds[];
    Frame F;
    F.lds = (LAS unsigned char*)lds;
    F.MISC = (volatile LAS unsigned*)(F.lds + MISC_OFF);
    F.tid = threadIdx.x; F.lane = F.tid & 63; F.wave = __builtin_amdgcn_readfirstlane(F.tid >> 6);
    F.G = gridDim.x; { const int bx = blockIdx.x; F.vcu = (F.G % 8 == 0) ? (bx % 8) * (F.G / 8) + bx / 8 : bx; }
    unsigned char* ws = args.ws;
    F.ctl = (unsigned*)(ws + WS_CTL);
    F.x = (const float*)args.in[0]; F.c = (const float*)args.in[1]; F.positions = (const int*)args.in[2]; F.w_ada = (const float*)args.in[3]; F.b_ada = (const float*)args.in[4];
    F.g_mix = (const float*)args.in[5]; F.w_in = (const float*)args.in[6]; F.g_q = (const float*)args.in[7]; F.g_k = (const float*)args.in[8]; F.lam = (const float*)args.in[9];
    F.g_sub = (const float*)args.in[10]; F.w_out = (const float*)args.in[11]; F.g_ffn = (const float*)args.in[12]; F.w_router = (const float*)args.in[13]; F.e_bias = (const float*)args.in[14];
    F.w_sh_gu = (const float*)args.in[15]; F.w_sh_down = (const float*)args.in[16]; F.w_gu = (const float*)args.in[17]; F.w_down = (const float*)args.in[18];
    F.out = args.out;
    F.MOD = (float*)(ws + WS_MOD); F.RCOS = (float*)(ws + WS_COS); F.RSIN = (float*)(ws + WS_SIN); F.DLT = (bf16*)(ws + WS_R); F.LW = (float*)(ws + WS_LW);
    F.WIN = (bf16*)(ws + WS_WIN); F.WOUT = (bf16*)(ws + WS_WOUT); F.WR = (bf16*)(ws + WS_WR); F.XN = (bf16*)(ws + WS_XN); F.PROJ = (bf16*)(ws + WS_PROJ); F.SVT = (bf16*)(ws + WS_SVT);
    F.ORAW = (bf16*)(ws + WS_ORAW); F.MIXED = (bf16*)(ws + WS_MIXED); F.H2 = (bf16*)(ws + WS_H2); F.Y = (bf16*)(ws + WS_Y); F.ACT = (bf16*)(ws + WS_ACT); F.LTOK = (unsigned*)(ws + WS_LTOK);
    for (int u = F.tid; u < (LDS_BYTES - LDSCTL_OFF) / 4; u += NWAVES * 64) ((LAS unsigned*)(F.lds + LDSCTL_OFF))[u] = 0u;
    __syncthreads();
    XcdBarrier bar = xcd_barrier_post(F.ctl + CW_BAR, F.MISC + 8);
#define GRID_BAR() xcd_barrier(bar)
#define PHASE_BEGIN() do { int t_ = threadIdx.x; asm volatile("" : "+v"(t_)); F.tid = t_; F.lane = t_ & 63; } while (0)

    PHASE_BEGIN(); p0_prologue(F);
    GRID_BAR();
    PHASE_BEGIN(); rows_adaln(F, F.x, F.g_mix, F.MOD + 0 * 1024, F.MOD + 1 * 1024, F.XN);
    GRID_BAR();
    {   pg8::Gemm g{F.XN, F.WIN, T, NPROJ, D}; pg8::StaticOrder S; S.init(T, NPROJ, F.G, (int)blockIdx.x);
        pg8::EpiProj E{F.PROJ, F.SVT, F.RCOS, F.RSIN, F.g_q, F.g_k};
        pg8::gemm_phase<pg8::EpiProj, pg8::StaticOrder, PG8_ALIGN, PG8_SP2>(F.lds + RING_OFF, g, S, E); }
    GRID_BAR();
    {   const attn_body::StaticOrder S((int)F.G, (int)blockIdx.x);
        attn_body::attn_phase<attn_body::StaticOrder>((char*)lds + RING_OFF, (const attn_body::bf16*)F.PROJ, (attn_body::bf16*)F.ORAW, S); }
    PHASE_BEGIN(); sb_phase(F);
    GRID_BAR();
    PHASE_BEGIN(); combine_phase(F);
    GRID_BAR();
    {   pg8::Gemm g{F.MIXED, F.WOUT, T, D, D}; pg8::StaticOrder S; S.init(T, D, F.G, (int)blockIdx.x);
        pg8::EpiGateBf16 E{F.MOD + 2 * 1024, F.DLT};
        pg8::gemm_phase<pg8::EpiGateBf16, pg8::StaticOrder, PG8_ALIGN, PG8_SP2>(F.lds + RING_OFF, g, S, E); }
    GRID_BAR();
    PHASE_BEGIN(); route_phase(F);
    GRID_BAR();
    PHASE_BEGIN(); expert_phase(F);
    GRID_BAR();
    PHASE_BEGIN(); final_phase(F);
}

extern "C" void kernel_launch(void* const* d_in, const int* in_sizes, int n_in, void* d_out, int out_size, void* d_ws, size_t ws_size, hipStream_t stream) {
    static int grid = 0;
    if (grid == 0) {
        if (n_in != 19 || out_size != T * D || ws_size < WS_END) { fprintf(stderr, "kernel_launch: unexpected problem shape (n_in %d, out %d, ws %zu); nothing launched\n", n_in, out_size, ws_size); grid = -1; return; }
        int dev = 0, cus = 0, per_cu = 0;
        if (hipGetDevice(&dev) != hipSuccess || hipDeviceGetAttribute(&cus, hipDeviceAttributeMultiprocessorCount, dev) != hipSuccess) { grid = -1; return; }
        if (hipFuncSetAttribute((const void*)hybrid_fwd, hipFuncAttributeMaxDynamicSharedMemorySize, LDS_BYTES) != hipSuccess) { fprintf(stderr, "kernel_launch: hipFuncSetAttribute failed\n"); grid = -1; return; }
        if (hipOccupancyMaxActiveBlocksPerMultiprocessor(&per_cu, (const void*)hybrid_fwd, NWAVES * 64, LDS_BYTES) != hipSuccess || per_cu < 1)
            fprintf(stderr, "kernel_launch: note: the occupancy query reports %d workgroups per CU\n", per_cu);
        (void)hipGetLastError();
        grid = cus;
        if (grid != 256) fprintf(stderr, "kernel_launch: %d CUs (expected 256)\n", grid);
    }
    if (grid < 0) return;
    if (hipMemsetAsync((char*)d_ws + WS_CTL, 0, CTL_ZERO_BYTES, stream) != hipSuccess) { fprintf(stderr, "kernel_launch: hipMemsetAsync failed\n"); return; }
    Args a{};
    for (int i = 0; i < 19; ++i) a.in[i] = d_in[i];
    a.out = (float*)d_out; a.ws = (unsigned char*)d_ws;
    hipLaunchKernelGGL(hybrid_fwd, dim3(grid), dim3(NWAVES * 64), LDS_BYTES, stream, a);
    const hipError_t le = hipPeekAtLastError();
    if (le != hipSuccess) fprintf(stderr, "kernel_launch: launch failed: %s\n", hipGetErrorName(le));
}
```
